# Optimizing an MI355X kernel written in HIP

```python
import math
import jax
import jax.numpy as jnp
from jax import lax
import numpy as np

D_MODEL = 1024
BATCH = 8
SEQ = 2048
DEPTH = 4

HEAD_DIM = 64
NSA_HEADS = 8
NSA_KV_HEADS = 2
NSA_GROUP = NSA_HEADS // NSA_KV_HEADS
CMP_BLOCK = 32
CMP_STRIDE = 16
CMP_HIDDEN = 128
SEL_BLOCK = 64
N_SELECT = 16
N_LOCAL_SEL = 2
WINDOW = 512
NSA_Q_BLOCK = 64
FOX_HEADS = 8
Q_BLOCK = 128
REL_BUCKETS = 32
REL_MAX_DIST = 128
D_FF_DENSE = 2816
N_EXPERTS = 8
TOP_K = 2
D_FF_EXPERT = 3584
DN_ALPHA = (2 * DEPTH) ** 0.25
DN_BETA = (8 * DEPTH) ** -0.25
LN_EPS = 1e-5
FORCED_SCORE = 1e4
NEG_INF = -1e30

NSA_Q_W = NSA_HEADS * HEAD_DIM
NSA_KV_W = NSA_KV_HEADS * HEAD_DIM
FOX_W = FOX_HEADS * HEAD_DIM
IN_SPLITS = (NSA_Q_W, 6 * NSA_KV_W, 3 * NSA_HEADS, 3 * FOX_W, FOX_HEADS, 2 * D_MODEL)
D_IN_PROJ = NSA_Q_W + 6 * NSA_KV_W + 3 * NSA_HEADS + 3 * FOX_W + FOX_HEADS + 2 * D_MODEL
N_DENSE_LAYERS = (DEPTH + 1) // 2
N_MOE_LAYERS = DEPTH // 2

kernel_name = 'hybrid_nsa_fox_moe_deepnorm'


def layer_norm(x, g, b):
    xf = x.astype(jnp.float32)
    mu = xf.mean(-1, keepdims=True)
    var = jnp.square(xf - mu).mean(-1, keepdims=True)
    return ((xf - mu) * lax.rsqrt(var + LN_EPS) * g + b).astype(x.dtype)


def masked_softmax(s, mask, axis):
    s = jnp.where(mask, s.astype(jnp.float32), NEG_INF)
    s = s - s.max(axis=axis, keepdims=True)
    e = jnp.where(mask, jnp.exp(s), 0.0)
    return e / jnp.maximum(e.sum(axis=axis, keepdims=True), 1e-30)


def t5_bucket(dist):
    n = jnp.maximum(dist, 0)
    max_exact = REL_BUCKETS // 2
    large = max_exact + (jnp.log(jnp.maximum(n, 1).astype(jnp.float32) / max_exact)
                         / math.log(REL_MAX_DIST / max_exact) * (REL_BUCKETS - max_exact)).astype(jnp.int32)
    large = jnp.minimum(large, REL_BUCKETS - 1)
    return jnp.where(n < max_exact, n, large)


def compress_blocks(kv, pe, w1, w2):
    B, S, Hkv, dk = kv.shape
    r = CMP_BLOCK // CMP_STRIDE
    n_half = S // CMP_STRIDE
    n_cmp = n_half - r + 1
    h = kv.reshape(B, n_half, CMP_STRIDE, Hkv, dk)
    blocks = jnp.concatenate([h[:, j:j + n_cmp] for j in range(r)], axis=2)
    blocks = blocks + pe[None, None, :, None, :]
    blocks = blocks.transpose(0, 1, 3, 2, 4).reshape(B, n_cmp, Hkv, CMP_BLOCK * dk)
    return jax.nn.gelu(blocks @ w1) @ w2


def cmp_to_sel_overlap(n_cmp, n_sel):
    c0 = np.arange(n_cmp)[:, None] * CMP_STRIDE
    s0 = np.arange(n_sel)[None, :] * SEL_BLOCK
    ov = np.maximum(np.minimum(c0 + CMP_BLOCK, s0 + SEL_BLOCK) - np.maximum(c0, s0), 0)
    return jnp.asarray(ov / CMP_BLOCK, dtype=jnp.float32)


def nsa_attention(q, k_c, v_c, k_s, v_s, k_w, v_w, gates, rel_bias):
    B, S, Hkv, G, dk = q.shape
    n_cmp = k_c.shape[1]
    n_sel = S // SEL_BLOCK
    top_n = min(N_SELECT, n_sel)
    n_qb = S // NSA_Q_BLOCK
    scale = dk ** -0.5
    tab = rel_bias.astype(jnp.float32).reshape(REL_BUCKETS, Hkv, G)
    tab_h = tab.transpose(1, 0, 2)
    cmp_end = jnp.arange(n_cmp) * CMP_STRIDE + CMP_BLOCK - 1
    overlap = cmp_to_sel_overlap(n_cmp, n_sel)
    blk = jnp.arange(n_sel)
    k_sb = k_s.reshape(B, n_sel, SEL_BLOCK, Hkv, dk).transpose(0, 3, 1, 2, 4)
    v_sb = v_s.reshape(B, n_sel, SEL_BLOCK, Hkv, dk).transpose(0, 3, 1, 2, 4)
    b_idx = jnp.arange(B)[:, None, None, None]
    h_idx = jnp.arange(Hkv)[None, :, None, None]
    pad = ((0, 0), (WINDOW, 0), (0, 0), (0, 0))
    k_wp = jnp.pad(k_w, pad)
    v_wp = jnp.pad(v_w, pad)
    qi = jnp.arange(NSA_Q_BLOCK)
    kj = jnp.arange(NSA_Q_BLOCK + WINDOW)
    rel_w = qi[:, None] + WINDOW - kj[None, :]
    band = (rel_w >= 0) & (rel_w < WINDOW)
    bias_w = tab[t5_bucket(rel_w)].transpose(2, 3, 0, 1)

    def block(args):
        c, qb, gb = args
        t = c * NSA_Q_BLOCK + qi
        s_c = jnp.einsum('bqhgd,bchd->bhgqc', qb, k_c) * scale
        vis_c = cmp_end[None, :] <= t[:, None]
        bias_c = tab[t5_bucket(t[:, None] - cmp_end[None, :])].transpose(2, 3, 0, 1)
        p_c = masked_softmax(s_c + bias_c, vis_c, -1)
        o_c = jnp.einsum('bhgqc,bchd->bqhgd', p_c.astype(v_c.dtype), v_c)
        imp = jnp.einsum('bhgqc,cj->bhqj', p_c, overlap)
        cur = (t // SEL_BLOCK)[:, None]
        forced = (blk[None, :] == 0) | ((blk[None, :] <= cur) & (blk[None, :] > cur - N_LOCAL_SEL))
        imp = jnp.where(forced, FORCED_SCORE, jnp.where(blk[None, :] <= cur, imp, -1.0))
        _, idx = lax.top_k(imp, top_n)
        k_g = k_sb[b_idx, h_idx, idx]
        v_g = v_sb[b_idx, h_idx, idx]
        pos = idx[..., None] * SEL_BLOCK + jnp.arange(SEL_BLOCK)
        rel_s = t[:, None, None] - pos
        vis_s = (rel_s >= 0)[:, :, None]
        bias_s = tab_h[h_idx[..., None], t5_bucket(rel_s)].transpose(0, 1, 5, 2, 3, 4)
        s_s = jnp.einsum('bqhgd,bhqnld->bhgqnl', qb, k_g) * scale + bias_s
        p_s = masked_softmax(s_s, vis_s, (-2, -1))
        o_s = jnp.einsum('bhgqnl,bhqnld->bqhgd', p_s.astype(v_g.dtype), v_g)
        k_wb = lax.dynamic_slice_in_dim(k_wp, c * NSA_Q_BLOCK, NSA_Q_BLOCK + WINDOW, axis=1)
        v_wb = lax.dynamic_slice_in_dim(v_wp, c * NSA_Q_BLOCK, NSA_Q_BLOCK + WINDOW, axis=1)
        s_w = jnp.einsum('bqhgd,bkhd->bhgqk', qb, k_wb) * scale + bias_w
        vis_w = band & ((c * NSA_Q_BLOCK - WINDOW + kj) >= 0)[None, :]
        p_w = masked_softmax(s_w, vis_w, -1)
        o_w = jnp.einsum('bhgqk,bkhd->bqhgd', p_w.astype(v_wb.dtype), v_wb)
        return gb[..., 0:1] * o_c + gb[..., 1:2] * o_s + gb[..., 2:3] * o_w

    q_blocks = q.reshape(B, n_qb, NSA_Q_BLOCK, Hkv, G, dk).transpose(1, 0, 2, 3, 4, 5)
    g_blocks = gates.reshape(B, n_qb, NSA_Q_BLOCK, Hkv, G, 3).transpose(1, 0, 2, 3, 4, 5)
    out = lax.map(block, (jnp.arange(n_qb), q_blocks, g_blocks))
    return out.transpose(1, 0, 2, 3, 4, 5).reshape(B, S, Hkv * G * dk)


def forgetting_attention(q, k, v, log_f):
    B, S, H, dk = q.shape
    n_qb = S // Q_BLOCK
    scale = dk ** -0.5
    F = jnp.cumsum(log_f, axis=1)
    F_k = F.transpose(0, 2, 1)
    key_pos = jnp.arange(S)

    def block(args):
        c, qb, Fq = args
        t = c * Q_BLOCK + jnp.arange(Q_BLOCK)
        s = jnp.einsum('bqhd,bkhd->bhqk', qb, k).astype(jnp.float32) * scale
        s = s + (Fq.transpose(0, 2, 1)[..., None] - F_k[:, :, None, :])
        p = masked_softmax(s, key_pos[None, :] <= t[:, None], -1)
        return jnp.einsum('bhqk,bkhd->bqhd', p.astype(v.dtype), v)

    q_blocks = q.reshape(B, n_qb, Q_BLOCK, H, dk).transpose(1, 0, 2, 3, 4)
    f_blocks = F.reshape(B, n_qb, Q_BLOCK, H).transpose(1, 0, 2, 3)
    out = lax.map(block, (jnp.arange(n_qb), q_blocks, f_blocks))
    return out.transpose(1, 0, 2, 3, 4).reshape(B, S, H * dk)


def hybrid_mixer(x, w_in, cmp_pe, cmp_w1, cmp_w2, f_bias, w_nsa_br, w_fox_br, w_o, rel_bias):
    B, S, _ = x.shape
    proj = x @ w_in
    offsets = np.cumsum(IN_SPLITS)[:-1].tolist()
    nsa_q, nsa_kv, nsa_g, fox_qkv, fox_f, merge_g = jnp.split(proj, offsets, axis=-1)
    q = nsa_q.reshape(B, S, NSA_KV_HEADS, NSA_GROUP, HEAD_DIM)
    k_c, v_c, k_s, v_s, k_w, v_w = [a.reshape(B, S, NSA_KV_HEADS, HEAD_DIM)
                                    for a in jnp.split(nsa_kv, 6, axis=-1)]
    k_c = compress_blocks(k_c, cmp_pe[0], cmp_w1[0], cmp_w2[0])
    v_c = compress_blocks(v_c, cmp_pe[1], cmp_w1[1], cmp_w2[1])
    gates = jax.nn.sigmoid(nsa_g).reshape(B, S, NSA_KV_HEADS, NSA_GROUP, 3)
    y_nsa = nsa_attention(q, k_c, v_c, k_s, v_s, k_w, v_w, gates, rel_bias)
    fq, fk, fv = [a.reshape(B, S, FOX_HEADS, HEAD_DIM) for a in jnp.split(fox_qkv, 3, axis=-1)]
    log_f = jax.nn.log_sigmoid(fox_f.astype(jnp.float32) + f_bias.astype(jnp.float32))
    y_fox = forgetting_attention(fq, fk, fv, log_f)
    g_nsa, g_fox = jnp.split(jax.nn.sigmoid(merge_g), 2, axis=-1)
    merged = g_nsa * (y_nsa @ w_nsa_br) + g_fox * (y_fox @ w_fox_br)
    return merged @ w_o


def swiglu(x, w_gate, w_up, w_down):
    return (jax.nn.silu(x @ w_gate) * (x @ w_up)) @ w_down


def moe_swiglu(x, router, w_gate, w_up, w_down):
    logits = (x @ router).astype(jnp.float32)
    top_val, top_idx = lax.top_k(logits, TOP_K)
    top_w = jax.nn.softmax(top_val, axis=-1)
    gate = jnp.sum(jax.nn.one_hot(top_idx, N_EXPERTS, dtype=jnp.float32) * top_w[..., None], axis=-2)
    gate = gate.astype(x.dtype)
    out = jnp.zeros_like(x)
    for e in range(N_EXPERTS):
        out = out + gate[..., e:e + 1] * swiglu(x, w_gate[e], w_up[e], w_down[e])
    return out


def setup_inputs(seed: int = 0) -> dict:
    key = jax.random.key(seed)
    ks = jax.random.split(key, 21)
    f32 = jnp.float32

    def nrm(k, shape, scale):
        return jax.random.normal(k, shape, f32) * scale

    return {
        'x': nrm(ks[0], (BATCH, SEQ, D_MODEL), 1.0),
        'w_in': nrm(ks[1], (DEPTH, D_MODEL, D_IN_PROJ), D_MODEL ** -0.5),
        'nsa_cmp_pe': nrm(ks[2], (DEPTH, 2, CMP_BLOCK, HEAD_DIM), 0.1),
        'nsa_cmp_w1': nrm(ks[3], (DEPTH, 2, CMP_BLOCK * HEAD_DIM, CMP_HIDDEN), (CMP_BLOCK * HEAD_DIM) ** -0.5),
        'nsa_cmp_w2': nrm(ks[4], (DEPTH, 2, CMP_HIDDEN, HEAD_DIM), CMP_HIDDEN ** -0.5),
        'fox_f_bias': jax.random.uniform(ks[5], (DEPTH, FOX_HEADS), f32, 1.0, 4.0),
        'w_nsa_branch': nrm(ks[6], (DEPTH, NSA_Q_W, D_MODEL), NSA_Q_W ** -0.5),
        'w_fox_branch': nrm(ks[7], (DEPTH, FOX_W, D_MODEL), FOX_W ** -0.5),
        'w_out': nrm(ks[8], (DEPTH, D_MODEL, D_MODEL), DN_BETA * D_MODEL ** -0.5),
        'rel_bias': nrm(ks[9], (REL_BUCKETS, NSA_HEADS), 0.5),
        'ln1_g': 1.0 + nrm(ks[10], (DEPTH, D_MODEL), 0.02),
        'ln1_b': nrm(ks[11], (DEPTH, D_MODEL), 0.02),
        'ln2_g': 1.0 + nrm(ks[12], (DEPTH, D_MODEL), 0.02),
        'ln2_b': nrm(ks[13], (DEPTH, D_MODEL), 0.02),
        'dense_w_gate': nrm(ks[14], (N_DENSE_LAYERS, D_MODEL, D_FF_DENSE), D_MODEL ** -0.5),
        'dense_w_up': nrm(ks[15], (N_DENSE_LAYERS, D_MODEL, D_FF_DENSE), D_MODEL ** -0.5),
        'dense_w_down': nrm(ks[16], (N_DENSE_LAYERS, D_FF_DENSE, D_MODEL), DN_BETA * D_FF_DENSE ** -0.5),
        'moe_router': nrm(ks[17], (N_MOE_LAYERS, D_MODEL, N_EXPERTS), D_MODEL ** -0.5),
        'moe_w_gate': nrm(ks[18], (N_MOE_LAYERS, N_EXPERTS, D_MODEL, D_FF_EXPERT), D_MODEL ** -0.5),
        'moe_w_up': nrm(ks[19], (N_MOE_LAYERS, N_EXPERTS, D_MODEL, D_FF_EXPERT), D_MODEL ** -0.5),
        'moe_w_down': nrm(ks[20], (N_MOE_LAYERS, N_EXPERTS, D_FF_EXPERT, D_MODEL), DN_BETA * D_FF_EXPERT ** -0.5),
    }


def reference(x, w_in, nsa_cmp_pe, nsa_cmp_w1, nsa_cmp_w2, fox_f_bias, w_nsa_branch, w_fox_branch,
              w_out, rel_bias, ln1_g, ln1_b, ln2_g, ln2_b, dense_w_gate, dense_w_up, dense_w_down,
              moe_router, moe_w_gate, moe_w_up, moe_w_down):
    for layer in range(DEPTH):
        h = hybrid_mixer(x, w_in[layer], nsa_cmp_pe[layer], nsa_cmp_w1[layer], nsa_cmp_w2[layer],
                         fox_f_bias[layer], w_nsa_branch[layer], w_fox_branch[layer], w_out[layer], rel_bias)
        x = layer_norm(DN_ALPHA * x + h, ln1_g[layer], ln1_b[layer])
        j = layer // 2
        if layer % 2 == 0:
            f = swiglu(x, dense_w_gate[j], dense_w_up[j], dense_w_down[j])
        else:
            f = moe_swiglu(x, moe_router[j], moe_w_gate[j], moe_w_up[j], moe_w_down[j])
        x = layer_norm(DN_ALPHA * x + f, ln2_g[layer], ln2_b[layer])
    return x
```

```cpp
#include <hip/hip_runtime.h>
#include <cstdio>
#include <cstdint>

namespace pg8 {
#define PG8_LAS __attribute__((address_space(3)))
typedef unsigned short bf16_t;
typedef short bf16x8 __attribute__((ext_vector_type(8)));
typedef float f32x4 __attribute__((ext_vector_type(4)));
typedef float f32x2 __attribute__((ext_vector_type(2)));
typedef unsigned u32x4 __attribute__((ext_vector_type(4)));
constexpr int BM = 256, BK = 64, HALF = 128, HTB = HALF * BK * 2, STAGE_BYTES = 8 * HTB, NXCD = 8, WGM = 8;

__host__ __device__ __forceinline__ int lds_byte(int r, int c) { const int st = (r >> 4) * 2 + (c >> 5), rr = r & 15, cc = c & 31, ob = rr * 64 + cc * 2; return st * 1024 + (ob ^ (((ob >> 9) & 1) << 5)); }
__host__ __device__ __forceinline__ void stage_rc(int b, int& R, int& C) { const int st = b / 1024, sb = b % 1024, swz = sb ^ (((sb >> 9) & 1) << 5); R = (st >> 1) * 16 + swz / 64; C = (st & 1) * 32 + (swz % 64) / 2; }
__host__ __device__ __forceinline__ int perm32(int rho) { const int n = rho >> 4, i = rho & 15; return 8 * (i >> 2) + 4 * n + (i & 3); }

struct Unit { int pm, pn, pb; };
struct Gemm { const bf16_t* A; const bf16_t* Bt; int lda, ldb, K; };

struct StaticOrder {
    int nM, nN, nwg, G, c;
    __device__ __forceinline__ void init(int nM_, int nN_, int G_, int c_) { nM = nM_; nN = nN_; nwg = nM * nN; G = G_; c = c_; }
    __device__ __forceinline__ bool next(int i, Unit& u) const {
        const long L = (long)i * G + c; if (L >= nwg) return false;
        int wgid = (int)L; { const int q = nwg / NXCD, r = nwg % NXCD, xcd = wgid % NXCD, off = wgid / NXCD; wgid = (xcd < r ? xcd * (q + 1) : r * (q + 1) + (xcd - r) * q) + off; }
        const int nig = WGM * nN, gid = wgid / nig, fm = gid * WGM, gsz = (nM - fm) < WGM ? (nM - fm) : WGM;
        u.pm = fm + ((wgid % nig) % gsz); u.pn = (wgid % nig) / gsz; u.pb = u.pn; return true;
    }
};
struct MoeOrder {
    StaticOrder so; int t1, t2, t3, t4, t5, t6, t7;
    __device__ __forceinline__ bool next(int i, Unit& u) const {
        if (!so.next(i, u)) return false;
        const int e = (u.pm >= t1) + (u.pm >= t2) + (u.pm >= t3) + (u.pm >= t4) + (u.pm >= t5) + (u.pm >= t6) + (u.pm >= t7);
        u.pb = e * so.nN + u.pn; return true;
    }
};

__device__ __forceinline__ unsigned cvt_pk_bf16(float lo, float hi) { unsigned r; asm volatile("v_cvt_pk_bf16_f32 %0, %1, %2" : "=v"(r) : "v"(lo), "v"(hi)); return r; }

template <class Epi, class Sched, bool ALIGN_EPI, bool SP2>
__device__ __forceinline__ void gemm_phase(PG8_LAS unsigned char* lds, const Gemm g, const Sched& S, const Epi& E) {
    int tid = threadIdx.x; asm volatile("" : "+v"(tid));
    const int wid = __builtin_amdgcn_readfirstlane(tid >> 6), lane = tid & 63, wr = wid >> 2, wc = wid & 3, fr = lane & 15, fq = lane >> 4;
    const int K = g.K, nt = K / BK;
    unsigned voffA[2], voffB[2];
#pragma unroll
    for (int i = 0; i < 2; ++i) { int R, C; stage_rc(tid * 16 + i * 8192, R, C); const int Rb = Epi::PERM ? ((R & ~31) + perm32(R & 31)) : R;
        voffA[i] = (unsigned)(R * g.lda + C) * 2u; voffB[i] = (unsigned)(Rb * g.ldb + C) * 2u; }
    const size_t kstep = (size_t)(BK * 2);
    const size_t hstepA = (size_t)HALF * g.lda * 2, hstepB = (size_t)HALF * g.ldb * 2;
    const size_t tstepA = 2 * hstepA, tstepB = 2 * hstepB;
    const unsigned ldsw = (unsigned)wid * 1024u;
    const int aoff = lds_byte(wr * 64 + fr, fq * 8), boff = lds_byte(wc * 32 + fr, fq * 8);
#define PG8_SA(b, h) (((b) * 2 + (h)) * HTB)
#define PG8_SB(b, h) ((4 + (b) * 2 + (h)) * HTB)
#define PG8_STAGE(bufoff, gbase, voff) do { _Pragma("unroll") for (int _i = 0; _i < 2; ++_i) \
        __builtin_amdgcn_global_load_lds((const unsigned*)((const char*)(gbase) + (voff)[_i]), (PG8_LAS unsigned*)(lds + (bufoff) + ldsw + _i * 8192), 16, 0, 0); } while (0)
#define PG8_LDA(dst, b, h) do { _Pragma("unroll") for (int m = 0; m < 4; ++m) _Pragma("unroll") for (int k = 0; k < 2; ++k) dst[m][k] = *(const PG8_LAS bf16x8*)(lds + PG8_SA(b, h) + aoff + m * 2048 + k * 1024); } while (0)
#define PG8_LDB(dst, b, h) do { _Pragma("unroll") for (int n = 0; n < 2; ++n) _Pragma("unroll") for (int k = 0; k < 2; ++k) dst[n][k] = *(const PG8_LAS bf16x8*)(lds + PG8_SB(b, h) + boff + n * 2048 + k * 1024); } while (0)
#define PG8_MMA(ai, bj, At, Bt) do { __builtin_amdgcn_s_setprio(1); _Pragma("unroll") for (int m = 0; m < 4; ++m) _Pragma("unroll") for (int n = 0; n < 2; ++n) _Pragma("unroll") for (int k = 0; k < 2; ++k) \
        acc[ai][bj][m][n] = __builtin_amdgcn_mfma_f32_16x16x32_bf16(Bt[n][k], At[m][k], acc[ai][bj][m][n], 0, 0, 0); __builtin_amdgcn_s_setprio(0); } while (0)
#define PG8_WAIT_V(n) asm volatile("s_waitcnt vmcnt(" #n ")" ::: "memory")
#define PG8_WAIT_L(n) asm volatile("s_waitcnt lgkmcnt(" #n ")" ::: "memory")
#define PG8_BAR __builtin_amdgcn_s_barrier()
#define PG8_SCHED __builtin_amdgcn_sched_barrier(0)
    Unit cur, nxt; int ui = 0;
    if (!S.next(0, cur)) return;
    f32x4 acc[2][2][4][2];
#pragma unroll
    for (int a = 0; a < 2; ++a)
#pragma unroll
        for (int b = 0; b < 2; ++b)
#pragma unroll
            for (int m = 0; m < 4; ++m)
#pragma unroll
                for (int n = 0; n < 2; ++n) acc[a][b][m][n] = (f32x4){0.f, 0.f, 0.f, 0.f};
    bf16x8 At[4][2], B0[2][2], B1[2][2];
    const char* cA = (const char*)g.A + (size_t)cur.pm * tstepA; const char* cB = (const char*)g.Bt + (size_t)cur.pb * tstepB;
    if constexpr (SP2) {
        PG8_STAGE(PG8_SB(0, 0), cB, voffB); PG8_STAGE(PG8_SB(0, 1), cB + hstepB, voffB); PG8_STAGE(PG8_SA(0, 0), cA, voffA); PG8_STAGE(PG8_SA(0, 1), cA + hstepA, voffA);
        if (wr == 1) PG8_BAR;
        PG8_WAIT_V(2); PG8_BAR;
        PG8_STAGE(PG8_SB(1, 0), cB + kstep, voffB); PG8_STAGE(PG8_SA(1, 0), cA + kstep, voffA); PG8_STAGE(PG8_SB(1, 1), cB + hstepB + kstep, voffB);
        PG8_WAIT_V(6); PG8_BAR;
    } else {
        PG8_STAGE(PG8_SB(0, 0), cB, voffB); PG8_STAGE(PG8_SA(0, 0), cA, voffA); PG8_STAGE(PG8_SB(0, 1), cB + hstepB, voffB); PG8_STAGE(PG8_SA(0, 1), cA + hstepA, voffA);
        if (wr == 1) PG8_BAR;
        PG8_WAIT_V(4); PG8_BAR;
        PG8_STAGE(PG8_SB(1, 0), cB + kstep, voffB); PG8_STAGE(PG8_SA(1, 0), cA + kstep, voffA); PG8_STAGE(PG8_SB(1, 1), cB + hstepB + kstep, voffB);
        PG8_WAIT_V(6); PG8_BAR;
    }
    for (;;) {
        const bool has_next = S.next(ui + 1, nxt);
        const char* nA = has_next ? (const char*)g.A + (size_t)nxt.pm * tstepA : cA; const char* nB = has_next ? (const char*)g.Bt + (size_t)nxt.pb * tstepB : cB;
        for (int t = 0; t < nt; t += 2) {
            const bool last = (t == nt - 2);
            const char* a1 = cA + (size_t)(t + 1) * kstep;
            const char* a2 = last ? nA : cA + (size_t)(t + 2) * kstep; const char* b2 = last ? nB : cB + (size_t)(t + 2) * kstep;
            const char* a3 = a2 + kstep; const char* b3 = b2 + kstep;
            if constexpr (SP2) {
            PG8_LDB(B0, 0, 0); PG8_LDB(B1, 0, 1); PG8_SCHED; PG8_LDA(At, 0, 0); PG8_STAGE(PG8_SA(1, 1), a1 + hstepA, voffA);
            PG8_WAIT_V(8); PG8_WAIT_L(0); PG8_BAR; PG8_MMA(0, 0, At, B0); PG8_MMA(0, 1, At, B1); PG8_BAR; PG8_SCHED;
            PG8_LDA(At, 0, 1); PG8_STAGE(PG8_SB(0, 0), b2, voffB); PG8_STAGE(PG8_SB(0, 1), b2 + hstepB, voffB); PG8_STAGE(PG8_SA(0, 0), a2, voffA);
            PG8_WAIT_V(8); PG8_WAIT_L(0); PG8_BAR; PG8_MMA(1, 0, At, B0); PG8_MMA(1, 1, At, B1); PG8_BAR; PG8_SCHED;
            PG8_LDB(B0, 1, 0); PG8_LDB(B1, 1, 1); PG8_SCHED; PG8_LDA(At, 1, 0); PG8_STAGE(PG8_SA(0, 1), a2 + hstepA, voffA);
            PG8_WAIT_V(8); PG8_WAIT_L(0); PG8_BAR; PG8_MMA(0, 0, At, B0); PG8_MMA(0, 1, At, B1); PG8_BAR; PG8_SCHED;
            PG8_LDA(At, 1, 1); PG8_STAGE(PG8_SB(1, 0), b3, voffB); PG8_STAGE(PG8_SB(1, 1), b3 + hstepB, voffB); PG8_STAGE(PG8_SA(1, 0), a3, voffA);
            PG8_WAIT_V(8); PG8_WAIT_L(0); PG8_BAR; PG8_MMA(1, 0, At, B0); PG8_MMA(1, 1, At, B1); PG8_BAR; PG8_SCHED;
            } else {
            PG8_LDB(B0, 0, 0); PG8_SCHED; PG8_LDA(At, 0, 0); PG8_STAGE(PG8_SA(1, 1), a1 + hstepA, voffA);
            PG8_WAIT_L(8); PG8_BAR; PG8_WAIT_L(0); PG8_MMA(0, 0, At, B0); PG8_BAR; PG8_SCHED;
            PG8_LDB(B1, 0, 1); PG8_STAGE(PG8_SB(0, 0), b2, voffB);
            PG8_BAR; PG8_WAIT_L(0); PG8_MMA(0, 1, At, B1); PG8_BAR;
            PG8_LDA(At, 0, 1); PG8_STAGE(PG8_SA(0, 0), a2, voffA);
            PG8_BAR; PG8_WAIT_L(0); PG8_MMA(1, 0, At, B0); PG8_BAR; PG8_SCHED;
            PG8_STAGE(PG8_SB(0, 1), b2 + hstepB, voffB);
            PG8_WAIT_V(6); PG8_BAR; PG8_MMA(1, 1, At, B1); PG8_BAR;
            PG8_LDB(B0, 1, 0); PG8_SCHED; PG8_LDA(At, 1, 0); PG8_STAGE(PG8_SA(0, 1), a2 + hstepA, voffA);
            PG8_WAIT_L(8); PG8_BAR; PG8_WAIT_L(0); PG8_MMA(0, 0, At, B0); PG8_BAR; PG8_SCHED;
            PG8_LDB(B1, 1, 1); PG8_STAGE(PG8_SB(1, 0), b3, voffB);
            PG8_BAR; PG8_WAIT_L(0); PG8_MMA(0, 1, At, B1); PG8_BAR;
            PG8_LDA(At, 1, 1); PG8_STAGE(PG8_SA(1, 0), a3, voffA);
            PG8_BAR; PG8_WAIT_L(0); PG8_MMA(1, 0, At, B0); PG8_BAR; PG8_SCHED;
            PG8_STAGE(PG8_SB(1, 1), b3 + hstepB, voffB);
            PG8_WAIT_V(6); PG8_BAR; PG8_MMA(1, 1, At, B1); PG8_BAR;
            }
        }
        if constexpr (ALIGN_EPI) { if (wr == 0) PG8_BAR; }
        E(acc, cur, wr, wc, fr, fq);
        if (!has_next) break;
#pragma unroll
        for (int a = 0; a < 2; ++a)
#pragma unroll
            for (int b = 0; b < 2; ++b)
#pragma unroll
                for (int m = 0; m < 4; ++m)
#pragma unroll
                    for (int n = 0; n < 2; ++n) acc[a][b][m][n] = (f32x4){0.f, 0.f, 0.f, 0.f};
        cur = nxt; cA = nA; cB = nB; ++ui;
        if constexpr (ALIGN_EPI) { if (wr == 1) PG8_BAR; }
    }
    PG8_WAIT_V(0);
    if constexpr (!ALIGN_EPI) { if (wr == 0) PG8_BAR; }
    PG8_BAR;
#undef PG8_SA
#undef PG8_SB
#undef PG8_STAGE
#undef PG8_LDA
#undef PG8_LDB
#undef PG8_MMA
#undef PG8_WAIT_V
#undef PG8_WAIT_L
#undef PG8_BAR
#undef PG8_SCHED
}
}

constexpr int NWAVES = 8;
constexpr int BATCH = 8, SEQ = 2048, DM = 1024, DEPTH = 4, M = BATCH * SEQ;
constexpr int HD = 64, NSA_H = 8, NSA_KVH = 2, NSA_G = 4, FOX_H = 8;
constexpr int N_CMP = 127, CMP_HID = 128;
constexpr int D_IN = 4896, NPROJ = 5120;
constexpr int FF_D = 2816, FF_E = 3584, NEXP = 8;
constexpr int XG_ROWS = 34816;
constexpr float LN_EPS = 1e-5f, DN_ALPHA = 1.681792830507429f, LOG2E = 1.4426950408889634f;
constexpr int PC_Q = 0, PC_KV = 512, PC_FOX = 1280, PC_MG = 2816, PC_MISC = 4864;
constexpr int SC_Q = 0, SC_KV = 512, SC_NG = 1280, SC_FOX = 1304, SC_FF = 2840, SC_MG = 2848;

constexpr size_t MiB = 1u << 20;
constexpr size_t WS_CTL = 0, CTL_ZERO_BYTES = 1 * MiB;
constexpr size_t WS_CBP = 1 * MiB;
constexpr size_t WS_NG = 2 * MiB;
constexpr size_t WS_LF = 4 * MiB;
constexpr size_t WS_NF2 = 4 * MiB + 512 * 1024;
constexpr size_t WS_KCC = 5 * MiB;
constexpr size_t WS_VCC = 5 * MiB + 256 * 1024;
constexpr size_t WS_TOKE = 5 * MiB + 512 * 1024;
constexpr size_t WS_TOKW = WS_TOKE + 128 * 1024;
constexpr size_t WS_TOKP = WS_TOKW + 128 * 1024;
constexpr size_t WS_TOKS = WS_TOKP + 128 * 1024;
constexpr size_t WS_WIN = 8 * MiB;
constexpr size_t WS_WC1 = 48 * MiB;
constexpr size_t WS_WNSA = 52 * MiB;
constexpr size_t WS_WFOX = 56 * MiB;
constexpr size_t WS_WO = 60 * MiB;
constexpr size_t WS_WDGU = 68 * MiB;
constexpr size_t WS_WDD = 90 * MiB;
constexpr size_t WS_WMGU = 102 * MiB;
constexpr size_t WS_WMD = 326 * MiB;
constexpr size_t WS_XB = 438 * MiB;
constexpr size_t WS_PRE = 470 * MiB;
constexpr size_t WS_XG = 534 * MiB;
constexpr size_t WS_HID = 602 * MiB;
constexpr size_t WS_QN = 602 * MiB;
constexpr size_t WS_KV6 = 618 * MiB;
constexpr size_t WS_FQKV = 642 * MiB;
constexpr size_t WS_MG = 690 * MiB;
constexpr size_t WS_YN = 754 * MiB;
constexpr size_t WS_YF = 770 * MiB;
constexpr size_t WS_MERGED = 786 * MiB;
constexpr size_t WS_END = 840 * MiB;
static_assert(WS_HID + (size_t)XG_ROWS * FF_E * 2 <= WS_END && WS_MERGED + (size_t)M * DM * 2 <= WS_END, "ws map");
constexpr int CW_BAR = 4096;
constexpr int CW_MOECNT = 16384;

constexpr int RING_BYTES = 131072;
constexpr int LDSCTL_OFF = RING_BYTES, MISC_OFF = LDSCTL_OFF + 320;
constexpr int LDS_BYTES = 147456;

#define GAS __attribute__((address_space(1)))
#define LAS __attribute__((address_space(3)))
typedef unsigned short bf16;
typedef unsigned v4u __attribute__((ext_vector_type(4)));
typedef unsigned v2u __attribute__((ext_vector_type(2)));
typedef float f32x4 __attribute__((ext_vector_type(4)));
typedef float f32x16 __attribute__((ext_vector_type(16)));
typedef short bf16x8 __attribute__((ext_vector_type(8)));
#define LDS_WAIT() asm volatile("s_waitcnt lgkmcnt(0)" ::: "memory")
#define VM_WAIT() asm volatile("s_waitcnt vmcnt(0)" ::: "memory")
__device__ __forceinline__ unsigned f2bf(float f) { unsigned u = __builtin_bit_cast(unsigned, f); return (u + 0x7fffu + ((u >> 16) & 1u)) >> 16; }
__device__ __forceinline__ unsigned pk2(float lo, float hi) { return f2bf(lo) | (f2bf(hi) << 16); }
__device__ __forceinline__ float bf2f(unsigned v) { return __builtin_bit_cast(float, v << 16); }
__device__ __forceinline__ float bflo(unsigned w) { return __builtin_bit_cast(float, w << 16); }
__device__ __forceinline__ float bfhi(unsigned w) { return __builtin_bit_cast(float, w & 0xffff0000u); }
__device__ __forceinline__ float sigmoidf_(float x) { return 1.f / (1.f + __expf(-x)); }
__device__ __forceinline__ float wave_sum(float v) {
#pragma unroll
    for (int o = 1; o < 64; o <<= 1) v += __shfl_xor(v, o);
    return v;
}
__device__ __forceinline__ float wave_max(float v) {
#pragma unroll
    for (int o = 1; o < 64; o <<= 1) v = fmaxf(v, __shfl_xor(v, o));
    return v;
}
__constant__ unsigned char T5LUT[128] = {0, 1, 2, 3, 4, 5, 6, 7, 8, 9, 10, 11, 12, 13, 14, 15, 16, 16, 16, 17, 17, 18, 18, 18, 19, 19, 19, 20, 20, 20, 20, 21, 21, 21, 21, 22, 22, 22, 22, 22, 23, 23, 23, 23, 23, 23, 24, 24, 24, 24, 24, 24, 25, 25, 25, 25, 25, 25, 25, 26, 26, 26, 26, 26, 26, 26, 26, 27, 27, 27, 27, 27, 27, 27, 27, 27, 27, 28, 28, 28, 28, 28, 28, 28, 28, 28, 28, 29, 29, 29, 29, 29, 29, 29, 29, 29, 29, 29, 29, 30, 30, 30, 30, 30, 30, 30, 30, 30, 30, 30, 30, 30, 30, 31, 31, 31, 31, 31, 31, 31, 31, 31, 31, 31, 31, 31, 31, 31};
__device__ __forceinline__ int t5b(int n) { return n < 128 ? (int)T5LUT[n] : 31; }

#define XB_TMO      128
#define XB_XCNT(j)  (256  + 64 * (j))
#define XB_XSUB(j)  (1280 + 64 * (j))
#define XB_XGEN(j)  (2304 + 64 * (j))
#define XB_TOP      3328
#define XB_TOPGEN   3392
#define XCD_BAR_WORDS 3456
#define XB_SPIN_CAP (1u << 18)

__device__ __forceinline__ unsigned xb_ld(unsigned* p)              { return __hip_atomic_load(p, __ATOMIC_RELAXED, __HIP_MEMORY_SCOPE_AGENT); }
__device__ __forceinline__ unsigned xb_add(unsigned* p, unsigned v) { return __hip_atomic_fetch_add(p, v, __ATOMIC_RELAXED, __HIP_MEMORY_SCOPE_AGENT); }
__device__ __forceinline__ unsigned xb_xcc_id() { return (unsigned)__builtin_amdgcn_s_getreg((3 << 11) | 20) & 0xFu; }
#define XB_SPIN(cond, bar) do { unsigned _sp = 0; while (cond) { __builtin_amdgcn_s_sleep(1); \
    if ((++_sp & 255u) == 0u) { if (xb_ld(&(bar)[XB_TMO])) break; if (_sp > XB_SPIN_CAP) { atomicAdd(&(bar)[XB_TMO], 1u); break; } } } } while (0)

struct XcdBarrier {
    unsigned* bar; unsigned x;
    volatile LAS unsigned* st;
};

__device__ __forceinline__ XcdBarrier xcd_barrier_post(unsigned* bar, volatile LAS unsigned* st) {
    XcdBarrier b; b.bar = bar; b.x = xb_xcc_id(); b.st = st;
    if (threadIdx.x == 0) (void)xb_add(&bar[XB_XCNT(b.x)], 1u);
    return b;
}
__device__ __forceinline__ void xcd_barrier_complete(unsigned* bar, unsigned x, unsigned& nloc, unsigned& nx) {
    const unsigned G = gridDim.x * gridDim.y * gridDim.z;
    unsigned sum, cnt, mine, sp = 0u;
    for (;;) {
        sum = 0u; cnt = 0u; mine = 0u;
#pragma unroll
        for (unsigned j = 0; j < 16; ++j) { const unsigned c = xb_ld(&bar[XB_XCNT(j)]); sum += c; cnt += (c > 0u) ? 1u : 0u; mine = (j == x) ? c : mine; }
        if (sum == G) break;
        __builtin_amdgcn_s_sleep(1);
        if ((++sp & 255u) == 0u) { if (xb_ld(&bar[XB_TMO])) break; if (sp > XB_SPIN_CAP) { atomicAdd(&bar[XB_TMO], 1u); break; } }
    }
    nloc = mine > 0u ? mine : 1u; nx = cnt > 0u ? cnt : 1u;
}

__device__ __forceinline__ void xcd_barrier(const XcdBarrier& b) {
    asm volatile("s_waitcnt vmcnt(0)" ::: "memory");
    __syncthreads();
    if (threadIdx.x == 0) {
        unsigned* bar = b.bar;
        __builtin_amdgcn_s_waitcnt(0);
        unsigned nloc = b.st[0], nx = b.st[1];
        if (nloc == 0u) { xcd_barrier_complete(bar, b.x, nloc, nx); b.st[0] = nloc; b.st[1] = nx; }
        const unsigned old = xb_add(&bar[XB_XSUB(b.x)], 1u);
        const unsigned gen = old / nloc;
        if (old + 1u == (gen + 1u) * nloc) {
            __builtin_amdgcn_fence(__ATOMIC_RELEASE, "agent");
            asm volatile("s_waitcnt vmcnt(0)" ::: "memory");
            const unsigned og = xb_add(&bar[XB_TOP], 1u);
            const unsigned tg = og / nx;
            if (og + 1u == (tg + 1u) * nx) xb_add(&bar[XB_TOPGEN], 1u);
            else XB_SPIN(xb_ld(&bar[XB_TOPGEN]) == tg, bar);
            __builtin_amdgcn_fence(__ATOMIC_ACQUIRE, "agent");
            xb_add(&bar[XB_XGEN(b.x)], 1u);
            asm volatile("s_waitcnt vmcnt(0)" ::: "memory");
        } else {
            XB_SPIN(xb_ld(&bar[XB_XGEN(b.x)]) == gen, bar);
            __builtin_amdgcn_fence(__ATOMIC_ACQUIRE, "agent");
            asm volatile("s_waitcnt vmcnt(0)" ::: "memory");
        }
    }
    __syncthreads();
}

using pg8::Unit; using pg8::cvt_pk_bf16;
typedef const f32x4 (&AccRef)[2][2][4][2];

struct EpiInProj {
    static constexpr bool PERM = true;
    unsigned char* ws; const float* fbias;
    __device__ __forceinline__ void operator()(AccRef acc, const Unit& u, int wr, int wc, int fr, int fq) const {
        const int row0 = u.pm * 256 + wr * 64 + fr;
#pragma unroll
        for (int bj = 0; bj < 2; ++bj) {
            const int cw = u.pn * 256 + bj * 128 + wc * 32;
            const int c = cw + 8 * fq;
            if (cw < PC_MG) {
                bf16* base; int nh, head; float sc = 1.f;
                if (cw < PC_KV) { base = (bf16*)(ws + WS_QN); nh = 8; head = c >> 6; sc = 0.125f; }
                else if (cw < PC_FOX) { const int cc = c - PC_KV; base = (bf16*)(ws + WS_KV6) + (size_t)(cc >> 7) * ((size_t)M * 128); nh = 2; head = (cc >> 6) & 1; }
                else { const int cc = c - PC_FOX; const int which = cc >> 9; base = (bf16*)(ws + WS_FQKV) + (size_t)which * ((size_t)M * 512); nh = 8; head = (cc >> 6) & 7; sc = (which == 0) ? 0.125f : 1.f; }
                const int d = c & 63;
#pragma unroll
                for (int ai = 0; ai < 2; ++ai)
#pragma unroll
                    for (int m = 0; m < 4; ++m) {
                        const int row = row0 + ai * 128 + m * 16, b = row >> 11, s = row & 2047;
                        const f32x4 v0 = acc[ai][bj][m][0] * sc, v1 = acc[ai][bj][m][1] * sc;
                        v4u w; w.x = cvt_pk_bf16(v0[0], v0[1]); w.y = cvt_pk_bf16(v0[2], v0[3]); w.z = cvt_pk_bf16(v1[0], v1[1]); w.w = cvt_pk_bf16(v1[2], v1[3]);
                        *(v4u*)(base + ((size_t)(b * nh + head) * SEQ + s) * 64 + d) = w;
                    }
            } else if (cw < PC_MISC) {
                bf16* mg = (bf16*)(ws + WS_MG);
#pragma unroll
                for (int ai = 0; ai < 2; ++ai)
#pragma unroll
                    for (int m = 0; m < 4; ++m) {
                        const int row = row0 + ai * 128 + m * 16;
                        const f32x4 a = acc[ai][bj][m][0], bq = acc[ai][bj][m][1];
                        v4u w; w.x = cvt_pk_bf16(sigmoidf_(a[0]), sigmoidf_(a[1])); w.y = cvt_pk_bf16(sigmoidf_(a[2]), sigmoidf_(a[3]));
                        w.z = cvt_pk_bf16(sigmoidf_(bq[0]), sigmoidf_(bq[1])); w.w = cvt_pk_bf16(sigmoidf_(bq[2]), sigmoidf_(bq[3]));
                        *(v4u*)(mg + (size_t)row * 2048 + (c - PC_MG)) = w;
                    }
            } else if (cw == PC_MISC) {
                float* ng = (float*)(ws + WS_NG); float* lf = (float*)(ws + WS_LF);
#pragma unroll
                for (int ai = 0; ai < 2; ++ai)
#pragma unroll
                    for (int m = 0; m < 4; ++m) {
                        const int row = row0 + ai * 128 + m * 16;
                        const f32x4 a = acc[ai][bj][m][0], bq = acc[ai][bj][m][1];
                        if (fq < 3) {
                            float* o = ng + (size_t)row * 24 + 8 * fq;
                            *(f32x4*)o = (f32x4){sigmoidf_(a[0]), sigmoidf_(a[1]), sigmoidf_(a[2]), sigmoidf_(a[3])};
                            *(f32x4*)(o + 4) = (f32x4){sigmoidf_(bq[0]), sigmoidf_(bq[1]), sigmoidf_(bq[2]), sigmoidf_(bq[3])};
                        } else {
                            float* o = lf + (size_t)row * 8; float r[8];
#pragma unroll
                            for (int i = 0; i < 8; ++i) { const float x = (i < 4 ? a[i & 3] : bq[i & 3]) + fbias[i]; r[i] = fminf(x, 0.f) - log1pf(__expf(-fabsf(x))); }
                            *(f32x4*)o = (f32x4){r[0], r[1], r[2], r[3]}; *(f32x4*)(o + 4) = (f32x4){r[4], r[5], r[6], r[7]};
                        }
                    }
            }
        }
    }
};

template <bool ADD> struct EpiBranch {
    static constexpr bool PERM = true;
    const bf16* mg; bf16* out; int goff;
    __device__ __forceinline__ void operator()(AccRef acc, const Unit& u, int wr, int wc, int fr, int fq) const {
        const int row0 = u.pm * 256 + wr * 64 + fr, col0 = u.pn * 256 + wc * 32 + 8 * fq;
#pragma unroll
        for (int ai = 0; ai < 2; ++ai)
#pragma unroll
            for (int m = 0; m < 4; ++m) {
                const int row = row0 + ai * 128 + m * 16;
#pragma unroll
                for (int bj = 0; bj < 2; ++bj) {
                    const int c = col0 + bj * 128;
                    const v4u g = *(const v4u*)(mg + (size_t)row * 2048 + goff + c);
                    const f32x4 a = acc[ai][bj][m][0], bq = acc[ai][bj][m][1];
                    float r[8] = {bflo(g.x) * a[0], bfhi(g.x) * a[1], bflo(g.y) * a[2], bfhi(g.y) * a[3], bflo(g.z) * bq[0], bfhi(g.z) * bq[1], bflo(g.w) * bq[2], bfhi(g.w) * bq[3]};
                    if (ADD) { const v4u p = *(const v4u*)(out + (size_t)row * DM + c);
                        r[0] += bflo(p.x); r[1] += bfhi(p.x); r[2] += bflo(p.y); r[3] += bfhi(p.y); r[4] += bflo(p.z); r[5] += bfhi(p.z); r[6] += bflo(p.w); r[7] += bfhi(p.w); }
                    v4u w; w.x = cvt_pk_bf16(r[0], r[1]); w.y = cvt_pk_bf16(r[2], r[3]); w.z = cvt_pk_bf16(r[4], r[5]); w.w = cvt_pk_bf16(r[6], r[7]);
                    *(v4u*)(out + (size_t)row * DM + c) = w;
                }
            }
    }
};

struct EpiResF32 {
    static constexpr bool PERM = false;
    const float* xres; float* pre;
    __device__ __forceinline__ void operator()(AccRef acc, const Unit& u, int wr, int wc, int fr, int fq) const {
        const int row0 = u.pm * 256 + wr * 64 + fr, col0 = u.pn * 256 + wc * 32 + 4 * fq;
#pragma unroll
        for (int ai = 0; ai < 2; ++ai)
#pragma unroll
            for (int m = 0; m < 4; ++m) {
                const size_t off = (size_t)(row0 + ai * 128 + m * 16) * DM + col0;
#pragma unroll
                for (int bj = 0; bj < 2; ++bj)
#pragma unroll
                    for (int n = 0; n < 2; ++n) { const f32x4 x = *(const f32x4*)(xres + off + bj * 128 + n * 16); *(f32x4*)(pre + off + bj * 128 + n * 16) = x * DN_ALPHA + acc[ai][bj][m][n]; }
            }
    }
};

struct EpiSwiGLU {
    static constexpr bool PERM = true;
    bf16* hid; int ldh;
    __device__ __forceinline__ void operator()(AccRef acc, const Unit& u, int wr, int wc, int fr, int fq) const {
        const int row0 = u.pm * 256 + wr * 64 + fr, col0 = u.pn * 128 + wc * 32 + 8 * fq;
#pragma unroll
        for (int ai = 0; ai < 2; ++ai)
#pragma unroll
            for (int m = 0; m < 4; ++m) {
                float r[8];
#pragma unroll
                for (int n = 0; n < 2; ++n)
#pragma unroll
                    for (int i = 0; i < 4; ++i) { const float g = acc[ai][0][m][n][i], up = acc[ai][1][m][n][i]; r[n * 4 + i] = g * sigmoidf_(g) * up; }
                v4u w; w.x = cvt_pk_bf16(r[0], r[1]); w.y = cvt_pk_bf16(r[2], r[3]); w.z = cvt_pk_bf16(r[4], r[5]); w.w = cvt_pk_bf16(r[6], r[7]);
                *(v4u*)(hid + (size_t)(row0 + ai * 128 + m * 16) * ldh + col0) = w;
            }
    }
};

struct EpiPlainBf16 {
    static constexpr bool PERM = true;
    bf16* out;
    __device__ __forceinline__ void operator()(AccRef acc, const Unit& u, int wr, int wc, int fr, int fq) const {
        const int row0 = u.pm * 256 + wr * 64 + fr, col0 = u.pn * 256 + wc * 32 + 8 * fq;
#pragma unroll
        for (int ai = 0; ai < 2; ++ai)
#pragma unroll
            for (int m = 0; m < 4; ++m)
#pragma unroll
                for (int bj = 0; bj < 2; ++bj) {
                    const f32x4 a = acc[ai][bj][m][0], bq = acc[ai][bj][m][1];
                    v4u w; w.x = cvt_pk_bf16(a[0], a[1]); w.y = cvt_pk_bf16(a[2], a[3]); w.z = cvt_pk_bf16(bq[0], bq[1]); w.w = cvt_pk_bf16(bq[2], bq[3]);
                    *(v4u*)(out + (size_t)(row0 + ai * 128 + m * 16) * DM + col0 + bj * 128) = w;
                }
    }
};

struct Args { const float* in[21]; float* out; unsigned char* ws; int ph_lo, ph_hi; };
struct Frame { LAS unsigned char* lds; int vcu, G; };
typedef __attribute__((address_space(4))) const Args CArgs;
__device__ __forceinline__ const CArgs* kargs() { const CArgs* p = (const CArgs*)__builtin_amdgcn_kernarg_segment_ptr(); asm volatile("" : "+s"(p)); return p; }
#define PHASE_IDS() int tid = threadIdx.x; asm volatile("" : "+v"(tid)); const int lane = tid & 63; const int wave = __builtin_amdgcn_readfirstlane(tid >> 6); (void)lane; (void)wave
enum { I_X = 0, I_WIN, I_PE, I_W1, I_W2, I_FB, I_WNSA, I_WFOX, I_WOUT, I_REL, I_LN1G, I_LN1B, I_LN2G, I_LN2B, I_DG, I_DU, I_DD, I_ROUT, I_MG, I_MU, I_MD };

struct SegDesc { const float* W; bf16* dst; int ldw, ncols, K, mode, roff; };
__device__ __forceinline__ SegDesc seg_desc(int s, const CArgs* a) {
    SegDesc d; unsigned char* ws = a->ws;
    if (s < 44) {
        const int L = s / 11, q = s % 11;
        if (q < 6) {
            const int sc[6] = {SC_Q, SC_KV, SC_FOX, SC_MG, SC_NG, SC_FF}, nc[6] = {512, 768, 1536, 2048, 24, 8}, ro[6] = {PC_Q, PC_KV, PC_FOX, PC_MG, PC_MISC, PC_MISC + 24};
            int scq = sc[0], ncq = nc[0], roq = ro[0];
#pragma unroll
            for (int i = 1; i < 6; ++i) if (q == i) { scq = sc[i]; ncq = nc[i]; roq = ro[i]; }
            d.W = a->in[I_WIN] + (size_t)L * DM * D_IN + scq; d.ldw = D_IN; d.ncols = ncq; d.K = DM; d.dst = (bf16*)(ws + WS_WIN) + (size_t)L * NPROJ * DM; d.mode = 0; d.roff = roq;
        } else if (q == 6) { d.W = a->in[I_WNSA] + (size_t)L * 512 * DM; d.ldw = DM; d.ncols = DM; d.K = 512; d.dst = (bf16*)(ws + WS_WNSA) + (size_t)L * DM * 512; d.mode = 0; d.roff = 0; }
        else if (q == 7) { d.W = a->in[I_WFOX] + (size_t)L * 512 * DM; d.ldw = DM; d.ncols = DM; d.K = 512; d.dst = (bf16*)(ws + WS_WFOX) + (size_t)L * DM * 512; d.mode = 0; d.roff = 0; }
        else if (q == 8) { d.W = a->in[I_WOUT] + (size_t)L * DM * DM; d.ldw = DM; d.ncols = DM; d.K = DM; d.dst = (bf16*)(ws + WS_WO) + (size_t)L * DM * DM; d.mode = 0; d.roff = 0; }
        else { const int kv = q - 9; d.W = a->in[I_W1] + (size_t)(L * 2 + kv) * 2048 * 128; d.ldw = 128; d.ncols = 128; d.K = 2048; d.dst = (bf16*)(ws + WS_WC1) + (size_t)(L * 2 + kv) * 128 * 2048; d.mode = 0; d.roff = 0; }
    } else if (s < 50) {
        const int j = (s - 44) / 3, q = (s - 44) % 3;
        if (q < 2) { d.W = a->in[q == 0 ? I_DG : I_DU] + (size_t)j * DM * FF_D; d.ldw = FF_D; d.ncols = FF_D; d.K = DM; d.dst = (bf16*)(ws + WS_WDGU) + (size_t)j * 2 * FF_D * DM; d.mode = 1; d.roff = q * 128; }
        else { d.W = a->in[I_DD] + (size_t)j * FF_D * DM; d.ldw = DM; d.ncols = DM; d.K = FF_D; d.dst = (bf16*)(ws + WS_WDD) + (size_t)j * DM * FF_D; d.mode = 0; d.roff = 0; }
    } else {
        const int je = (s - 50) / 3, q = (s - 50) % 3;
        if (q < 2) { d.W = a->in[q == 0 ? I_MG : I_MU] + (size_t)je * DM * FF_E; d.ldw = FF_E; d.ncols = FF_E; d.K = DM; d.dst = (bf16*)(ws + WS_WMGU) + (size_t)je * 2 * FF_E * DM; d.mode = 1; d.roff = q * 128; }
        else { d.W = a->in[I_MD] + (size_t)je * FF_E * DM; d.ldw = DM; d.ncols = DM; d.K = FF_E; d.dst = (bf16*)(ws + WS_WMD) + (size_t)je * DM * FF_E; d.mode = 0; d.roff = 0; }
    }
    return d;
}
constexpr int NSEG = 98;

__device__ __forceinline__ void p0_prologue(const Frame& F) {
    PHASE_IDS(); const CArgs* a = kargs();
    LAS float* scr = (LAS float*)(F.lds + wave * 16384);
    const int gw = F.vcu * NWAVES + wave, NGW = F.G * NWAVES;
    int base = 0;
    for (int s = 0; s < NSEG; ++s) {
        const SegDesc d = seg_desc(s, a);
        const int nblk = (d.ncols + 31) >> 5, n_items = (d.K >> 6) * nblk;
        int start = gw - (base % NGW); if (start < 0) start += NGW;
        for (int it = start; it < n_items; it += NGW) {
            const int kb = it / nblk, nb = it % nblk, k0 = 64 * kb, n0 = 32 * nb;
            const int nn = n0 + (lane & 31); const bool okn = nn < d.ncols;
#pragma unroll 8
            for (int i = 0; i < 32; ++i) { const int kk = 2 * i + (lane >> 5); scr[kk * 33 + (lane & 31)] = okn ? d.W[(size_t)(k0 + kk) * d.ldw + nn] : 0.f; }
            LDS_WAIT(); asm volatile("" ::: "memory");
            const int c = lane & 7;
            const int rbase = d.mode ? (d.roff + ((n0 >> 7) << 8) + (n0 & 127)) : (d.roff + n0);
#pragma unroll
            for (int j = 0; j < 4; ++j) { const int n = (lane >> 3) + 8 * j; const LAS float* sp = scr + (8 * c) * 33 + n;
                v4u o; o.x = pk2(sp[0 * 33], sp[1 * 33]); o.y = pk2(sp[2 * 33], sp[3 * 33]); o.z = pk2(sp[4 * 33], sp[5 * 33]); o.w = pk2(sp[6 * 33], sp[7 * 33]);
                if (n0 + n < d.ncols) *(GAS v4u*)(d.dst + (size_t)(rbase + n) * d.K + k0 + 8 * c) = o; }
            LDS_WAIT(); asm volatile("" ::: "memory");
        }
        base += n_items;
    }
    {
        constexpr int PADROWS = NPROJ - (PC_MISC + 32), V16_PER_L = PADROWS * DM * 2 / 16;
        const int gt = gw * 64 + lane, NGT = NGW * 64;
        for (int i = gt; i < DEPTH * V16_PER_L; i += NGT) { const int L = i / V16_PER_L, r = i % V16_PER_L;
            *((GAS v4u*)((bf16*)(a->ws + WS_WIN) + ((size_t)L * NPROJ + PC_MISC + 32) * DM) + r) = (v4u){0u, 0u, 0u, 0u}; }
        const float* x = a->in[I_X]; bf16* xb = (bf16*)(a->ws + WS_XB);
        for (int i = gt; i < M * DM / 8; i += NGT) { const f32x4 p = *((const GAS f32x4*)x + 2 * (size_t)i), q = *((const GAS f32x4*)x + 2 * (size_t)i + 1);
            v4u o; o.x = pk2(p[0], p[1]); o.y = pk2(p[2], p[3]); o.z = pk2(q[0], q[1]); o.w = pk2(q[2], q[3]); *((GAS v4u*)xb + i) = o; }
    }
    if (gw < 256) {
        const int lk = gw >> 5, sl = gw & 31;
        const float* pe = a->in[I_PE] + (size_t)lk * 2048 + sl * 64; const float* w1 = a->in[I_W1] + ((size_t)lk * 2048 + sl * 64) * 128;
        float a0 = 0.f, a1 = 0.f;
        for (int k = 0; k < 64; ++k) { const float p = pe[k]; a0 += p * w1[k * 128 + lane]; a1 += p * w1[k * 128 + 64 + lane]; }
        float* cbp = (float*)(a->ws + WS_CBP) + (size_t)gw * 128; cbp[lane] = a0; cbp[64 + lane] = a1;
    }
}

__device__ __forceinline__ float gelu_tanh(float x) { const float u = 0.7978845608028654f * (x + 0.044715f * x * x * x); return 0.5f * x * (1.f + tanhf(u)); }

__device__ __forceinline__ void p2_cmp_scan(const Frame& F, int L) {
    PHASE_IDS(); const CArgs* a = kargs(); unsigned char* ws = a->ws;
    LAS float* H = (LAS float*)F.lds;
    const int sub = tid >> 7, n = tid & 127;
    for (int it = blockIdx.x; it < 1024; it += F.G) {
        const int U = it * 4 + sub, kv = U >> 11, bh = (U >> 7) & 15, i = U & 127;
        float acc = 0.f;
        if (i < N_CMP) {
            const bf16* A = (const bf16*)(ws + WS_KV6) + (size_t)kv * ((size_t)M * 128) + ((size_t)bh * SEQ + 16 * i) * 64;
            const bf16* W = (const bf16*)(ws + WS_WC1) + ((size_t)(L * 2 + kv) * 128 + n) * 2048;
            for (int k = 0; k < 2048; k += 8) { const v4u av = *(const GAS v4u*)(A + k), wv = *(const GAS v4u*)(W + k);
                acc += bflo(av.x) * bflo(wv.x) + bfhi(av.x) * bfhi(wv.x) + bflo(av.y) * bflo(wv.y) + bfhi(av.y) * bfhi(wv.y)
                     + bflo(av.z) * bflo(wv.z) + bfhi(av.z) * bfhi(wv.z) + bflo(av.w) * bflo(wv.w) + bfhi(av.w) * bfhi(wv.w); }
            const float* cbp = (const float*)(ws + WS_CBP) + (size_t)(L * 2 + kv) * 32 * 128 + n; float cb = 0.f;
            for (int s = 0; s < 32; ++s) cb += cbp[s * 128];
            acc = gelu_tanh(acc + cb);
        }
        H[sub * 128 + n] = acc;
        __syncthreads();
        if (n < 64) {
            const float* w2 = a->in[I_W2] + (size_t)(L * 2 + kv) * 128 * 64 + n; float o = 0.f;
            for (int j = 0; j < 128; ++j) o += H[sub * 128 + j] * w2[j * 64];
            bf16* dst = (bf16*)(ws + (kv ? WS_VCC : WS_KCC)) + ((size_t)bh * 128 + i) * 64 + n;
            *dst = (bf16)f2bf(i < N_CMP ? o : 0.f);
        }
        __syncthreads();
    }
    const int gw = F.vcu * NWAVES + wave;
    if (gw < BATCH * FOX_H) {
        const int b = gw >> 3, h = gw & 7;
        const float* lf = (const float*)(ws + WS_LF) + ((size_t)b * SEQ + 32 * lane) * 8 + h;
        float loc = 0.f;
        for (int i = 0; i < 32; ++i) loc += lf[i * 8];
        float inc = loc;
#pragma unroll
        for (int o = 1; o < 64; o <<= 1) { const float t = __shfl_up(inc, o); if (lane >= o) inc += t; }
        float run = inc - loc;
        float* out = (float*)(ws + WS_NF2) + (size_t)gw * SEQ + 32 * lane;
        for (int i = 0; i < 32; ++i) { run += lf[i * 8]; out[i] = -run * LOG2E; }
    }
}

__device__ __forceinline__ void load_q64(const bf16* q, float (&qf)[64]) {
#pragma unroll
    for (int i = 0; i < 8; ++i) { const v4u v = *(const GAS v4u*)(q + 8 * i);
        qf[8 * i + 0] = bflo(v.x); qf[8 * i + 1] = bfhi(v.x); qf[8 * i + 2] = bflo(v.y); qf[8 * i + 3] = bfhi(v.y); qf[8 * i + 4] = bflo(v.z); qf[8 * i + 5] = bfhi(v.z); qf[8 * i + 6] = bflo(v.w); qf[8 * i + 7] = bfhi(v.w); }
}
__device__ __forceinline__ float dot64(const float (&qf)[64], const bf16* k) {
    float acc = 0.f;
#pragma unroll
    for (int i = 0; i < 8; ++i) { const v4u v = *(const GAS v4u*)(k + 8 * i);
        acc += qf[8 * i + 0] * bflo(v.x) + qf[8 * i + 1] * bfhi(v.x) + qf[8 * i + 2] * bflo(v.y) + qf[8 * i + 3] * bfhi(v.y) + qf[8 * i + 4] * bflo(v.z) + qf[8 * i + 5] * bfhi(v.z) + qf[8 * i + 6] * bflo(v.w) + qf[8 * i + 7] * bfhi(v.w); }
    return acc;
}
__device__ __forceinline__ void softmax_lds(LAS float* sc, int n, int lane, float mxl) {
    const float mx = wave_max(mxl);
    float l = 0.f;
    for (int i = lane; i < n; i += 64) { const float s = sc[i]; const float p = (s > -1e29f) ? exp2f(s - mx) : 0.f; sc[i] = p; l += p; }
    l = wave_sum(l);
    const float inv = 1.f / fmaxf(l, 1e-30f);
    for (int i = lane; i < n; i += 64) sc[i] *= inv;
}

__device__ __forceinline__ void p3_fox_naive(const Frame& F) {
    PHASE_IDS(); const CArgs* a = kargs(); unsigned char* ws = a->ws;
    LAS float* sc = (LAS float*)F.lds + wave * 2048;
    const int gw = F.vcu * NWAVES + wave, NGW = F.G * NWAVES;
    const bf16* FQ = (const bf16*)(ws + WS_FQKV); const bf16* FK = FQ + (size_t)M * 512; const bf16* FV = FK + (size_t)M * 512;
    for (int it = gw; it < BATCH * FOX_H * SEQ; it += NGW) {
        const int bh = it >> 11, t = it & 2047;
        float qf[64]; load_q64(FQ + ((size_t)bh * SEQ + t) * 64, qf);
        const float* nf = (const float*)(ws + WS_NF2) + (size_t)bh * SEQ; const float nft = nf[t];
        const bf16* kb = FK + (size_t)bh * SEQ * 64; const bf16* vb = FV + (size_t)bh * SEQ * 64;
        float mx = -1e30f;
        for (int s = lane; s <= t; s += 64) { const float v = dot64(qf, kb + (size_t)s * 64) * LOG2E + (nf[s] - nft); sc[s] = v; mx = fmaxf(mx, v); }
        softmax_lds(sc, t + 1, lane, mx);
        float o = 0.f;
        for (int s = 0; s <= t; ++s) o += sc[s] * bf2f(vb[(size_t)s * 64 + lane]);
        const int b = bh >> 3, h = bh & 7;
        ((bf16*)(ws + WS_YF))[((size_t)b * SEQ + t) * 512 + h * 64 + lane] = (bf16)f2bf(o);
    }
}

__device__ __forceinline__ void p3_nsa_naive(const Frame& F) {
    PHASE_IDS(); const CArgs* a = kargs(); unsigned char* ws = a->ws;
    const int half = wave >> 2, g = wave & 3;
    LAS float* sc = (LAS float*)F.lds + wave * 1024;
    LAS float* pc = (LAS float*)(F.lds + 32768) + half * 512;
    const bf16* QN = (const bf16*)(ws + WS_QN); const bf16* KV6 = (const bf16*)(ws + WS_KV6);
    const float* rel = a->in[I_REL];
    for (int it = blockIdx.x * 2 + half; it < BATCH * NSA_KVH * SEQ; it += 2 * F.G) {
        const int bk = it >> 11, t = it & 2047, b = bk >> 1, kvh = bk & 1, h = kvh * 4 + g, cur = t >> 6;
        float qf[64]; load_q64(QN + ((size_t)(b * 8 + h) * SEQ + t) * 64, qf);
        const float* ng = (const float*)(ws + WS_NG) + ((size_t)b * SEQ + t) * 24 + h * 3;
        const float g0 = ng[0], g1 = ng[1], g2 = ng[2];
        const bf16* kc = (const bf16*)(ws + WS_KCC) + (size_t)bk * 128 * 64; const bf16* vc = (const bf16*)(ws + WS_VCC) + (size_t)bk * 128 * 64;
        float mx = -1e30f;
        for (int c = lane; c < 128; c += 64) { const int ce = 16 * c + 31; float v = -1e30f;
            if (c < N_CMP && ce <= t) v = (dot64(qf, kc + (size_t)c * 64) + rel[t5b(t - ce) * 8 + h]) * LOG2E;
            sc[c] = v; mx = fmaxf(mx, v); }
        softmax_lds(sc, 128, lane, mx);
        float oc = 0.f;
        for (int c = 0; c < 128; ++c) oc += sc[c] * bf2f(vc[(size_t)c * 64 + lane]);
        pc[g * 128 + lane] = sc[lane]; pc[g * 128 + 64 + lane] = sc[64 + lane];
        __syncthreads();
        unsigned selmask;
        {
            float imp = -1.f;
            if (lane < 32) {
                const int j = lane;
                float P[5];
#pragma unroll
                for (int q = 0; q < 5; ++q) { const int c = 4 * j - 1 + q; P[q] = (c >= 0 && c < 128) ? ((pc[c] + pc[128 + c]) + (pc[256 + c] + pc[384 + c])) : 0.f; }
                const float v = P[1] + P[2] + P[3] + 0.5f * P[4] + 0.5f * P[0];
                const bool forced = (j == 0) || (j <= cur && j > cur - 2);
                imp = forced ? 1e4f : (j <= cur ? v : -1.f);
            }
            int rank = 0;
            for (int jj = 0; jj < 32; ++jj) { const float o = __shfl(imp, jj); rank += (o > imp || (o == imp && jj < lane)) ? 1 : 0; }
            selmask = (unsigned)(__ballot(lane < 32 && rank < 16) & 0xffffffffull);
        }
        __syncthreads();
        const bf16* ks = KV6 + (size_t)2 * M * 128 + (size_t)bk * SEQ * 64; const bf16* vs = KV6 + (size_t)3 * M * 128 + (size_t)bk * SEQ * 64;
        int nsel = 0; mx = -1e30f;
        for (int j = 0; j <= cur; ++j) if ((selmask >> j) & 1u) { const int pos = 64 * j + lane; float v = -1e30f;
            if (pos <= t) v = (dot64(qf, ks + (size_t)pos * 64) + rel[t5b(t - pos) * 8 + h]) * LOG2E;
            sc[nsel * 64 + lane] = v; mx = fmaxf(mx, v); ++nsel; }
        softmax_lds(sc, nsel * 64, lane, mx);
        float os = 0.f; { int q = 0;
            for (int j = 0; j <= cur; ++j) if ((selmask >> j) & 1u) { for (int i = 0; i < 64; ++i) os += sc[q * 64 + i] * bf2f(vs[(size_t)(64 * j + i) * 64 + lane]); ++q; } }
        const bf16* kw = KV6 + (size_t)4 * M * 128 + (size_t)bk * SEQ * 64; const bf16* vw = KV6 + (size_t)5 * M * 128 + (size_t)bk * SEQ * 64;
        const int lo = t - 511 > 0 ? t - 511 : 0, nw = t - lo + 1;
        mx = -1e30f;
        for (int i = lane; i < nw; i += 64) { const int pos = lo + i; const float v = (dot64(qf, kw + (size_t)pos * 64) + rel[t5b(t - pos) * 8 + h]) * LOG2E; sc[i] = v; mx = fmaxf(mx, v); }
        softmax_lds(sc, nw, lane, mx);
        float ow = 0.f;
        for (int i = 0; i < nw; ++i) ow += sc[i] * bf2f(vw[(size_t)(lo + i) * 64 + lane]);
        ((bf16*)(ws + WS_YN))[((size_t)b * SEQ + t) * 512 + h * 64 + lane] = (bf16)f2bf(g0 * oc + g1 * os + g2 * ow);
    }
}

template <int MODE, bool ROUTE, int LNG, int LNB>
__device__ __forceinline__ void ln_phase(const Frame& F, int L, int j) {
    PHASE_IDS(); const CArgs* a = kargs(); unsigned char* ws = a->ws; unsigned* ctl = (unsigned*)(ws + WS_CTL);
    const float* gam = a->in[LNG] + L * DM; const float* bet = a->in[LNB] + L * DM;
    const int gw = F.vcu * NWAVES + wave, NGW = F.G * NWAVES;
    LAS int* lcnt = (LAS int*)F.lds;
    LAS int* lrow = (LAS int*)(F.lds + 256);
    if (ROUTE) { if (tid < 16) lcnt[tid] = 0; __syncthreads(); }
    const float* pre = (const float*)(ws + WS_PRE); float* X = a->out; bf16* XB = (bf16*)(ws + WS_XB);
    f32x4 gv[4], bv[4];
#pragma unroll
    for (int q = 0; q < 4; ++q) { gv[q] = *((const GAS f32x4*)gam + lane + 64 * q); bv[q] = *((const GAS f32x4*)bet + lane + 64 * q); }
    int ri = 0;
    for (int m = gw; m < M; m += NGW, ++ri) {
        f32x4 v[4];
        if (MODE == 0) {
#pragma unroll
            for (int q = 0; q < 4; ++q) v[q] = *((const GAS f32x4*)(pre + (size_t)m * DM) + lane + 64 * q);
        } else {
            const int* ts = (const int*)(ws + WS_TOKS) + 2 * m; const float* tw = (const float*)(ws + WS_TOKW) + 2 * m;
            const int s0 = ts[0], s1 = ts[1]; const float w0 = tw[0], w1 = tw[1];
            const bf16* ys = (const bf16*)(ws + WS_XG);
#pragma unroll
            for (int q = 0; q < 4; ++q) {
                const f32x4 x = *((const GAS f32x4*)(X + (size_t)m * DM) + lane + 64 * q);
                const v2u y0 = *((const GAS v2u*)(ys + (size_t)s0 * DM) + lane + 64 * q), y1 = *((const GAS v2u*)(ys + (size_t)s1 * DM) + lane + 64 * q);
                v[q] = x * DN_ALPHA + (f32x4){bflo(y0.x), bfhi(y0.x), bflo(y0.y), bfhi(y0.y)} * w0 + (f32x4){bflo(y1.x), bfhi(y1.x), bflo(y1.y), bfhi(y1.y)} * w1;
            }
        }
        float s = 0.f;
#pragma unroll
        for (int q = 0; q < 4; ++q) s += (v[q][0] + v[q][1]) + (v[q][2] + v[q][3]);
        const float mean = wave_sum(s) * (1.f / DM); float s2 = 0.f;
#pragma unroll
        for (int q = 0; q < 4; ++q) { v[q] = v[q] - mean; s2 += (v[q][0] * v[q][0] + v[q][1] * v[q][1]) + (v[q][2] * v[q][2] + v[q][3] * v[q][3]); }
        const float rstd = 1.f / sqrtf(wave_sum(s2) * (1.f / DM) + LN_EPS);
#pragma unroll
        for (int q = 0; q < 4; ++q) { v[q] = v[q] * rstd * gv[q] + bv[q];
            *((GAS f32x4*)(X + (size_t)m * DM) + lane + 64 * q) = v[q];
            v2u o; o.x = pk2(v[q][0], v[q][1]); o.y = pk2(v[q][2], v[q][3]); *((GAS v2u*)(XB + (size_t)m * DM) + lane + 64 * q) = o; }
        if (ROUTE) {
            const float* R = a->in[I_ROUT] + (size_t)j * DM * NEXP;
            float lg[8];
#pragma unroll
            for (int e = 0; e < 8; ++e) lg[e] = 0.f;
#pragma unroll
            for (int q = 0; q < 4; ++q)
#pragma unroll
                for (int c = 0; c < 4; ++c) { const float xv = v[q][c]; const float* rr = R + (size_t)(4 * lane + 256 * q + c) * 8; const f32x4 r0 = *(const GAS f32x4*)rr, r1 = *(const GAS f32x4*)(rr + 4);
                    lg[0] += xv * r0[0]; lg[1] += xv * r0[1]; lg[2] += xv * r0[2]; lg[3] += xv * r0[3]; lg[4] += xv * r1[0]; lg[5] += xv * r1[1]; lg[6] += xv * r1[2]; lg[7] += xv * r1[3]; }
#pragma unroll
            for (int e = 0; e < 8; ++e) lg[e] = wave_sum(lg[e]);
            int e0 = 0; float l0 = lg[0];
#pragma unroll
            for (int e = 1; e < 8; ++e) if (lg[e] > l0) { l0 = lg[e]; e0 = e; }
            int e1 = -1; float l1 = -3.0e38f;
#pragma unroll
            for (int e = 0; e < 8; ++e) if (e != e0 && lg[e] > l1) { l1 = lg[e]; e1 = e; }
            const float w0 = 1.f / (1.f + __expf(l1 - l0));
            if (lane == 0) {
                int* te = (int*)(ws + WS_TOKE) + 2 * m; float* tw = (float*)(ws + WS_TOKW) + 2 * m;
                te[0] = e0; te[1] = e1; tw[0] = w0; tw[1] = 1.f - w0;
                const int p0 = __hip_atomic_fetch_add(&lcnt[e0], 1, __ATOMIC_RELAXED, __HIP_MEMORY_SCOPE_WORKGROUP), p1 = __hip_atomic_fetch_add(&lcnt[e1], 1, __ATOMIC_RELAXED, __HIP_MEMORY_SCOPE_WORKGROUP);
                LAS int* lr = lrow + (wave * 16 + ri) * 4; lr[0] = e0; lr[1] = e1; lr[2] = p0; lr[3] = p1;
            }
        }
    }
    if (ROUTE) {
        __syncthreads();
        if (tid < 8) lcnt[8 + tid] = (int)atomicAdd(ctl + CW_MOECNT + j * 64 + tid, (unsigned)lcnt[tid]);
        __syncthreads();
        ri = 0;
        for (int m = gw; m < M; m += NGW, ++ri) if (lane < 2) { LAS int* lr = lrow + (wave * 16 + ri) * 4; ((int*)(ws + WS_TOKP))[2 * m + lane] = lr[2 + lane] + lcnt[8 + lr[lane]]; }
    }
}

struct MoeTiles { int toff[9]; };
__device__ __forceinline__ void moe_tiles(unsigned* ctl, int j, int (&toff)[9]) {
    toff[0] = 0;
#pragma unroll
    for (int e = 0; e < 8; ++e) { const unsigned c = __hip_atomic_load(ctl + CW_MOECNT + j * 64 + e, __ATOMIC_RELAXED, __HIP_MEMORY_SCOPE_AGENT); toff[e + 1] = toff[e] + (int)((c + 255u) >> 8); }
}
__device__ __forceinline__ void moe_gather(const Frame& F, int j) {
    PHASE_IDS(); const CArgs* a = kargs(); unsigned char* ws = a->ws;
    int toff[9]; moe_tiles((unsigned*)(ws + WS_CTL), j, toff);
    const int gw = F.vcu * NWAVES + wave, NGW = F.G * NWAVES;
    const bf16* XB = (const bf16*)(ws + WS_XB); bf16* XG = (bf16*)(ws + WS_XG);
    for (int it = gw; it < 2 * M; it += NGW) {
        const int e = ((const int*)(ws + WS_TOKE))[it], p = ((const int*)(ws + WS_TOKP))[it];
        int tb = toff[0];
#pragma unroll
        for (int q = 1; q < 8; ++q) tb = (e == q) ? toff[q] : tb;
        const int slot = tb * 256 + p;
        if (lane == 0) ((int*)(ws + WS_TOKS))[it] = slot;
        const GAS v4u* src = (const GAS v4u*)(XB + (size_t)(it >> 1) * DM); GAS v4u* dst = (GAS v4u*)(XG + (size_t)slot * DM);
        dst[lane] = src[lane]; dst[64 + lane] = src[64 + lane];
    }
}

constexpr int PH_PER_LAYER = 10, NPHASES = 1 + DEPTH * PH_PER_LAYER;
#ifndef MK_SINGLE
#define MK_SINGLE 1
#endif

__global__ void __launch_bounds__(NWAVES * 64, 2) hybrid_fwd(Args args) {
    extern __shared__ __attribute__((aligned(16))) unsigned char lds[];
    Frame F;
    F.lds = (LAS unsigned char*)lds;
    F.G = gridDim.x; { const int bx = blockIdx.x; F.vcu = (F.G % 8 == 0) ? (bx % 8) * (F.G / 8) + bx / 8 : bx; }
    for (int u = threadIdx.x; u < (LDS_BYTES - LDSCTL_OFF) / 4; u += NWAVES * 64) ((LAS unsigned*)(F.lds + LDSCTL_OFF))[u] = 0u;
    __syncthreads();
    const int lo = args.ph_lo, hi = args.ph_hi;
    XcdBarrier bar; bar.bar = (unsigned*)(args.ws + WS_CTL) + CW_BAR; bar.x = 0; bar.st = nullptr;
    if (hi - lo > 1) bar = xcd_barrier_post((unsigned*)(args.ws + WS_CTL) + CW_BAR, (volatile LAS unsigned*)(F.lds + MISC_OFF) + 8);
#define IN(k) (lo <= (k) && (k) < hi)
#define SEAM(k) do { if (IN(k) && IN((k) + 1)) xcd_barrier(bar); } while (0)

    if (IN(0)) { p0_prologue(F); }
    SEAM(0);

    for (int L = 0; L < DEPTH; ++L) {
        const int pb = 1 + PH_PER_LAYER * L, j = L >> 1; const bool moe = (L & 1) != 0;
        if (IN(pb + 0)) {
            const CArgs* ka = kargs(); unsigned char* ws = ka->ws;
            pg8::Gemm g{(const bf16*)(ws + WS_XB), (const bf16*)(ws + WS_WIN) + (size_t)L * NPROJ * DM, DM, DM, DM};
            pg8::StaticOrder S; S.init(M / 256, NPROJ / 256, F.G, (int)blockIdx.x);
            EpiInProj E{ws, ka->in[I_FB] + L * 8};
            pg8::gemm_phase<EpiInProj, pg8::StaticOrder, true, true>(F.lds, g, S, E);
        }
        SEAM(pb + 0);
        if (IN(pb + 1)) { p2_cmp_scan(F, L); }
        SEAM(pb + 1);
        if (IN(pb + 2)) { p3_fox_naive(F); __syncthreads(); p3_nsa_naive(F); }
        SEAM(pb + 2);
        if (IN(pb + 3)) {
            const CArgs* ka = kargs(); unsigned char* ws = ka->ws;
            pg8::StaticOrder S; S.init(M / 256, DM / 256, F.G, (int)blockIdx.x);
            { pg8::Gemm g{(const bf16*)(ws + WS_YN), (const bf16*)(ws + WS_WNSA) + (size_t)L * DM * 512, 512, 512, 512};
              EpiBranch<false> E{(const bf16*)(ws + WS_MG), (bf16*)(ws + WS_MERGED), 0};
              pg8::gemm_phase<EpiBranch<false>, pg8::StaticOrder, false, true>(F.lds, g, S, E); }
            VM_WAIT(); __syncthreads();
            { pg8::Gemm g{(const bf16*)(ws + WS_YF), (const bf16*)(ws + WS_WFOX) + (size_t)L * DM * 512, 512, 512, 512};
              EpiBranch<true> E{(const bf16*)(ws + WS_MG), (bf16*)(ws + WS_MERGED), 1024};
              pg8::gemm_phase<EpiBranch<true>, pg8::StaticOrder, false, true>(F.lds, g, S, E); }
        }
        SEAM(pb + 3);
        if (IN(pb + 4)) {
            const CArgs* ka = kargs(); unsigned char* ws = ka->ws;
            pg8::Gemm g{(const bf16*)(ws + WS_MERGED), (const bf16*)(ws + WS_WO) + (size_t)L * DM * DM, DM, DM, DM};
            pg8::StaticOrder S; S.init(M / 256, DM / 256, F.G, (int)blockIdx.x);
            EpiResF32 E{L == 0 ? ka->in[I_X] : (const float*)ka->out, (float*)(ws + WS_PRE)};
            pg8::gemm_phase<EpiResF32, pg8::StaticOrder, false, true>(F.lds, g, S, E);
        }
        SEAM(pb + 4);
        if (IN(pb + 5)) {
            if (moe) ln_phase<0, true, I_LN1G, I_LN1B>(F, L, j);
            else ln_phase<0, false, I_LN1G, I_LN1B>(F, L, j);
        }
        SEAM(pb + 5);
        if (IN(pb + 6) && moe) { moe_gather(F, j); }
        if (moe) SEAM(pb + 6);
        if (IN(pb + 7)) {
            const CArgs* ka = kargs(); unsigned char* ws = ka->ws;
            if (moe) {
                int toff[9]; moe_tiles((unsigned*)(ws + WS_CTL), j, toff);
                pg8::MoeOrder S; S.so.init(toff[8], 2 * FF_E / 256, F.G, (int)blockIdx.x);
                S.t1 = toff[1]; S.t2 = toff[2]; S.t3 = toff[3]; S.t4 = toff[4]; S.t5 = toff[5]; S.t6 = toff[6]; S.t7 = toff[7];
                pg8::Gemm g{(const bf16*)(ws + WS_XG), (const bf16*)(ws + WS_WMGU) + (size_t)j * NEXP * 2 * FF_E * DM, DM, DM, DM};
                EpiSwiGLU E{(bf16*)(ws + WS_HID), FF_E};
                pg8::gemm_phase<EpiSwiGLU, pg8::MoeOrder, true, true>(F.lds, g, S, E);
            } else {
                pg8::Gemm g{(const bf16*)(ws + WS_XB), (const bf16*)(ws + WS_WDGU) + (size_t)j * 2 * FF_D * DM, DM, DM, DM};
                pg8::StaticOrder S; S.init(M / 256, 2 * FF_D / 256, F.G, (int)blockIdx.x);
                EpiSwiGLU E{(bf16*)(ws + WS_HID), FF_D};
                pg8::gemm_phase<EpiSwiGLU, pg8::StaticOrder, true, true>(F.lds, g, S, E);
            }
        }
        SEAM(pb + 7);
        if (IN(pb + 8)) {
            const CArgs* ka = kargs(); unsigned char* ws = ka->ws;
            if (moe) {
                int toff[9]; moe_tiles((unsigned*)(ws + WS_CTL), j, toff);
                pg8::MoeOrder S; S.so.init(toff[8], DM / 256, F.G, (int)blockIdx.x);
                S.t1 = toff[1]; S.t2 = toff[2]; S.t3 = toff[3]; S.t4 = toff[4]; S.t5 = toff[5]; S.t6 = toff[6]; S.t7 = toff[7];
                pg8::Gemm g{(const bf16*)(ws + WS_HID), (const bf16*)(ws + WS_WMD) + (size_t)j * NEXP * DM * FF_E, FF_E, FF_E, FF_E};
                EpiPlainBf16 E{(bf16*)(ws + WS_XG)};
                pg8::gemm_phase<EpiPlainBf16, pg8::MoeOrder, true, true>(F.lds, g, S, E);
            } else {
                pg8::Gemm g{(const bf16*)(ws + WS_HID), (const bf16*)(ws + WS_WDD) + (size_t)j * DM * FF_D, FF_D, FF_D, FF_D};
                pg8::StaticOrder S; S.init(M / 256, DM / 256, F.G, (int)blockIdx.x);
                EpiResF32 E{(const float*)ka->out, (float*)(ws + WS_PRE)};
                pg8::gemm_phase<EpiResF32, pg8::StaticOrder, false, true>(F.lds, g, S, E);
            }
        }
        SEAM(pb + 8);
        if (IN(pb + 9)) {
            if (moe) ln_phase<1, false, I_LN2G, I_LN2B>(F, L, j);
            else ln_phase<0, false, I_LN2G, I_LN2B>(F, L, j);
        }
        SEAM(pb + 9);
    }
#undef IN
#undef SEAM
}

extern "C" void kernel_launch(void* const* d_in, const int* in_sizes, int n_in, void* d_out, int out_size, void* d_ws, size_t ws_size, hipStream_t stream) {
    static int grid = 0;
    if (grid == 0) {
        if (n_in != 21 || in_sizes[0] != M * DM || out_size != M * DM || ws_size < WS_END) { fprintf(stderr, "kernel_launch: unexpected shapes / workspace (n_in %d, ws %zu, need %zu); nothing launched\n", n_in, ws_size, (size_t)WS_END); grid = -1; return; }
        int dev = 0, cus = 0, per_cu = 0;
        if (hipGetDevice(&dev) != hipSuccess || hipDeviceGetAttribute(&cus, hipDeviceAttributeMultiprocessorCount, dev) != hipSuccess) { grid = -1; return; }
        if (hipFuncSetAttribute((const void*)hybrid_fwd, hipFuncAttributeMaxDynamicSharedMemorySize, LDS_BYTES) != hipSuccess) { fprintf(stderr, "kernel_launch: hipFuncSetAttribute failed\n"); grid = -1; return; }
        if (hipOccupancyMaxActiveBlocksPerMultiprocessor(&per_cu, (const void*)hybrid_fwd, NWAVES * 64, LDS_BYTES) != hipSuccess || per_cu < 1) { fprintf(stderr, "kernel_launch: occupancy query reports %d blocks per CU\n", per_cu); }
        (void)hipGetLastError();
        grid = cus;
    }
    if (grid < 0) return;
    if (hipMemsetAsync((char*)d_ws + WS_CTL, 0, CTL_ZERO_BYTES, stream) != hipSuccess) return;
    Args a{};
    for (int i = 0; i < 21; ++i) a.in[i] = (const float*)d_in[i];
    a.out = (float*)d_out; a.ws = (unsigned char*)d_ws;
#if MK_SINGLE
    a.ph_lo = 0; a.ph_hi = NPHASES;
    hipLaunchKernelGGL(hybrid_fwd, dim3(grid), dim3(NWAVES * 64), LDS_BYTES, stream, a);
#else
    for (int p = 0; p < NPHASES; ++p) {
        if (p >= 1) { const int L = (p - 1) / PH_PER_LAYER, k = (p - 1) % PH_PER_LAYER; if (k == 6 && !(L & 1)) continue; }
        a.ph_lo = p; a.ph_hi = p + 1;
        hipLaunchKernelGGL(hybrid_fwd, dim3(grid), dim3(NWAVES * 64), LDS_BYTES, stream, a);
    }
#endif
}
```

```cpp
#include <hip/hip_runtime.h>
#include <cstdio>
#include <cstdint>

namespace pg8 {
#define PG8_LAS __attribute__((address_space(3)))
typedef unsigned short bf16_t;
typedef short bf16x8 __attribute__((ext_vector_type(8)));
typedef float f32x4 __attribute__((ext_vector_type(4)));
typedef float f32x2 __attribute__((ext_vector_type(2)));
typedef unsigned u32x4 __attribute__((ext_vector_type(4)));
constexpr int BM = 256, BK = 64, HALF = 128, HTB = HALF * BK * 2, STAGE_BYTES = 8 * HTB, NXCD = 8, WGM = 8;

__host__ __device__ __forceinline__ int lds_byte(int r, int c) { const int st = (r >> 4) * 2 + (c >> 5), rr = r & 15, cc = c & 31, ob = rr * 64 + cc * 2; return st * 1024 + (ob ^ (((ob >> 9) & 1) << 5)); }
__host__ __device__ __forceinline__ void stage_rc(int b, int& R, int& C) { const int st = b / 1024, sb = b % 1024, swz = sb ^ (((sb >> 9) & 1) << 5); R = (st >> 1) * 16 + swz / 64; C = (st & 1) * 32 + (swz % 64) / 2; }
__host__ __device__ __forceinline__ int perm32(int rho) { const int n = rho >> 4, i = rho & 15; return 8 * (i >> 2) + 4 * n + (i & 3); }

struct Unit { int pm, pn, pb; };
struct Gemm { const bf16_t* A; const bf16_t* Bt; int lda, ldb, K; };

struct StaticOrder {
    int nM, nN, nwg, G, c;
    __device__ __forceinline__ void init(int nM_, int nN_, int G_, int c_) { nM = nM_; nN = nN_; nwg = nM * nN; G = G_; c = c_; }
    __device__ __forceinline__ bool next(int i, Unit& u) const {
        const long L = (long)i * G + c; if (L >= nwg) return false;
        int wgid = (int)L; { const int q = nwg / NXCD, r = nwg % NXCD, xcd = wgid % NXCD, off = wgid / NXCD; wgid = (xcd < r ? xcd * (q + 1) : r * (q + 1) + (xcd - r) * q) + off; }
        const int nig = WGM * nN, gid = wgid / nig, fm = gid * WGM, gsz = (nM - fm) < WGM ? (nM - fm) : WGM;
        u.pm = fm + ((wgid % nig) % gsz); u.pn = (wgid % nig) / gsz; u.pb = u.pn; return true;
    }
};
struct MoeOrder {
    StaticOrder so; int t1, t2, t3, t4, t5, t6, t7;
    __device__ __forceinline__ bool next(int i, Unit& u) const {
        if (!so.next(i, u)) return false;
        const int e = (u.pm >= t1) + (u.pm >= t2) + (u.pm >= t3) + (u.pm >= t4) + (u.pm >= t5) + (u.pm >= t6) + (u.pm >= t7);
        u.pb = e * so.nN + u.pn; return true;
    }
};

__device__ __forceinline__ unsigned cvt_pk_bf16(float lo, float hi) { unsigned r; asm volatile("v_cvt_pk_bf16_f32 %0, %1, %2" : "=v"(r) : "v"(lo), "v"(hi)); return r; }

template <class Epi, class Sched, bool ALIGN_EPI, bool SP2>
__device__ __forceinline__ void gemm_phase(PG8_LAS unsigned char* lds, const Gemm g, const Sched& S, const Epi& E, int wid_in) {
    int wid = wid_in; asm volatile("" : "+s"(wid));
    int lane; asm volatile("v_mbcnt_lo_u32_b32 %0, -1, 0\n\tv_mbcnt_hi_u32_b32 %0, -1, %0" : "=v"(lane));
    const int tid = wid * 64 + lane, wr = wid >> 2, wc = wid & 3, fr = lane & 15, fq = lane >> 4;
    const int K = g.K, nt = K / BK;
    unsigned voffA[2], voffB[2];
#pragma unroll
    for (int i = 0; i < 2; ++i) { int R, C; stage_rc(tid * 16 + i * 8192, R, C); const int Rb = Epi::PERM ? ((R & ~31) + perm32(R & 31)) : R;
        voffA[i] = (unsigned)(R * g.lda + C) * 2u; voffB[i] = (unsigned)(Rb * g.ldb + C) * 2u; }
    const size_t kstep = (size_t)(BK * 2);
    const size_t hstepA = (size_t)HALF * g.lda * 2, hstepB = (size_t)HALF * g.ldb * 2;
    const size_t tstepA = 2 * hstepA, tstepB = 2 * hstepB;
    const unsigned ldsw = (unsigned)wid * 1024u;
    const int aoff = lds_byte(wr * 64 + fr, fq * 8), boff = lds_byte(wc * 32 + fr, fq * 8);
#define PG8_SA(b, h) (((b) * 2 + (h)) * HTB)
#define PG8_SB(b, h) ((4 + (b) * 2 + (h)) * HTB)
#define PG8_STAGE(bufoff, gbase, voff) do { _Pragma("unroll") for (int _i = 0; _i < 2; ++_i) \
        __builtin_amdgcn_global_load_lds((const unsigned*)((const char*)(gbase) + (voff)[_i]), (PG8_LAS unsigned*)(lds + (bufoff) + ldsw + _i * 8192), 16, 0, 0); } while (0)
#define PG8_LDA(dst, b, h) do { _Pragma("unroll") for (int m = 0; m < 4; ++m) _Pragma("unroll") for (int k = 0; k < 2; ++k) dst[m][k] = *(const PG8_LAS bf16x8*)(lds + PG8_SA(b, h) + aoff + m * 2048 + k * 1024); } while (0)
#define PG8_LDB(dst, b, h) do { _Pragma("unroll") for (int n = 0; n < 2; ++n) _Pragma("unroll") for (int k = 0; k < 2; ++k) dst[n][k] = *(const PG8_LAS bf16x8*)(lds + PG8_SB(b, h) + boff + n * 2048 + k * 1024); } while (0)
#define PG8_MMA(ai, bj, At, Bt) do { __builtin_amdgcn_s_setprio(1); _Pragma("unroll") for (int m = 0; m < 4; ++m) _Pragma("unroll") for (int n = 0; n < 2; ++n) _Pragma("unroll") for (int k = 0; k < 2; ++k) \
        acc[ai][bj][m][n] = __builtin_amdgcn_mfma_f32_16x16x32_bf16(Bt[n][k], At[m][k], acc[ai][bj][m][n], 0, 0, 0); __builtin_amdgcn_s_setprio(0); } while (0)
#define PG8_WAIT_V(n) asm volatile("s_waitcnt vmcnt(" #n ")" ::: "memory")
#define PG8_WAIT_L(n) asm volatile("s_waitcnt lgkmcnt(" #n ")" ::: "memory")
#define PG8_BAR __builtin_amdgcn_s_barrier()
#define PG8_SCHED __builtin_amdgcn_sched_barrier(0)
    Unit cur, nxt; int ui = 0;
    if (!S.next(0, cur)) return;
    f32x4 acc[2][2][4][2];
#pragma unroll
    for (int a = 0; a < 2; ++a)
#pragma unroll
        for (int b = 0; b < 2; ++b)
#pragma unroll
            for (int m = 0; m < 4; ++m)
#pragma unroll
                for (int n = 0; n < 2; ++n) acc[a][b][m][n] = (f32x4){0.f, 0.f, 0.f, 0.f};
    bf16x8 At[4][2], B0[2][2], B1[2][2];
    const char* cA = (const char*)g.A + (size_t)cur.pm * tstepA; const char* cB = (const char*)g.Bt + (size_t)cur.pb * tstepB;
    if constexpr (SP2) {
        PG8_STAGE(PG8_SB(0, 0), cB, voffB); PG8_STAGE(PG8_SB(0, 1), cB + hstepB, voffB); PG8_STAGE(PG8_SA(0, 0), cA, voffA); PG8_STAGE(PG8_SA(0, 1), cA + hstepA, voffA);
        if (wr == 1) PG8_BAR;
        PG8_WAIT_V(2); PG8_BAR;
        PG8_STAGE(PG8_SB(1, 0), cB + kstep, voffB); PG8_STAGE(PG8_SA(1, 0), cA + kstep, voffA); PG8_STAGE(PG8_SB(1, 1), cB + hstepB + kstep, voffB);
        PG8_WAIT_V(6); PG8_BAR;
    } else {
        PG8_STAGE(PG8_SB(0, 0), cB, voffB); PG8_STAGE(PG8_SA(0, 0), cA, voffA); PG8_STAGE(PG8_SB(0, 1), cB + hstepB, voffB); PG8_STAGE(PG8_SA(0, 1), cA + hstepA, voffA);
        if (wr == 1) PG8_BAR;
        PG8_WAIT_V(4); PG8_BAR;
        PG8_STAGE(PG8_SB(1, 0), cB + kstep, voffB); PG8_STAGE(PG8_SA(1, 0), cA + kstep, voffA); PG8_STAGE(PG8_SB(1, 1), cB + hstepB + kstep, voffB);
        PG8_WAIT_V(6); PG8_BAR;
    }
    for (;;) {
        const bool has_next = S.next(ui + 1, nxt);
        const char* nA = has_next ? (const char*)g.A + (size_t)nxt.pm * tstepA : cA; const char* nB = has_next ? (const char*)g.Bt + (size_t)nxt.pb * tstepB : cB;
        for (int t = 0; t < nt; t += 2) {
            const bool last = (t == nt - 2);
            const char* a1 = cA + (size_t)(t + 1) * kstep;
            const char* a2 = last ? nA : cA + (size_t)(t + 2) * kstep; const char* b2 = last ? nB : cB + (size_t)(t + 2) * kstep;
            const char* a3 = a2 + kstep; const char* b3 = b2 + kstep;
            if constexpr (SP2) {
            PG8_LDB(B0, 0, 0); PG8_LDB(B1, 0, 1); PG8_SCHED; PG8_LDA(At, 0, 0); PG8_STAGE(PG8_SA(1, 1), a1 + hstepA, voffA);
            PG8_WAIT_V(8); PG8_WAIT_L(0); PG8_BAR; PG8_MMA(0, 0, At, B0); PG8_MMA(0, 1, At, B1); PG8_BAR; PG8_SCHED;
            PG8_LDA(At, 0, 1); PG8_STAGE(PG8_SB(0, 0), b2, voffB); PG8_STAGE(PG8_SB(0, 1), b2 + hstepB, voffB); PG8_STAGE(PG8_SA(0, 0), a2, voffA);
            PG8_WAIT_V(8); PG8_WAIT_L(0); PG8_BAR; PG8_MMA(1, 0, At, B0); PG8_MMA(1, 1, At, B1); PG8_BAR; PG8_SCHED;
            PG8_LDB(B0, 1, 0); PG8_LDB(B1, 1, 1); PG8_SCHED; PG8_LDA(At, 1, 0); PG8_STAGE(PG8_SA(0, 1), a2 + hstepA, voffA);
            PG8_WAIT_V(8); PG8_WAIT_L(0); PG8_BAR; PG8_MMA(0, 0, At, B0); PG8_MMA(0, 1, At, B1); PG8_BAR; PG8_SCHED;
            PG8_LDA(At, 1, 1); PG8_STAGE(PG8_SB(1, 0), b3, voffB); PG8_STAGE(PG8_SB(1, 1), b3 + hstepB, voffB); PG8_STAGE(PG8_SA(1, 0), a3, voffA);
            PG8_WAIT_V(8); PG8_WAIT_L(0); PG8_BAR; PG8_MMA(1, 0, At, B0); PG8_MMA(1, 1, At, B1); PG8_BAR; PG8_SCHED;
            } else {
            PG8_LDB(B0, 0, 0); PG8_SCHED; PG8_LDA(At, 0, 0); PG8_STAGE(PG8_SA(1, 1), a1 + hstepA, voffA);
            PG8_WAIT_L(8); PG8_BAR; PG8_WAIT_L(0); PG8_MMA(0, 0, At, B0); PG8_BAR; PG8_SCHED;
            PG8_LDB(B1, 0, 1); PG8_STAGE(PG8_SB(0, 0), b2, voffB);
            PG8_BAR; PG8_WAIT_L(0); PG8_MMA(0, 1, At, B1); PG8_BAR;
            PG8_LDA(At, 0, 1); PG8_STAGE(PG8_SA(0, 0), a2, voffA);
            PG8_BAR; PG8_WAIT_L(0); PG8_MMA(1, 0, At, B0); PG8_BAR; PG8_SCHED;
            PG8_STAGE(PG8_SB(0, 1), b2 + hstepB, voffB);
            PG8_WAIT_V(6); PG8_BAR; PG8_MMA(1, 1, At, B1); PG8_BAR;
            PG8_LDB(B0, 1, 0); PG8_SCHED; PG8_LDA(At, 1, 0); PG8_STAGE(PG8_SA(0, 1), a2 + hstepA, voffA);
            PG8_WAIT_L(8); PG8_BAR; PG8_WAIT_L(0); PG8_MMA(0, 0, At, B0); PG8_BAR; PG8_SCHED;
            PG8_LDB(B1, 1, 1); PG8_STAGE(PG8_SB(1, 0), b3, voffB);
            PG8_BAR; PG8_WAIT_L(0); PG8_MMA(0, 1, At, B1); PG8_BAR;
            PG8_LDA(At, 1, 1); PG8_STAGE(PG8_SA(1, 0), a3, voffA);
            PG8_BAR; PG8_WAIT_L(0); PG8_MMA(1, 0, At, B0); PG8_BAR; PG8_SCHED;
            PG8_STAGE(PG8_SB(1, 1), b3 + hstepB, voffB);
            PG8_WAIT_V(6); PG8_BAR; PG8_MMA(1, 1, At, B1); PG8_BAR;
            }
        }
        if constexpr (ALIGN_EPI) { if (wr == 0) PG8_BAR; }
        E(acc, cur, wr, wc, fr, fq);
        if (!has_next) break;
#pragma unroll
        for (int a = 0; a < 2; ++a)
#pragma unroll
            for (int b = 0; b < 2; ++b)
#pragma unroll
                for (int m = 0; m < 4; ++m)
#pragma unroll
                    for (int n = 0; n < 2; ++n) acc[a][b][m][n] = (f32x4){0.f, 0.f, 0.f, 0.f};
        cur = nxt; cA = nA; cB = nB; ++ui;
        if constexpr (ALIGN_EPI) { if (wr == 1) PG8_BAR; }
    }
    PG8_WAIT_V(0);
    if constexpr (!ALIGN_EPI) { if (wr == 0) PG8_BAR; }
    PG8_BAR;
#undef PG8_SA
#undef PG8_SB
#undef PG8_STAGE
#undef PG8_LDA
#undef PG8_LDB
#undef PG8_MMA
#undef PG8_WAIT_V
#undef PG8_WAIT_L
#undef PG8_BAR
#undef PG8_SCHED
}
}

constexpr int NWAVES = 8;
constexpr int BATCH = 8, SEQ = 2048, DM = 1024, DEPTH = 4, M = BATCH * SEQ;
constexpr int HD = 64, NSA_H = 8, NSA_KVH = 2, NSA_G = 4, FOX_H = 8;
constexpr int N_CMP = 127, CMP_HID = 128;
constexpr int D_IN = 4896, NPROJ = 5120;
constexpr int FF_D = 2816, FF_E = 3584, NEXP = 8;
constexpr int XG_ROWS = 34816;
constexpr float LN_EPS = 1e-5f, DN_ALPHA = 1.681792830507429f, LOG2E = 1.4426950408889634f;
constexpr int PC_Q = 0, PC_KV = 512, PC_FOX = 1280, PC_MG = 2816, PC_MISC = 4864;
constexpr int SC_Q = 0, SC_KV = 512, SC_NG = 1280, SC_FOX = 1304, SC_FF = 2840, SC_MG = 2848;

constexpr size_t MiB = 1u << 20;
constexpr size_t WS_CTL = 0, CTL_ZERO_BYTES = 1 * MiB;
constexpr size_t WS_CBP = 1 * MiB;
constexpr size_t WS_NG = 2 * MiB;
constexpr size_t WS_LF = 4 * MiB;
constexpr size_t WS_NF2 = 4 * MiB + 512 * 1024;
constexpr size_t WS_KCC = 5 * MiB;
constexpr size_t WS_VCC = 5 * MiB + 256 * 1024;
constexpr size_t WS_TOKE = 5 * MiB + 512 * 1024;
constexpr size_t WS_TOKW = WS_TOKE + 128 * 1024;
constexpr size_t WS_TOKP = WS_TOKW + 128 * 1024;
constexpr size_t WS_TOKS = WS_TOKP + 128 * 1024;
constexpr size_t WS_WIN = 8 * MiB;
constexpr size_t WS_WC1 = 48 * MiB;
constexpr size_t WS_WNSA = 52 * MiB;
constexpr size_t WS_WFOX = 56 * MiB;
constexpr size_t WS_WO = 60 * MiB;
constexpr size_t WS_WDGU = 68 * MiB;
constexpr size_t WS_WDD = 90 * MiB;
constexpr size_t WS_WMGU = 102 * MiB;
constexpr size_t WS_WMD = 326 * MiB;
constexpr size_t WS_XB = 438 * MiB;
constexpr size_t WS_PRE = 470 * MiB;
constexpr size_t WS_XG = 534 * MiB;
constexpr size_t WS_HID = 602 * MiB;
constexpr size_t WS_QN = 602 * MiB;
constexpr size_t WS_KV6 = 618 * MiB;
constexpr size_t WS_FQKV = 642 * MiB;
constexpr size_t WS_MG = 690 * MiB;
constexpr size_t WS_YN = 754 * MiB;
constexpr size_t WS_YF = 770 * MiB;
constexpr size_t WS_MERGED = 786 * MiB;
constexpr size_t WS_END = 840 * MiB;
static_assert(WS_HID + (size_t)XG_ROWS * FF_E * 2 <= WS_END && WS_MERGED + (size_t)M * DM * 2 <= WS_END, "ws map");
constexpr int CW_BAR = 4096;
constexpr int CW_MOECNT = 16384;

constexpr int RING_BYTES = 131072;
constexpr int LDSCTL_OFF = RING_BYTES, MISC_OFF = LDSCTL_OFF + 320;
constexpr int LDS_BYTES = 147456;

#define GAS __attribute__((address_space(1)))
#define LAS __attribute__((address_space(3)))
typedef unsigned short bf16;
typedef unsigned v4u __attribute__((ext_vector_type(4)));
typedef unsigned v2u __attribute__((ext_vector_type(2)));
typedef float f32x4 __attribute__((ext_vector_type(4)));
typedef float f32x16 __attribute__((ext_vector_type(16)));
typedef short bf16x8 __attribute__((ext_vector_type(8)));
#define LDS_WAIT() asm volatile("s_waitcnt lgkmcnt(0)" ::: "memory")
#define VM_WAIT() asm volatile("s_waitcnt vmcnt(0)" ::: "memory")
__device__ __forceinline__ unsigned f2bf(float f) { unsigned u = __builtin_bit_cast(unsigned, f); return (u + 0x7fffu + ((u >> 16) & 1u)) >> 16; }
__device__ __forceinline__ unsigned pk2(float lo, float hi) { return f2bf(lo) | (f2bf(hi) << 16); }
__device__ __forceinline__ float bf2f(unsigned v) { return __builtin_bit_cast(float, v << 16); }
__device__ __forceinline__ float bflo(unsigned w) { return __builtin_bit_cast(float, w << 16); }
__device__ __forceinline__ float bfhi(unsigned w) { return __builtin_bit_cast(float, w & 0xffff0000u); }
__device__ __forceinline__ float sigmoidf_(float x) { return 1.f / (1.f + __expf(-x)); }
__device__ __forceinline__ float wave_sum(float v) {
#pragma unroll
    for (int o = 1; o < 64; o <<= 1) v += __shfl_xor(v, o);
    return v;
}
__device__ __forceinline__ float wave_max(float v) {
#pragma unroll
    for (int o = 1; o < 64; o <<= 1) v = fmaxf(v, __shfl_xor(v, o));
    return v;
}
__constant__ unsigned char T5LUT[128] = {0, 1, 2, 3, 4, 5, 6, 7, 8, 9, 10, 11, 12, 13, 14, 15, 16, 16, 16, 17, 17, 18, 18, 18, 19, 19, 19, 20, 20, 20, 20, 21, 21, 21, 21, 22, 22, 22, 22, 22, 23, 23, 23, 23, 23, 23, 24, 24, 24, 24, 24, 24, 25, 25, 25, 25, 25, 25, 25, 26, 26, 26, 26, 26, 26, 26, 26, 27, 27, 27, 27, 27, 27, 27, 27, 27, 27, 28, 28, 28, 28, 28, 28, 28, 28, 28, 28, 29, 29, 29, 29, 29, 29, 29, 29, 29, 29, 29, 29, 30, 30, 30, 30, 30, 30, 30, 30, 30, 30, 30, 30, 30, 30, 31, 31, 31, 31, 31, 31, 31, 31, 31, 31, 31, 31, 31, 31, 31};
__device__ __forceinline__ int t5b(int n) { return n < 128 ? (int)T5LUT[n] : 31; }

#define XB_TMO      128
#define XB_XCNT(j)  (256  + 64 * (j))
#define XB_XSUB(j)  (1280 + 64 * (j))
#define XB_XGEN(j)  (2304 + 64 * (j))
#define XB_TOP      3328
#define XB_TOPGEN   3392
#define XCD_BAR_WORDS 3456
#define XB_SPIN_CAP (1u << 18)

__device__ __forceinline__ unsigned xb_ld(unsigned* p)              { return __hip_atomic_load(p, __ATOMIC_RELAXED, __HIP_MEMORY_SCOPE_AGENT); }
__device__ __forceinline__ unsigned xb_add(unsigned* p, unsigned v) { return __hip_atomic_fetch_add(p, v, __ATOMIC_RELAXED, __HIP_MEMORY_SCOPE_AGENT); }
__device__ __forceinline__ unsigned xb_xcc_id() { return (unsigned)__builtin_amdgcn_s_getreg((3 << 11) | 20) & 0xFu; }
#define XB_SPIN(cond, bar) do { unsigned _sp = 0; while (cond) { __builtin_amdgcn_s_sleep(1); \
    if ((++_sp & 255u) == 0u) { if (xb_ld(&(bar)[XB_TMO])) break; if (_sp > XB_SPIN_CAP) { atomicAdd(&(bar)[XB_TMO], 1u); break; } } } } while (0)

struct XcdBarrier {
    unsigned* bar; unsigned x;
    volatile LAS unsigned* st;
};

__device__ __forceinline__ XcdBarrier xcd_barrier_post(unsigned* bar, volatile LAS unsigned* st) {
    XcdBarrier b; b.bar = bar; b.x = xb_xcc_id(); b.st = st;
    if (threadIdx.x == 0) (void)xb_add(&bar[XB_XCNT(b.x)], 1u);
    return b;
}
__device__ __forceinline__ void xcd_barrier_complete(unsigned* bar, unsigned x, unsigned& nloc, unsigned& nx) {
    const unsigned G = gridDim.x * gridDim.y * gridDim.z;
    unsigned sum, cnt, mine, sp = 0u;
    for (;;) {
        sum = 0u; cnt = 0u; mine = 0u;
#pragma unroll
        for (unsigned j = 0; j < 16; ++j) { const unsigned c = xb_ld(&bar[XB_XCNT(j)]); sum += c; cnt += (c > 0u) ? 1u : 0u; mine = (j == x) ? c : mine; }
        if (sum == G) break;
        __builtin_amdgcn_s_sleep(1);
        if ((++sp & 255u) == 0u) { if (xb_ld(&bar[XB_TMO])) break; if (sp > XB_SPIN_CAP) { atomicAdd(&bar[XB_TMO], 1u); break; } }
    }
    nloc = mine > 0u ? mine : 1u; nx = cnt > 0u ? cnt : 1u;
}

__device__ __forceinline__ void xcd_barrier(const XcdBarrier& b) {
    asm volatile("s_waitcnt vmcnt(0)" ::: "memory");
    __syncthreads();
    if (threadIdx.x == 0) {
        unsigned* bar = b.bar;
        __builtin_amdgcn_s_waitcnt(0);
        unsigned nloc = b.st[0], nx = b.st[1];
        if (nloc == 0u) { xcd_barrier_complete(bar, b.x, nloc, nx); b.st[0] = nloc; b.st[1] = nx; }
        const unsigned old = xb_add(&bar[XB_XSUB(b.x)], 1u);
        const unsigned gen = old / nloc;
        if (old + 1u == (gen + 1u) * nloc) {
            __builtin_amdgcn_fence(__ATOMIC_RELEASE, "agent");
            asm volatile("s_waitcnt vmcnt(0)" ::: "memory");
            const unsigned og = xb_add(&bar[XB_TOP], 1u);
            const unsigned tg = og / nx;
            if (og + 1u == (tg + 1u) * nx) xb_add(&bar[XB_TOPGEN], 1u);
            else XB_SPIN(xb_ld(&bar[XB_TOPGEN]) == tg, bar);
            __builtin_amdgcn_fence(__ATOMIC_ACQUIRE, "agent");
            xb_add(&bar[XB_XGEN(b.x)], 1u);
            asm volatile("s_waitcnt vmcnt(0)" ::: "memory");
        } else {
            XB_SPIN(xb_ld(&bar[XB_XGEN(b.x)]) == gen, bar);
            __builtin_amdgcn_fence(__ATOMIC_ACQUIRE, "agent");
            asm volatile("s_waitcnt vmcnt(0)" ::: "memory");
        }
    }
    __syncthreads();
}

using pg8::Unit; using pg8::cvt_pk_bf16;
typedef const f32x4 (&AccRef)[2][2][4][2];

struct EpiInProj {
    static constexpr bool PERM = true;
    unsigned char* ws; const float* fbias;
    __device__ __forceinline__ void operator()(AccRef acc, const Unit& u, int wr, int wc, int fr, int fq) const {
        const int row0 = u.pm * 256 + wr * 64 + fr;
#pragma unroll
        for (int bj = 0; bj < 2; ++bj) {
            const int cw = u.pn * 256 + bj * 128 + wc * 32;
            const int c = cw + 8 * fq;
            if (cw < PC_MG) {
                bf16* base; int nh, head; float sc = 1.f;
                if (cw < PC_KV) { base = (bf16*)(ws + WS_QN); nh = 8; head = c >> 6; sc = 0.125f * LOG2E; }
                else if (cw < PC_FOX) { const int cc = c - PC_KV; base = (bf16*)(ws + WS_KV6) + (size_t)(cc >> 7) * ((size_t)M * 128); nh = 2; head = (cc >> 6) & 1; }
                else { const int cc = c - PC_FOX; const int which = cc >> 9; base = (bf16*)(ws + WS_FQKV) + (size_t)which * ((size_t)M * 512); nh = 8; head = (cc >> 6) & 7; sc = (which == 0) ? 0.125f * LOG2E : 1.f; }
                const int d = c & 63;
#pragma unroll
                for (int ai = 0; ai < 2; ++ai)
#pragma unroll
                    for (int m = 0; m < 4; ++m) {
                        const int row = row0 + ai * 128 + m * 16, b = row >> 11, s = row & 2047;
                        const f32x4 v0 = acc[ai][bj][m][0] * sc, v1 = acc[ai][bj][m][1] * sc;
                        v4u w; w.x = cvt_pk_bf16(v0[0], v0[1]); w.y = cvt_pk_bf16(v0[2], v0[3]); w.z = cvt_pk_bf16(v1[0], v1[1]); w.w = cvt_pk_bf16(v1[2], v1[3]);
                        *(v4u*)(base + ((size_t)(b * nh + head) * SEQ + s) * 64 + d) = w;
                    }
            } else if (cw < PC_MISC) {
                bf16* mg = (bf16*)(ws + WS_MG);
#pragma unroll
                for (int ai = 0; ai < 2; ++ai)
#pragma unroll
                    for (int m = 0; m < 4; ++m) {
                        const int row = row0 + ai * 128 + m * 16;
                        const f32x4 a = acc[ai][bj][m][0], bq = acc[ai][bj][m][1];
                        v4u w; w.x = cvt_pk_bf16(sigmoidf_(a[0]), sigmoidf_(a[1])); w.y = cvt_pk_bf16(sigmoidf_(a[2]), sigmoidf_(a[3]));
                        w.z = cvt_pk_bf16(sigmoidf_(bq[0]), sigmoidf_(bq[1])); w.w = cvt_pk_bf16(sigmoidf_(bq[2]), sigmoidf_(bq[3]));
                        *(v4u*)(mg + (size_t)row * 2048 + (c - PC_MG)) = w;
                    }
            } else if (cw == PC_MISC) {
                float* ng = (float*)(ws + WS_NG); float* lf = (float*)(ws + WS_LF);
#pragma unroll
                for (int ai = 0; ai < 2; ++ai)
#pragma unroll
                    for (int m = 0; m < 4; ++m) {
                        const int row = row0 + ai * 128 + m * 16;
                        const f32x4 a = acc[ai][bj][m][0], bq = acc[ai][bj][m][1];
                        if (fq < 3) {
                            float* o = ng + (size_t)row * 24 + 8 * fq;
                            *(f32x4*)o = (f32x4){sigmoidf_(a[0]), sigmoidf_(a[1]), sigmoidf_(a[2]), sigmoidf_(a[3])};
                            *(f32x4*)(o + 4) = (f32x4){sigmoidf_(bq[0]), sigmoidf_(bq[1]), sigmoidf_(bq[2]), sigmoidf_(bq[3])};
                        } else {
                            float* o = lf + (size_t)row * 8; float r[8];
#pragma unroll
                            for (int i = 0; i < 8; ++i) { const float x = (i < 4 ? a[i & 3] : bq[i & 3]) + fbias[i]; r[i] = fminf(x, 0.f) - log1pf(__expf(-fabsf(x))); }
                            *(f32x4*)o = (f32x4){r[0], r[1], r[2], r[3]}; *(f32x4*)(o + 4) = (f32x4){r[4], r[5], r[6], r[7]};
                        }
                    }
            }
        }
    }
};

template <bool ADD> struct EpiBranch {
    static constexpr bool PERM = true;
    const bf16* mg; bf16* out; int goff;
    __device__ __forceinline__ void operator()(AccRef acc, const Unit& u, int wr, int wc, int fr, int fq) const {
        const int row0 = u.pm * 256 + wr * 64 + fr, col0 = u.pn * 256 + wc * 32 + 8 * fq;
#pragma unroll
        for (int ai = 0; ai < 2; ++ai)
#pragma unroll
            for (int m = 0; m < 4; ++m) {
                const int row = row0 + ai * 128 + m * 16;
#pragma unroll
                for (int bj = 0; bj < 2; ++bj) {
                    const int c = col0 + bj * 128;
                    const v4u g = *(const v4u*)(mg + (size_t)row * 2048 + goff + c);
                    const f32x4 a = acc[ai][bj][m][0], bq = acc[ai][bj][m][1];
                    float r[8] = {bflo(g.x) * a[0], bfhi(g.x) * a[1], bflo(g.y) * a[2], bfhi(g.y) * a[3], bflo(g.z) * bq[0], bfhi(g.z) * bq[1], bflo(g.w) * bq[2], bfhi(g.w) * bq[3]};
                    if (ADD) { const v4u p = *(const v4u*)(out + (size_t)row * DM + c);
                        r[0] += bflo(p.x); r[1] += bfhi(p.x); r[2] += bflo(p.y); r[3] += bfhi(p.y); r[4] += bflo(p.z); r[5] += bfhi(p.z); r[6] += bflo(p.w); r[7] += bfhi(p.w); }
                    v4u w; w.x = cvt_pk_bf16(r[0], r[1]); w.y = cvt_pk_bf16(r[2], r[3]); w.z = cvt_pk_bf16(r[4], r[5]); w.w = cvt_pk_bf16(r[6], r[7]);
                    *(v4u*)(out + (size_t)row * DM + c) = w;
                }
            }
    }
};

struct EpiResF32 {
    static constexpr bool PERM = false;
    const float* xres; float* pre;
    __device__ __forceinline__ void operator()(AccRef acc, const Unit& u, int wr, int wc, int fr, int fq) const {
        const int row0 = u.pm * 256 + wr * 64 + fr, col0 = u.pn * 256 + wc * 32 + 4 * fq;
#pragma unroll
        for (int ai = 0; ai < 2; ++ai)
#pragma unroll
            for (int m = 0; m < 4; ++m) {
                const size_t off = (size_t)(row0 + ai * 128 + m * 16) * DM + col0;
#pragma unroll
                for (int bj = 0; bj < 2; ++bj)
#pragma unroll
                    for (int n = 0; n < 2; ++n) { const f32x4 x = *(const f32x4*)(xres + off + bj * 128 + n * 16); *(f32x4*)(pre + off + bj * 128 + n * 16) = x * DN_ALPHA + acc[ai][bj][m][n]; }
            }
    }
};

struct EpiSwiGLU {
    static constexpr bool PERM = true;
    bf16* hid; int ldh;
    __device__ __forceinline__ void operator()(AccRef acc, const Unit& u, int wr, int wc, int fr, int fq) const {
        const int row0 = u.pm * 256 + wr * 64 + fr, col0 = u.pn * 128 + wc * 32 + 8 * fq;
#pragma unroll
        for (int ai = 0; ai < 2; ++ai)
#pragma unroll
            for (int m = 0; m < 4; ++m) {
                float r[8];
#pragma unroll
                for (int n = 0; n < 2; ++n)
#pragma unroll
                    for (int i = 0; i < 4; ++i) { const float g = acc[ai][0][m][n][i], up = acc[ai][1][m][n][i]; r[n * 4 + i] = g * sigmoidf_(g) * up; }
                v4u w; w.x = cvt_pk_bf16(r[0], r[1]); w.y = cvt_pk_bf16(r[2], r[3]); w.z = cvt_pk_bf16(r[4], r[5]); w.w = cvt_pk_bf16(r[6], r[7]);
                *(v4u*)(hid + (size_t)(row0 + ai * 128 + m * 16) * ldh + col0) = w;
            }
    }
};

struct EpiPlainBf16 {
    static constexpr bool PERM = true;
    bf16* out;
    __device__ __forceinline__ void operator()(AccRef acc, const Unit& u, int wr, int wc, int fr, int fq) const {
        const int row0 = u.pm * 256 + wr * 64 + fr, col0 = u.pn * 256 + wc * 32 + 8 * fq;
#pragma unroll
        for (int ai = 0; ai < 2; ++ai)
#pragma unroll
            for (int m = 0; m < 4; ++m)
#pragma unroll
                for (int bj = 0; bj < 2; ++bj) {
                    const f32x4 a = acc[ai][bj][m][0], bq = acc[ai][bj][m][1];
                    v4u w; w.x = cvt_pk_bf16(a[0], a[1]); w.y = cvt_pk_bf16(a[2], a[3]); w.z = cvt_pk_bf16(bq[0], bq[1]); w.w = cvt_pk_bf16(bq[2], bq[3]);
                    *(v4u*)(out + (size_t)(row0 + ai * 128 + m * 16) * DM + col0 + bj * 128) = w;
                }
    }
};

struct Args { const float* in[21]; float* out; unsigned char* ws; int ph_lo, ph_hi; };
struct Frame { LAS unsigned char* lds; int vcu, G, wave; };
__device__ __forceinline__ int lane_id() { int l; asm volatile("v_mbcnt_lo_u32_b32 %0, -1, 0\n\tv_mbcnt_hi_u32_b32 %0, -1, %0" : "=v"(l)); return l; }
typedef __attribute__((address_space(4))) const Args CArgs;
__device__ __forceinline__ const CArgs* kargs() { const CArgs* p = (const CArgs*)__builtin_amdgcn_kernarg_segment_ptr(); asm volatile("" : "+s"(p)); return p; }
#define PHASE_IDS() int wave = F.wave; asm volatile("" : "+s"(wave)); int lane = lane_id(); asm volatile("" : "+v"(lane)); const int tid = wave * 64 + lane; (void)tid
enum { I_X = 0, I_WIN, I_PE, I_W1, I_W2, I_FB, I_WNSA, I_WFOX, I_WOUT, I_REL, I_LN1G, I_LN1B, I_LN2G, I_LN2B, I_DG, I_DU, I_DD, I_ROUT, I_MG, I_MU, I_MD };

struct SegDesc { const float* W; bf16* dst; int ldw, ncols, K, mode, roff; };
__device__ __forceinline__ SegDesc seg_desc(int s, const CArgs* a) {
    SegDesc d; unsigned char* ws = a->ws;
    if (s < 44) {
        const int L = s / 11, q = s % 11;
        if (q < 6) {
            const int sc[6] = {SC_Q, SC_KV, SC_FOX, SC_MG, SC_NG, SC_FF}, nc[6] = {512, 768, 1536, 2048, 24, 8}, ro[6] = {PC_Q, PC_KV, PC_FOX, PC_MG, PC_MISC, PC_MISC + 24};
            int scq = sc[0], ncq = nc[0], roq = ro[0];
#pragma unroll
            for (int i = 1; i < 6; ++i) if (q == i) { scq = sc[i]; ncq = nc[i]; roq = ro[i]; }
            d.W = a->in[I_WIN] + (size_t)L * DM * D_IN + scq; d.ldw = D_IN; d.ncols = ncq; d.K = DM; d.dst = (bf16*)(ws + WS_WIN) + (size_t)L * NPROJ * DM; d.mode = 0; d.roff = roq;
        } else if (q == 6) { d.W = a->in[I_WNSA] + (size_t)L * 512 * DM; d.ldw = DM; d.ncols = DM; d.K = 512; d.dst = (bf16*)(ws + WS_WNSA) + (size_t)L * DM * 512; d.mode = 0; d.roff = 0; }
        else if (q == 7) { d.W = a->in[I_WFOX] + (size_t)L * 512 * DM; d.ldw = DM; d.ncols = DM; d.K = 512; d.dst = (bf16*)(ws + WS_WFOX) + (size_t)L * DM * 512; d.mode = 0; d.roff = 0; }
        else if (q == 8) { d.W = a->in[I_WOUT] + (size_t)L * DM * DM; d.ldw = DM; d.ncols = DM; d.K = DM; d.dst = (bf16*)(ws + WS_WO) + (size_t)L * DM * DM; d.mode = 0; d.roff = 0; }
        else { const int kv = q - 9; d.W = a->in[I_W1] + (size_t)(L * 2 + kv) * 2048 * 128; d.ldw = 128; d.ncols = 128; d.K = 2048; d.dst = (bf16*)(ws + WS_WC1) + (size_t)(L * 2 + kv) * 128 * 2048; d.mode = 0; d.roff = 0; }
    } else if (s < 50) {
        const int j = (s - 44) / 3, q = (s - 44) % 3;
        if (q < 2) { d.W = a->in[q == 0 ? I_DG : I_DU] + (size_t)j * DM * FF_D; d.ldw = FF_D; d.ncols = FF_D; d.K = DM; d.dst = (bf16*)(ws + WS_WDGU) + (size_t)j * 2 * FF_D * DM; d.mode = 1; d.roff = q * 128; }
        else { d.W = a->in[I_DD] + (size_t)j * FF_D * DM; d.ldw = DM; d.ncols = DM; d.K = FF_D; d.dst = (bf16*)(ws + WS_WDD) + (size_t)j * DM * FF_D; d.mode = 0; d.roff = 0; }
    } else {
        const int je = (s - 50) / 3, q = (s - 50) % 3;
        if (q < 2) { d.W = a->in[q == 0 ? I_MG : I_MU] + (size_t)je * DM * FF_E; d.ldw = FF_E; d.ncols = FF_E; d.K = DM; d.dst = (bf16*)(ws + WS_WMGU) + (size_t)je * 2 * FF_E * DM; d.mode = 1; d.roff = q * 128; }
        else { d.W = a->in[I_MD] + (size_t)je * FF_E * DM; d.ldw = DM; d.ncols = DM; d.K = FF_E; d.dst = (bf16*)(ws + WS_WMD) + (size_t)je * DM * FF_E; d.mode = 0; d.roff = 0; }
    }
    return d;
}
constexpr int NSEG = 98;

__device__ __forceinline__ void p0_prologue(const Frame& F) {
    PHASE_IDS(); const CArgs* a = kargs();
    LAS float* scr = (LAS float*)(F.lds + wave * 16384);
    const int gw = F.vcu * NWAVES + wave, NGW = F.G * NWAVES;
    int base = 0;
    for (int s = 0; s < NSEG; ++s) {
        const SegDesc d = seg_desc(s, a);
        const int nblk = (d.ncols + 31) >> 5, n_items = (d.K >> 6) * nblk;
        int start = gw - (base % NGW); if (start < 0) start += NGW;
        for (int it = start; it < n_items; it += NGW) {
            const int kb = it / nblk, nb = it % nblk, k0 = 64 * kb, n0 = 32 * nb;
            const int nn = n0 + (lane & 31); const bool okn = nn < d.ncols;
#pragma unroll 8
            for (int i = 0; i < 32; ++i) { const int kk = 2 * i + (lane >> 5); scr[kk * 33 + (lane & 31)] = okn ? d.W[(size_t)(k0 + kk) * d.ldw + nn] : 0.f; }
            LDS_WAIT(); asm volatile("" ::: "memory");
            const int c = lane & 7;
            const int rbase = d.mode ? (d.roff + ((n0 >> 7) << 8) + (n0 & 127)) : (d.roff + n0);
#pragma unroll
            for (int j = 0; j < 4; ++j) { const int n = (lane >> 3) + 8 * j; const LAS float* sp = scr + (8 * c) * 33 + n;
                v4u o; o.x = pk2(sp[0 * 33], sp[1 * 33]); o.y = pk2(sp[2 * 33], sp[3 * 33]); o.z = pk2(sp[4 * 33], sp[5 * 33]); o.w = pk2(sp[6 * 33], sp[7 * 33]);
                if (n0 + n < d.ncols) *(GAS v4u*)(d.dst + (size_t)(rbase + n) * d.K + k0 + 8 * c) = o; }
            LDS_WAIT(); asm volatile("" ::: "memory");
        }
        base += n_items;
    }
    {
        constexpr int PADROWS = NPROJ - (PC_MISC + 32), V16_PER_L = PADROWS * DM * 2 / 16;
        const int gt = gw * 64 + lane, NGT = NGW * 64;
        for (int i = gt; i < DEPTH * V16_PER_L; i += NGT) { const int L = i / V16_PER_L, r = i % V16_PER_L;
            *((GAS v4u*)((bf16*)(a->ws + WS_WIN) + ((size_t)L * NPROJ + PC_MISC + 32) * DM) + r) = (v4u){0u, 0u, 0u, 0u}; }
        const float* x = a->in[I_X]; bf16* xb = (bf16*)(a->ws + WS_XB);
        for (int i = gt; i < M * DM / 8; i += NGT) { const f32x4 p = *((const GAS f32x4*)x + 2 * (size_t)i), q = *((const GAS f32x4*)x + 2 * (size_t)i + 1);
            v4u o; o.x = pk2(p[0], p[1]); o.y = pk2(p[2], p[3]); o.z = pk2(q[0], q[1]); o.w = pk2(q[2], q[3]); *((GAS v4u*)xb + i) = o; }
    }
    if (gw < 256) {
        const int lk = gw >> 5, sl = gw & 31;
        const float* pe = a->in[I_PE] + (size_t)lk * 2048 + sl * 64; const float* w1 = a->in[I_W1] + ((size_t)lk * 2048 + sl * 64) * 128;
        float a0 = 0.f, a1 = 0.f;
        for (int k = 0; k < 64; ++k) { const float p = pe[k]; a0 += p * w1[k * 128 + lane]; a1 += p * w1[k * 128 + 64 + lane]; }
        float* cbp = (float*)(a->ws + WS_CBP) + (size_t)gw * 128; cbp[lane] = a0; cbp[64 + lane] = a1;
    }
}

__device__ __forceinline__ float gelu_tanh(float x) { const float u = 0.7978845608028654f * (x + 0.044715f * x * x * x); return 0.5f * x * (1.f + tanhf(u)); }

__device__ __forceinline__ void p2_cmp_scan(const Frame& F, int L) {
    PHASE_IDS(); const CArgs* a = kargs(); unsigned char* ws = a->ws;
    LAS float* H = (LAS float*)F.lds;
    const int sub = tid >> 7, n = tid & 127;
    for (int it = blockIdx.x; it < 1024; it += F.G) {
        const int U = it * 4 + sub, kv = U >> 11, bh = (U >> 7) & 15, i = U & 127;
        float acc = 0.f;
        if (i < N_CMP) {
            const bf16* A = (const bf16*)(ws + WS_KV6) + (size_t)kv * ((size_t)M * 128) + ((size_t)bh * SEQ + 16 * i) * 64;
            const bf16* W = (const bf16*)(ws + WS_WC1) + ((size_t)(L * 2 + kv) * 128 + n) * 2048;
            for (int k = 0; k < 2048; k += 8) { const v4u av = *(const GAS v4u*)(A + k), wv = *(const GAS v4u*)(W + k);
                acc += bflo(av.x) * bflo(wv.x) + bfhi(av.x) * bfhi(wv.x) + bflo(av.y) * bflo(wv.y) + bfhi(av.y) * bfhi(wv.y)
                     + bflo(av.z) * bflo(wv.z) + bfhi(av.z) * bfhi(wv.z) + bflo(av.w) * bflo(wv.w) + bfhi(av.w) * bfhi(wv.w); }
            const float* cbp = (const float*)(ws + WS_CBP) + (size_t)(L * 2 + kv) * 32 * 128 + n; float cb = 0.f;
            for (int s = 0; s < 32; ++s) cb += cbp[s * 128];
            acc = gelu_tanh(acc + cb);
        }
        H[sub * 128 + n] = acc;
        __syncthreads();
        if (n < 64) {
            const float* w2 = a->in[I_W2] + (size_t)(L * 2 + kv) * 128 * 64 + n; float o = 0.f;
            for (int j = 0; j < 128; ++j) o += H[sub * 128 + j] * w2[j * 64];
            bf16* dst = (bf16*)(ws + (kv ? WS_VCC : WS_KCC)) + ((size_t)bh * 128 + i) * 64 + n;
            *dst = (bf16)f2bf(i < N_CMP ? o : 0.f);
        }
        __syncthreads();
    }
    const int gw = F.vcu * NWAVES + wave;
    if (gw < BATCH * FOX_H) {
        const int b = gw >> 3, h = gw & 7;
        const float* lf = (const float*)(ws + WS_LF) + ((size_t)b * SEQ + 32 * lane) * 8 + h;
        float loc = 0.f;
        for (int i = 0; i < 32; ++i) loc += lf[i * 8];
        float inc = loc;
#pragma unroll
        for (int o = 1; o < 64; o <<= 1) { const float t = __shfl_up(inc, o); if (lane >= o) inc += t; }
        float run = inc - loc;
        float* out = (float*)(ws + WS_NF2) + (size_t)gw * SEQ + 32 * lane;
        for (int i = 0; i < 32; ++i) { run += lf[i * 8]; out[i] = -run * LOG2E; }
    }
}

__device__ __forceinline__ void load_q64(const bf16* q, float (&qf)[64]) {
#pragma unroll
    for (int i = 0; i < 8; ++i) { const v4u v = *(const GAS v4u*)(q + 8 * i);
        qf[8 * i + 0] = bflo(v.x); qf[8 * i + 1] = bfhi(v.x); qf[8 * i + 2] = bflo(v.y); qf[8 * i + 3] = bfhi(v.y); qf[8 * i + 4] = bflo(v.z); qf[8 * i + 5] = bfhi(v.z); qf[8 * i + 6] = bflo(v.w); qf[8 * i + 7] = bfhi(v.w); }
}
__device__ __forceinline__ float dot64(const float (&qf)[64], const bf16* k) {
    float acc = 0.f;
#pragma unroll
    for (int i = 0; i < 8; ++i) { const v4u v = *(const GAS v4u*)(k + 8 * i);
        acc += qf[8 * i + 0] * bflo(v.x) + qf[8 * i + 1] * bfhi(v.x) + qf[8 * i + 2] * bflo(v.y) + qf[8 * i + 3] * bfhi(v.y) + qf[8 * i + 4] * bflo(v.z) + qf[8 * i + 5] * bfhi(v.z) + qf[8 * i + 6] * bflo(v.w) + qf[8 * i + 7] * bfhi(v.w); }
    return acc;
}
__device__ __forceinline__ void softmax_lds(LAS float* sc, int n, int lane, float mxl) {
    const float mx = wave_max(mxl);
    float l = 0.f;
    for (int i = lane; i < n; i += 64) { const float s = sc[i]; const float p = (s > -1e29f) ? exp2f(s - mx) : 0.f; sc[i] = p; l += p; }
    l = wave_sum(l);
    const float inv = 1.f / fmaxf(l, 1e-30f);
    for (int i = lane; i < n; i += 64) sc[i] *= inv;
}

__device__ __forceinline__ void p3_fox_naive(const Frame& F) {
    PHASE_IDS(); const CArgs* a = kargs(); unsigned char* ws = a->ws;
    LAS float* sc = (LAS float*)F.lds + wave * 2048;
    const int gw = F.vcu * NWAVES + wave, NGW = F.G * NWAVES;
    const bf16* FQ = (const bf16*)(ws + WS_FQKV); const bf16* FK = FQ + (size_t)M * 512; const bf16* FV = FK + (size_t)M * 512;
    for (int it = gw; it < BATCH * FOX_H * SEQ; it += NGW) {
        const int bh = it >> 11, t = it & 2047;
        float qf[64]; load_q64(FQ + ((size_t)bh * SEQ + t) * 64, qf);
        const float* nf = (const float*)(ws + WS_NF2) + (size_t)bh * SEQ; const float nft = nf[t];
        const bf16* kb = FK + (size_t)bh * SEQ * 64; const bf16* vb = FV + (size_t)bh * SEQ * 64;
        float mx = -1e30f;
        for (int s = lane; s <= t; s += 64) { const float v = dot64(qf, kb + (size_t)s * 64) + (nf[s] - nft); sc[s] = v; mx = fmaxf(mx, v); }
        softmax_lds(sc, t + 1, lane, mx);
        float o = 0.f;
        for (int s = 0; s <= t; ++s) o += sc[s] * bf2f(vb[(size_t)s * 64 + lane]);
        const int b = bh >> 3, h = bh & 7;
        ((bf16*)(ws + WS_YF))[((size_t)b * SEQ + t) * 512 + h * 64 + lane] = (bf16)f2bf(o);
    }
}

__device__ __forceinline__ void p3_nsa_naive(const Frame& F) {
    PHASE_IDS(); const CArgs* a = kargs(); unsigned char* ws = a->ws;
    const int half = wave >> 2, g = wave & 3;
    LAS float* sc = (LAS float*)F.lds + wave * 1024;
    LAS float* pc = (LAS float*)(F.lds + 32768) + half * 512;
    const bf16* QN = (const bf16*)(ws + WS_QN); const bf16* KV6 = (const bf16*)(ws + WS_KV6);
    const float* rel = a->in[I_REL];
    for (int it = blockIdx.x * 2 + half; it < BATCH * NSA_KVH * SEQ; it += 2 * F.G) {
        const int bk = it >> 11, t = it & 2047, b = bk >> 1, kvh = bk & 1, h = kvh * 4 + g, cur = t >> 6;
        float qf[64]; load_q64(QN + ((size_t)(b * 8 + h) * SEQ + t) * 64, qf);
        const float* ng = (const float*)(ws + WS_NG) + ((size_t)b * SEQ + t) * 24 + h * 3;
        const float g0 = ng[0], g1 = ng[1], g2 = ng[2];
        const bf16* kc = (const bf16*)(ws + WS_KCC) + (size_t)bk * 128 * 64; const bf16* vc = (const bf16*)(ws + WS_VCC) + (size_t)bk * 128 * 64;
        float mx = -1e30f;
        for (int c = lane; c < 128; c += 64) { const int ce = 16 * c + 31; float v = -1e30f;
            if (c < N_CMP && ce <= t) v = dot64(qf, kc + (size_t)c * 64) + rel[t5b(t - ce) * 8 + h] * LOG2E;
            sc[c] = v; mx = fmaxf(mx, v); }
        softmax_lds(sc, 128, lane, mx);
        float oc = 0.f;
        for (int c = 0; c < 128; ++c) oc += sc[c] * bf2f(vc[(size_t)c * 64 + lane]);
        pc[g * 128 + lane] = sc[lane]; pc[g * 128 + 64 + lane] = sc[64 + lane];
        __syncthreads();
        unsigned selmask;
        {
            float imp = -1.f;
            if (lane < 32) {
                const int j = lane;
                float P[5];
#pragma unroll
                for (int q = 0; q < 5; ++q) { const int c = 4 * j - 1 + q; P[q] = (c >= 0 && c < 128) ? ((pc[c] + pc[128 + c]) + (pc[256 + c] + pc[384 + c])) : 0.f; }
                const float v = P[1] + P[2] + P[3] + 0.5f * P[4] + 0.5f * P[0];
                const bool forced = (j == 0) || (j <= cur && j > cur - 2);
                imp = forced ? 1e4f : (j <= cur ? v : -1.f);
            }
            int rank = 0;
            for (int jj = 0; jj < 32; ++jj) { const float o = __shfl(imp, jj); rank += (o > imp || (o == imp && jj < lane)) ? 1 : 0; }
            selmask = (unsigned)(__ballot(lane < 32 && rank < 16) & 0xffffffffull);
        }
        __syncthreads();
        const bf16* ks = KV6 + (size_t)2 * M * 128 + (size_t)bk * SEQ * 64; const bf16* vs = KV6 + (size_t)3 * M * 128 + (size_t)bk * SEQ * 64;
        int nsel = 0; mx = -1e30f;
        for (int j = 0; j <= cur; ++j) if ((selmask >> j) & 1u) { const int pos = 64 * j + lane; float v = -1e30f;
            if (pos <= t) v = dot64(qf, ks + (size_t)pos * 64) + rel[t5b(t - pos) * 8 + h] * LOG2E;
            sc[nsel * 64 + lane] = v; mx = fmaxf(mx, v); ++nsel; }
        softmax_lds(sc, nsel * 64, lane, mx);
        float os = 0.f; { int q = 0;
            for (int j = 0; j <= cur; ++j) if ((selmask >> j) & 1u) { for (int i = 0; i < 64; ++i) os += sc[q * 64 + i] * bf2f(vs[(size_t)(64 * j + i) * 64 + lane]); ++q; } }
        const bf16* kw = KV6 + (size_t)4 * M * 128 + (size_t)bk * SEQ * 64; const bf16* vw = KV6 + (size_t)5 * M * 128 + (size_t)bk * SEQ * 64;
        const int lo = t - 511 > 0 ? t - 511 : 0, nw = t - lo + 1;
        mx = -1e30f;
        for (int i = lane; i < nw; i += 64) { const int pos = lo + i; const float v = dot64(qf, kw + (size_t)pos * 64) + rel[t5b(t - pos) * 8 + h] * LOG2E; sc[i] = v; mx = fmaxf(mx, v); }
        softmax_lds(sc, nw, lane, mx);
        float ow = 0.f;
        for (int i = 0; i < nw; ++i) ow += sc[i] * bf2f(vw[(size_t)(lo + i) * 64 + lane]);
        ((bf16*)(ws + WS_YN))[((size_t)b * SEQ + t) * 512 + h * 64 + lane] = (bf16)f2bf(g0 * oc + g1 * os + g2 * ow);
    }
}

template <int MODE, bool ROUTE, int LNG, int LNB>
__device__ __forceinline__ void ln_phase(const Frame& F, int L, int j) {
    PHASE_IDS(); const CArgs* a = kargs(); unsigned char* ws = a->ws; unsigned* ctl = (unsigned*)(ws + WS_CTL);
    const float* gam = a->in[LNG] + L * DM; const float* bet = a->in[LNB] + L * DM;
    const int gw = F.vcu * NWAVES + wave, NGW = F.G * NWAVES;
    LAS int* lcnt = (LAS int*)F.lds;
    LAS int* lrow = (LAS int*)(F.lds + 256);
    if (ROUTE) { if (tid < 16) lcnt[tid] = 0; __syncthreads(); }
    const float* pre = (const float*)(ws + WS_PRE); float* X = a->out; bf16* XB = (bf16*)(ws + WS_XB);
    f32x4 gv[4], bv[4];
#pragma unroll
    for (int q = 0; q < 4; ++q) { gv[q] = *((const GAS f32x4*)gam + lane + 64 * q); bv[q] = *((const GAS f32x4*)bet + lane + 64 * q); }
    int ri = 0;
    for (int m = gw; m < M; m += NGW, ++ri) {
        f32x4 v[4];
        if (MODE == 0) {
#pragma unroll
            for (int q = 0; q < 4; ++q) v[q] = *((const GAS f32x4*)(pre + (size_t)m * DM) + lane + 64 * q);
        } else {
            const int* ts = (const int*)(ws + WS_TOKS) + 2 * m; const float* tw = (const float*)(ws + WS_TOKW) + 2 * m;
            const int s0 = ts[0], s1 = ts[1]; const float w0 = tw[0], w1 = tw[1];
            const bf16* ys = (const bf16*)(ws + WS_XG);
#pragma unroll
            for (int q = 0; q < 4; ++q) {
                const f32x4 x = *((const GAS f32x4*)(X + (size_t)m * DM) + lane + 64 * q);
                const v2u y0 = *((const GAS v2u*)(ys + (size_t)s0 * DM) + lane + 64 * q), y1 = *((const GAS v2u*)(ys + (size_t)s1 * DM) + lane + 64 * q);
                v[q] = x * DN_ALPHA + (f32x4){bflo(y0.x), bfhi(y0.x), bflo(y0.y), bfhi(y0.y)} * w0 + (f32x4){bflo(y1.x), bfhi(y1.x), bflo(y1.y), bfhi(y1.y)} * w1;
            }
        }
        float s = 0.f;
#pragma unroll
        for (int q = 0; q < 4; ++q) s += (v[q][0] + v[q][1]) + (v[q][2] + v[q][3]);
        const float mean = wave_sum(s) * (1.f / DM); float s2 = 0.f;
#pragma unroll
        for (int q = 0; q < 4; ++q) { v[q] = v[q] - mean; s2 += (v[q][0] * v[q][0] + v[q][1] * v[q][1]) + (v[q][2] * v[q][2] + v[q][3] * v[q][3]); }
        const float rstd = 1.f / sqrtf(wave_sum(s2) * (1.f / DM) + LN_EPS);
#pragma unroll
        for (int q = 0; q < 4; ++q) { v[q] = v[q] * rstd * gv[q] + bv[q];
            *((GAS f32x4*)(X + (size_t)m * DM) + lane + 64 * q) = v[q];
            v2u o; o.x = pk2(v[q][0], v[q][1]); o.y = pk2(v[q][2], v[q][3]); *((GAS v2u*)(XB + (size_t)m * DM) + lane + 64 * q) = o; }
        if (ROUTE) {
            const float* R = a->in[I_ROUT] + (size_t)j * DM * NEXP;
            float lg[8];
#pragma unroll
            for (int e = 0; e < 8; ++e) lg[e] = 0.f;
#pragma unroll
            for (int q = 0; q < 4; ++q)
#pragma unroll
                for (int c = 0; c < 4; ++c) { const float xv = v[q][c]; const float* rr = R + (size_t)(4 * lane + 256 * q + c) * 8; const f32x4 r0 = *(const GAS f32x4*)rr, r1 = *(const GAS f32x4*)(rr + 4);
                    lg[0] += xv * r0[0]; lg[1] += xv * r0[1]; lg[2] += xv * r0[2]; lg[3] += xv * r0[3]; lg[4] += xv * r1[0]; lg[5] += xv * r1[1]; lg[6] += xv * r1[2]; lg[7] += xv * r1[3]; }
#pragma unroll
            for (int e = 0; e < 8; ++e) lg[e] = wave_sum(lg[e]);
            int e0 = 0; float l0 = lg[0];
#pragma unroll
            for (int e = 1; e < 8; ++e) if (lg[e] > l0) { l0 = lg[e]; e0 = e; }
            int e1 = -1; float l1 = -3.0e38f;
#pragma unroll
            for (int e = 0; e < 8; ++e) if (e != e0 && lg[e] > l1) { l1 = lg[e]; e1 = e; }
            const float w0 = 1.f / (1.f + __expf(l1 - l0));
            if (lane == 0) {
                int* te = (int*)(ws + WS_TOKE) + 2 * m; float* tw = (float*)(ws + WS_TOKW) + 2 * m;
                te[0] = e0; te[1] = e1; tw[0] = w0; tw[1] = 1.f - w0;
                const int p0 = __hip_atomic_fetch_add(&lcnt[e0], 1, __ATOMIC_RELAXED, __HIP_MEMORY_SCOPE_WORKGROUP), p1 = __hip_atomic_fetch_add(&lcnt[e1], 1, __ATOMIC_RELAXED, __HIP_MEMORY_SCOPE_WORKGROUP);
                LAS int* lr = lrow + (wave * 16 + ri) * 4; lr[0] = e0; lr[1] = e1; lr[2] = p0; lr[3] = p1;
            }
        }
    }
    if (ROUTE) {
        __syncthreads();
        if (tid < 8) lcnt[8 + tid] = (int)atomicAdd(ctl + CW_MOECNT + j * 64 + tid, (unsigned)lcnt[tid]);
        __syncthreads();
        ri = 0;
        for (int m = gw; m < M; m += NGW, ++ri) if (lane < 2) { LAS int* lr = lrow + (wave * 16 + ri) * 4; ((int*)(ws + WS_TOKP))[2 * m + lane] = lr[2 + lane] + lcnt[8 + lr[lane]]; }
    }
}

struct MoeTiles { int toff[9]; };
__device__ __forceinline__ void moe_tiles(unsigned* ctl, int j, int (&toff)[9]) {
    toff[0] = 0;
#pragma unroll
    for (int e = 0; e < 8; ++e) { const unsigned c = __hip_atomic_load(ctl + CW_MOECNT + j * 64 + e, __ATOMIC_RELAXED, __HIP_MEMORY_SCOPE_AGENT); toff[e + 1] = toff[e] + (int)((c + 255u) >> 8); }
}
__device__ __forceinline__ void moe_gather(const Frame& F, int j) {
    PHASE_IDS(); const CArgs* a = kargs(); unsigned char* ws = a->ws;
    int toff[9]; moe_tiles((unsigned*)(ws + WS_CTL), j, toff);
    const int gw = F.vcu * NWAVES + wave, NGW = F.G * NWAVES;
    const bf16* XB = (const bf16*)(ws + WS_XB); bf16* XG = (bf16*)(ws + WS_XG);
    for (int it = gw; it < 2 * M; it += NGW) {
        const int e = ((const int*)(ws + WS_TOKE))[it], p = ((const int*)(ws + WS_TOKP))[it];
        int tb = toff[0];
#pragma unroll
        for (int q = 1; q < 8; ++q) tb = (e == q) ? toff[q] : tb;
        const int slot = tb * 256 + p;
        if (lane == 0) ((int*)(ws + WS_TOKS))[it] = slot;
        const GAS v4u* src = (const GAS v4u*)(XB + (size_t)(it >> 1) * DM); GAS v4u* dst = (GAS v4u*)(XG + (size_t)slot * DM);
        dst[lane] = src[lane]; dst[64 + lane] = src[64 + lane];
    }
}

namespace att {
constexpr int KSTR = 1152, KT_BYTES = 8 * KSTR, VT_BYTES = 8192;
constexpr int L_K = 0, L_V = 2 * KT_BYTES, L_F = L_V + 2 * VT_BYTES, L_WSF = L_F + 512, L_LUT = L_WSF + 8 * 256, L_SEL = L_LUT + 4096, L_ACC = L_SEL + 256, L_OST = L_ACC, L_IMP = L_ACC + 32768, L_END = L_ACC + 65536;
static_assert(L_END <= RING_BYTES, "attention LDS map");
constexpr float MASKV = -3.0e30f, MINIT = -1.0e30f;
typedef short v4i16_t __attribute__((ext_vector_type(4)));
typedef short s16x4 __attribute__((ext_vector_type(4)));
__device__ __forceinline__ int crow(int r, int hi) { return (r & 3) + 8 * (r >> 2) + 4 * hi; }
__device__ __forceinline__ float swap_max(float m) { auto rr = __builtin_amdgcn_permlane32_swap(__float_as_uint(m), __float_as_uint(m), false, false); return fmaxf(__uint_as_float(rr[0]), __uint_as_float(rr[1])); }
__device__ __forceinline__ float swap_sum(float m) { auto rr = __builtin_amdgcn_permlane32_swap(__float_as_uint(m), __float_as_uint(m), false, false); return __uint_as_float(rr[0]) + __uint_as_float(rr[1]); }
__device__ __forceinline__ float swap_other(float m) { return __shfl_xor(m, 32); }
__device__ __forceinline__ unsigned cvtpk(float lo, float hi) { unsigned r; asm volatile("v_cvt_pk_bf16_f32 %0, %1, %2" : "=v"(r) : "v"(lo), "v"(hi)); return r; }

struct TileRegs { v4u k, v; f32x4 f; };
__device__ __forceinline__ void tile_issue(TileRegs& R, const bf16* kt, const bf16* vt, int tid) {
    R.k = *((const GAS v4u*)kt + tid); R.v = *((const GAS v4u*)vt + tid);
}
__device__ __forceinline__ void tile_store(const TileRegs& R, LAS unsigned char* lds, int buf, int tid) {
    const int row = tid >> 3, c = tid & 7;
    *(LAS v4u*)(lds + L_K + buf * KT_BYTES + c * KSTR + row * 16) = R.k;
    *(LAS v4u*)(lds + L_V + buf * VT_BYTES + (c >> 2) * 4096 + row * 64 + (c & 3) * 16) = R.v;
}
__device__ __forceinline__ void qkt(f32x16& p0, f32x16& p1, const LAS unsigned char* kb, const bf16x8 (&qr)[4], int r32, int hi) {
    p0 = (f32x16){}; p1 = (f32x16){};
#pragma unroll
    for (int d0 = 0; d0 < 4; ++d0) {
        const bf16x8 b0 = *(const LAS bf16x8*)(kb + (2 * d0 + hi) * KSTR + r32 * 16);
        const bf16x8 b1 = *(const LAS bf16x8*)(kb + (2 * d0 + hi) * KSTR + r32 * 16 + 512);
        p0 = __builtin_amdgcn_mfma_f32_32x32x16_bf16(b0, qr[d0], p0, 0, 0, 0);
        p1 = __builtin_amdgcn_mfma_f32_32x32x16_bf16(b1, qr[d0], p1, 0, 0, 0);
    }
}
__device__ __forceinline__ s16x4 vtr(const LAS unsigned char* p) { return __builtin_bit_cast(s16x4, __builtin_amdgcn_ds_read_tr16_b64_v4i16((LAS v4i16_t*)p)); }
__device__ __forceinline__ void pv(f32x16 (&o)[2], const LAS unsigned char* vb, const f32x16& p0, const f32x16& p1, int lane) {
    const int hi = lane >> 5;
    const LAS unsigned char* vp = vb + ((lane >> 4) & 1) * 32 + (lane & 3) * 8 + (4 * hi + ((lane & 15) >> 2)) * 64;
    v4u pw[4];
#pragma unroll
    for (int q = 0; q < 4; ++q) { pw[0][q] = cvtpk(p0[2 * q], p0[2 * q + 1]); pw[1][q] = cvtpk(p0[8 + 2 * q], p0[8 + 2 * q + 1]); pw[2][q] = cvtpk(p1[2 * q], p1[2 * q + 1]); pw[3][q] = cvtpk(p1[8 + 2 * q], p1[8 + 2 * q + 1]); }
#pragma unroll
    for (int d0 = 0; d0 < 2; ++d0)
#pragma unroll
        for (int ks = 0; ks < 4; ++ks) {
            const s16x4 lo = vtr(vp + d0 * 4096 + ks * 1024), hh = vtr(vp + d0 * 4096 + ks * 1024 + 512);
            const bf16x8 vf = (bf16x8){lo[0], lo[1], lo[2], lo[3], hh[0], hh[1], hh[2], hh[3]};
            o[d0] = __builtin_amdgcn_mfma_f32_32x32x16_bf16(__builtin_bit_cast(bf16x8, pw[ks]), vf, o[d0], 0, 0, 0);
        }
}
__device__ __forceinline__ void scale_rows(f32x16 (&o)[2], float f, LAS float* wsf, int r32, int hi) {
    if (hi == 0) wsf[r32] = f;
    asm volatile("s_waitcnt lgkmcnt(0)" ::: "memory");
#pragma unroll
    for (int k = 0; k < 4; ++k) { const f32x4 fv = *(const LAS f32x4*)(wsf + 8 * k + 4 * hi);
#pragma unroll
        for (int i = 0; i < 4; ++i) { o[0][4 * k + i] *= fv[i]; o[1][4 * k + i] *= fv[i]; } }
    asm volatile("s_waitcnt lgkmcnt(0)" ::: "memory");
}
__device__ __forceinline__ void axpy_rows(f32x16 (&acc)[2], const f32x16 (&o)[2], float f, LAS float* wsf, int r32, int hi) {
    if (hi == 0) wsf[r32] = f;
    asm volatile("s_waitcnt lgkmcnt(0)" ::: "memory");
#pragma unroll
    for (int k = 0; k < 4; ++k) { const f32x4 fv = *(const LAS f32x4*)(wsf + 8 * k + 4 * hi);
#pragma unroll
        for (int i = 0; i < 4; ++i) { acc[0][4 * k + i] += o[0][4 * k + i] * fv[i]; acc[1][4 * k + i] += o[1][4 * k + i] * fv[i]; } }
    asm volatile("s_waitcnt lgkmcnt(0)" ::: "memory");
}
template <int MODE>
__device__ __forceinline__ void acc_rows(f32x16 (&o)[2], float f, LAS float* wsf, LAS float* accw, int r32, int hi) {
    if (hi == 0) wsf[r32] = f;
    asm volatile("s_waitcnt lgkmcnt(0)" ::: "memory");
#pragma unroll
    for (int k = 0; k < 4; ++k) { const f32x4 fv = *(const LAS f32x4*)(wsf + 8 * k + 4 * hi);
#pragma unroll
        for (int i = 0; i < 4; ++i)
#pragma unroll
            for (int d0 = 0; d0 < 2; ++d0) { LAS float* p = accw + (8 * k + 4 * hi + i) * 64 + d0 * 32 + r32; const float v = o[d0][4 * k + i] * fv[i];
                if (MODE == 0) *p = v; else if (MODE == 1) *p += v; else o[d0][4 * k + i] = *p + v; } }
    asm volatile("s_waitcnt lgkmcnt(0)" ::: "memory");
}
__device__ __forceinline__ void softmax_pv(f32x16& p0, f32x16& p1, f32x16 (&o)[2], float& m, float& l, const LAS unsigned char* vb, LAS float* wsf, int lane) {
    const int r32 = lane & 31, hi = lane >> 5;
    float mt = fmaxf(p0[0], p1[0]);
#pragma unroll
    for (int r = 1; r < 16; ++r) mt = fmaxf(mt, fmaxf(p0[r], p1[r]));
    mt = swap_max(mt);
    const float mn = fmaxf(m, mt), alpha = __builtin_amdgcn_exp2f(m - mn);
    float s = 0.f;
#pragma unroll
    for (int r = 0; r < 16; ++r) { p0[r] = __builtin_amdgcn_exp2f(p0[r] - mn); p1[r] = __builtin_amdgcn_exp2f(p1[r] - mn); s += p0[r] + p1[r]; }
    l = l * alpha + s; m = mn;
    if (__any(alpha != 1.f)) scale_rows(o, alpha, wsf, r32, hi);
    pv(o, vb, p0, p1, lane);
}
__device__ __forceinline__ void store_rows(const f32x16 (&o)[2], LAS unsigned char* ost, bf16* dst, int pitch, int lane) {
    const int r32 = lane & 31, hi = lane >> 5;
    LAS bf16* stg = (LAS bf16*)ost;
#pragma unroll
    for (int r = 0; r < 16; ++r) { const int orow = crow(r, hi);
#pragma unroll
        for (int d0 = 0; d0 < 2; ++d0) stg[orow * 64 + d0 * 32 + r32] = (bf16)f2bf(o[d0][r]); }
    asm volatile("s_waitcnt lgkmcnt(0)" ::: "memory");
#pragma unroll
    for (int i = 0; i < 4; ++i) { const int row = i * 8 + (lane >> 3), ch = lane & 7; const v4u v = *(const LAS v4u*)(stg + row * 64 + ch * 8); *(GAS v4u*)(dst + (size_t)row * pitch + ch * 8) = v; }
    asm volatile("s_waitcnt lgkmcnt(0)" ::: "memory");
}
#define ATT_BAR() do { asm volatile("s_waitcnt vmcnt(0) lgkmcnt(0)" ::: "memory"); __builtin_amdgcn_s_barrier(); asm volatile("" ::: "memory"); } while (0)
#define ATT_LBAR() do { asm volatile("s_waitcnt lgkmcnt(0)" ::: "memory"); __builtin_amdgcn_s_barrier(); asm volatile("" ::: "memory"); } while (0)

__device__ __forceinline__ void fox_unit(LAS unsigned char* lds, unsigned char* ws, int bh, int qb, int tid_in) {
    int tid = tid_in; asm volatile("" : "+v"(tid));
    const int lane = tid & 63, wave = __builtin_amdgcn_readfirstlane(tid >> 6), r32 = lane & 31, hi = lane >> 5;
    const bf16* FQ = (const bf16*)(ws + WS_FQKV) + (size_t)bh * SEQ * 64; const bf16* FK = FQ + (size_t)M * 512; const bf16* FV = FK + (size_t)M * 512;
    const float* nf = (const float*)(ws + WS_NF2) + (size_t)bh * SEQ;
    LAS float* wsf = (LAS float*)(lds + L_WSF + wave * 256);
    const int q0 = 256 * qb + 32 * wave, qg = q0 + r32;
    bf16x8 qr[4];
#pragma unroll
    for (int d0 = 0; d0 < 4; ++d0) qr[d0] = *(const GAS bf16x8*)(FQ + (size_t)qg * 64 + 16 * d0 + 8 * hi);
    const int NT = 4 * qb + 4, mylast = (q0 + 31) >> 6;
    float m = MINIT, l = 0.f; f32x16 o[2]; o[0] = (f32x16){}; o[1] = (f32x16){};
    TileRegs R;
    tile_issue(R, FK, FV, tid); if (tid < 16) R.f = *((const GAS f32x4*)nf + tid);
    tile_store(R, lds, 0, tid); if (tid < 16) *(LAS f32x4*)(lds + L_F + tid * 16) = R.f;
    ATT_BAR();
    for (int t = 0; t < NT; ++t) {
        const int buf = t & 1;
        if (t + 1 < NT) { tile_issue(R, FK + (size_t)(t + 1) * 4096, FV + (size_t)(t + 1) * 4096, tid); if (tid < 16) R.f = *((const GAS f32x4*)(nf + (t + 1) * 64) + tid); }
        if (t <= mylast) {
            f32x16 p0, p1; qkt(p0, p1, lds + L_K + buf * KT_BYTES, qr, r32, hi);
            const LAS float* fb = (const LAS float*)(lds + L_F + buf * 256);
#pragma unroll
            for (int k = 0; k < 4; ++k) { const f32x4 f0 = *(const LAS f32x4*)(fb + 8 * k + 4 * hi), f1 = *(const LAS f32x4*)(fb + 32 + 8 * k + 4 * hi);
#pragma unroll
                for (int i = 0; i < 4; ++i) { p0[4 * k + i] += f0[i]; p1[4 * k + i] += f1[i]; } }
            if (64 * t + 63 > q0) {
                const int lim = qg - 64 * t;
#pragma unroll
                for (int r = 0; r < 16; ++r) { const int kv = crow(r, hi); if (kv > lim) p0[r] = MASKV; if (kv + 32 > lim) p1[r] = MASKV; }
            }
            softmax_pv(p0, p1, o, m, l, lds + L_V + buf * VT_BYTES, wsf, lane);
        }
        if (t + 1 < NT) { tile_store(R, lds, buf ^ 1, tid); if (tid < 16) *(LAS f32x4*)(lds + L_F + (buf ^ 1) * 256 + tid * 16) = R.f; }
        ATT_BAR();
    }
    l = swap_sum(l);
    scale_rows(o, 1.f / l, wsf, r32, hi);
    const int b = bh >> 3, h = bh & 7;
    store_rows(o, lds + L_OST + wave * 4096, (bf16*)(ws + WS_YF) + ((size_t)b * SEQ + q0) * 512 + h * 64, 512, lane);
}

template <bool NEAR>
__device__ __forceinline__ void nsa_scores(f32x16& p0, f32x16& p1, int dj, int tl, int hi, bool rowsel, int lim, const LAS float* lut, float cfar) {
#pragma unroll
    for (int r = 0; r < 16; ++r) {
        const int kv = crow(r, hi), rel0 = 64 * dj + tl - kv, rel1 = rel0 - 32;
        float b0 = cfar, b1 = cfar;
        if (NEAR) { b0 = lut[min(max(rel0, 0), 255)]; b1 = lut[min(max(rel1, 0), 255)]; }
        p0[r] = (rowsel && rel0 >= 0 && rel0 < lim) ? p0[r] + b0 : MASKV;
        p1[r] = (rowsel && rel1 >= 0 && rel1 < lim) ? p1[r] + b1 : MASKV;
    }
}

__device__ __forceinline__ void nsa_unit(LAS unsigned char* lds, unsigned char* ws, const float* relb, int bk, int cur, int tid_in) {
    int tid = tid_in; asm volatile("" : "+v"(tid));
    const int lane = tid & 63, wave = __builtin_amdgcn_readfirstlane(tid >> 6), r32 = lane & 31, hi = lane >> 5;
    const int g = wave & 3, th = wave >> 2, tl = 32 * th + r32, t = 64 * cur + tl, b = bk >> 1, kvh = bk & 1, h = 4 * kvh + g;
    LAS float* wsf = (LAS float*)(lds + L_WSF + wave * 256);
    LAS float* lutall = (LAS float*)(lds + L_LUT); const LAS float* lut = lutall + g * 256;
    LAS float* impP = (LAS float*)(lds + L_IMP); LAS unsigned* selm = (LAS unsigned*)(lds + L_SEL);
    const bf16* KV6 = (const bf16*)(ws + WS_KV6);
    for (int e = tid; e < 1024; e += 512) { const int gg = e >> 8, rel = e & 255; lutall[e] = relb[t5b(rel) * 8 + 4 * kvh + gg] * LOG2E; }
    const float cfar = relb[31 * 8 + h] * LOG2E;
    bf16x8 qr[4];
    { const bf16* Q = (const bf16*)(ws + WS_QN) + ((size_t)(b * 8 + h) * SEQ + t) * 64;
#pragma unroll
      for (int d0 = 0; d0 < 4; ++d0) qr[d0] = *(const GAS bf16x8*)(Q + 16 * d0 + 8 * hi); }
    const float* ngp = (const float*)(ws + WS_NG) + ((size_t)b * SEQ + t) * 24 + h * 3;
    const float g_c = ngp[0], g_s = ngp[1], g_w = ngp[2];
    f32x16 oc[2]; oc[0] = (f32x16){}; oc[1] = (f32x16){};
    LAS float* accw = (LAS float*)(lds + L_ACC + wave * 8192);
    {
        const bf16* kc = (const bf16*)(ws + WS_KCC) + (size_t)bk * 128 * 64; const bf16* vc = (const bf16*)(ws + WS_VCC) + (size_t)bk * 128 * 64;
        { TileRegs R0, R1; tile_issue(R0, kc, vc, tid); tile_issue(R1, kc + 4096, vc + 4096, tid);
          tile_store(R0, lds, 0, tid); tile_store(R1, lds, 1, tid); }
        ATT_BAR();
        const int ntc = cur > 15 ? 2 : 1;
#define CMP_SCORES(tt) do { qkt(p0, p1, lds + L_K + (tt) * KT_BYTES, qr, r32, hi); \
        _Pragma("unroll") for (int r = 0; r < 16; ++r) { const int c0 = 64 * (tt) + crow(r, hi), rel0 = t - (16 * c0 + 31), rel1 = rel0 - 512; \
            p0[r] = (rel0 >= 0) ? p0[r] + lut[min(rel0, 255)] : MASKV; \
            p1[r] = (rel1 >= 0 && c0 + 32 < N_CMP) ? p1[r] + lut[min(max(rel1, 0), 255)] : MASKV; } } while (0)
        float mx = MASKV, s = 0.f;
        for (int tt = 0; tt < ntc; ++tt) {
            f32x16 p0, p1; CMP_SCORES(tt);
            float mt = fmaxf(p0[0], p1[0]);
#pragma unroll
            for (int r = 1; r < 16; ++r) mt = fmaxf(mt, fmaxf(p0[r], p1[r]));
            mt = swap_max(mt);
            const float mn = fmaxf(mx, mt), mref = mn < -1e29f ? 0.f : mn;
            s *= __builtin_amdgcn_exp2f(fmaxf(mx, -1e30f) - fmaxf(mn, -1e30f));
#pragma unroll
            for (int r = 0; r < 16; ++r) s += __builtin_amdgcn_exp2f(p0[r] - mref) + __builtin_amdgcn_exp2f(p1[r] - mref);
            mx = mn;
        }
        s = swap_sum(s);
        const float mref = mx < -1e29f ? 0.f : mx, inv = 1.f / fmaxf(s, 1e-30f);
        LAS float* ip = impP + (size_t)(g * 64 + tl) * 32;
        float carry = 0.f;
        for (int tt = 0; tt < 2; ++tt) {
            if (tt < ntc) {
                f32x16 p0, p1; CMP_SCORES(tt);
#pragma unroll
                for (int r = 0; r < 16; ++r) { p0[r] = __builtin_amdgcn_exp2f(p0[r] - mref) * inv; p1[r] = __builtin_amdgcn_exp2f(p1[r] - mref) * inv; }
#pragma unroll
                for (int nn = 0; nn < 8; ++nn) { const f32x16& P = (nn >> 2) ? p1 : p0; const int k4 = 4 * (nn & 3);
                    const float pe = swap_other(P[k4 + 3]);
                    const float prev = hi ? pe : carry;
                    ip[2 * (8 * tt + nn) + hi] = (P[k4] + P[k4 + 1]) + (P[k4 + 2] + 0.5f * P[k4 + 3]) + 0.5f * prev;
                    carry = pe; }
                pv(oc, lds + L_V + tt * VT_BYTES, p0, p1, lane);
            } else {
#pragma unroll
                for (int nn = 0; nn < 8; ++nn) ip[2 * (8 * tt + nn) + hi] = 0.f;
            }
        }
#undef CMP_SCORES
    }
    ATT_LBAR();
    for (int i = 0; i < 8; ++i) {
        const int tok = 8 * wave + i;
        float imp = -1.f;
        if (lane < 32) { const int j = lane; const float v = (impP[(0 * 64 + tok) * 32 + j] + impP[(1 * 64 + tok) * 32 + j]) + (impP[(2 * 64 + tok) * 32 + j] + impP[(3 * 64 + tok) * 32 + j]);
            const bool forced = (j == 0) || (j <= cur && j > cur - 2);
            imp = forced ? 1e4f : (j <= cur ? v : -1.f); }
        int rank = 0;
        for (int jj = 0; jj < 32; ++jj) { const float ov = __shfl(imp, jj); rank += (ov > imp || (ov == imp && jj < lane)) ? 1 : 0; }
        const unsigned msk = (unsigned)(__ballot(lane < 32 && rank < 16) & 0xffffffffull);
        if (lane == 0) selm[tok] = msk;
    }
    ATT_LBAR();
    acc_rows<0>(oc, g_c, wsf, accw, r32, hi);
    const unsigned vismask = (cur >= 31) ? 0xffffffffu : ((2u << cur) - 1u);
    const unsigned mysel = selm[tl] & vismask;
    unsigned U = selm[lane] & vismask;
#pragma unroll
    for (int of = 1; of < 64; of <<= 1) U |= (unsigned)__shfl_xor((int)U, of);
    U = (unsigned)__builtin_amdgcn_readfirstlane((int)U);
    {
        const bf16* ks = KV6 + (size_t)2 * M * 128 + (size_t)bk * SEQ * 64; const bf16* vs = KV6 + (size_t)3 * M * 128 + (size_t)bk * SEQ * 64;
        float m = MINIT, l = 0.f; f32x16 o[2]; o[0] = (f32x16){}; o[1] = (f32x16){};
        unsigned rem = U; int j = __builtin_ctz(rem); rem &= rem - 1u;
        TileRegs R; tile_issue(R, ks + (size_t)j * 4096, vs + (size_t)j * 4096, tid); tile_store(R, lds, 0, tid);
        ATT_BAR();
        int buf = 0;
        for (;;) {
            const int jn = rem ? __builtin_ctz(rem) : -1; rem &= rem - 1u;
            if (jn >= 0) tile_issue(R, ks + (size_t)jn * 4096, vs + (size_t)jn * 4096, tid);
            {
                f32x16 p0, p1; qkt(p0, p1, lds + L_K + buf * KT_BYTES, qr, r32, hi);
                const int dj = cur - j; const bool rowsel = (mysel >> j) & 1u;
                if (dj <= 2) nsa_scores<true>(p0, p1, dj, tl, hi, rowsel, 1 << 30, lut, cfar);
                else nsa_scores<false>(p0, p1, dj, tl, hi, rowsel, 1 << 30, lut, cfar);
                softmax_pv(p0, p1, o, m, l, lds + L_V + buf * VT_BYTES, wsf, lane);
            }
            if (jn >= 0) tile_store(R, lds, buf ^ 1, tid);
            ATT_BAR();
            if (jn < 0) break;
            j = jn; buf ^= 1;
        }
        l = swap_sum(l);
        acc_rows<1>(o, g_s / l, wsf, accw, r32, hi);
    }
    {
        const bf16* kw = KV6 + (size_t)4 * M * 128 + (size_t)bk * SEQ * 64; const bf16* vw = KV6 + (size_t)5 * M * 128 + (size_t)bk * SEQ * 64;
        float m = MINIT, l = 0.f; f32x16 o[2]; o[0] = (f32x16){}; o[1] = (f32x16){};
        const int jlo = cur - 8 > 0 ? cur - 8 : 0;
        int j = cur;
        TileRegs R; tile_issue(R, kw + (size_t)j * 4096, vw + (size_t)j * 4096, tid); tile_store(R, lds, 0, tid);
        ATT_BAR();
        int buf = 0;
        for (;;) {
            const int jn = j - 1;
            if (jn >= jlo) tile_issue(R, kw + (size_t)jn * 4096, vw + (size_t)jn * 4096, tid);
            {
                f32x16 p0, p1; qkt(p0, p1, lds + L_K + buf * KT_BYTES, qr, r32, hi);
                const int dj = cur - j;
                if (dj <= 2) nsa_scores<true>(p0, p1, dj, tl, hi, true, 512, lut, cfar);
                else nsa_scores<false>(p0, p1, dj, tl, hi, true, 512, lut, cfar);
                softmax_pv(p0, p1, o, m, l, lds + L_V + buf * VT_BYTES, wsf, lane);
            }
            if (jn >= jlo) tile_store(R, lds, buf ^ 1, tid);
            ATT_BAR();
            if (jn < jlo) break;
            j = jn; buf ^= 1;
        }
        l = swap_sum(l);
        acc_rows<2>(o, g_w / l, wsf, accw, r32, hi);
        store_rows(o, (LAS unsigned char*)accw, (bf16*)(ws + WS_YN) + ((size_t)b * SEQ + 64 * cur + 32 * th) * 512 + h * 64, 512, lane);
    }
}
}

__device__ __forceinline__ void p3_attention(const Frame& F) {
    PHASE_IDS(); const CArgs* a = kargs(); unsigned char* ws = a->ws;
    for (int u = F.vcu; u < 512; u += F.G) { const int idx = u & 255, sec = u >> 8, bh = idx >> 2, s = idx & 3; att::fox_unit(F.lds, ws, bh, sec ? s : 7 - s, tid); }
    for (int u = F.vcu; u < 512; u += F.G) { const int idx = u & 255, sec = u >> 8, bk = idx >> 4, s = idx & 15; att::nsa_unit(F.lds, ws, a->in[I_REL], bk, sec ? s : 31 - s, tid); }
}

constexpr int PH_PER_LAYER = 10, NPHASES = 1 + DEPTH * PH_PER_LAYER;
#ifndef NAIVE_ATTN
#define NAIVE_ATTN 0
#endif
#ifndef MK_SINGLE
#define MK_SINGLE 1
#endif

#define IN(k) (lo <= (k) && (k) < hi)
#define SEAM(k) do { if (IN(k) && IN((k) + 1)) { XcdBarrier b_ = bar; asm volatile("" : "+s"(b_.bar)); xcd_barrier(b_); } } while (0)
template <int L> __device__ __forceinline__ void layer_body(const Frame& F, const int lo, const int hi, const XcdBarrier& bar) {
        const int pb = 1 + PH_PER_LAYER * L, j = L >> 1; const bool moe = (L & 1) != 0;
        if (IN(pb + 0)) {
            const CArgs* ka = kargs(); unsigned char* ws = ka->ws;
            pg8::Gemm g{(const bf16*)(ws + WS_XB), (const bf16*)(ws + WS_WIN) + (size_t)L * NPROJ * DM, DM, DM, DM};
            pg8::StaticOrder S; S.init(M / 256, NPROJ / 256, F.G, (int)blockIdx.x);
            EpiInProj E{ws, ka->in[I_FB] + L * 8};
            pg8::gemm_phase<EpiInProj, pg8::StaticOrder, true, true>(F.lds, g, S, E, F.wave);
        }
        SEAM(pb + 0);
        if (IN(pb + 1)) { p2_cmp_scan(F, L); }
        SEAM(pb + 1);
        if (IN(pb + 2)) {
#if NAIVE_ATTN
            p3_fox_naive(F); __syncthreads(); p3_nsa_naive(F);
#else
            p3_attention(F);
#endif
        }
        SEAM(pb + 2);
        if (IN(pb + 3)) {
            const CArgs* ka = kargs(); unsigned char* ws = ka->ws;
            pg8::StaticOrder S; S.init(M / 256, DM / 256, F.G, (int)blockIdx.x);
            { pg8::Gemm g{(const bf16*)(ws + WS_YN), (const bf16*)(ws + WS_WNSA) + (size_t)L * DM * 512, 512, 512, 512};
              EpiBranch<false> E{(const bf16*)(ws + WS_MG), (bf16*)(ws + WS_MERGED), 0};
              pg8::gemm_phase<EpiBranch<false>, pg8::StaticOrder, false, true>(F.lds, g, S, E, F.wave); }
            VM_WAIT(); __syncthreads();
            { pg8::Gemm g{(const bf16*)(ws + WS_YF), (const bf16*)(ws + WS_WFOX) + (size_t)L * DM * 512, 512, 512, 512};
              EpiBranch<true> E{(const bf16*)(ws + WS_MG), (bf16*)(ws + WS_MERGED), 1024};
              pg8::gemm_phase<EpiBranch<true>, pg8::StaticOrder, false, true>(F.lds, g, S, E, F.wave); }
        }
        SEAM(pb + 3);
        if (IN(pb + 4)) {
            const CArgs* ka = kargs(); unsigned char* ws = ka->ws;
            pg8::Gemm g{(const bf16*)(ws + WS_MERGED), (const bf16*)(ws + WS_WO) + (size_t)L * DM * DM, DM, DM, DM};
            pg8::StaticOrder S; S.init(M / 256, DM / 256, F.G, (int)blockIdx.x);
            EpiResF32 E{L == 0 ? ka->in[I_X] : (const float*)ka->out, (float*)(ws + WS_PRE)};
            pg8::gemm_phase<EpiResF32, pg8::StaticOrder, false, true>(F.lds, g, S, E, F.wave);
        }
        SEAM(pb + 4);
        if (IN(pb + 5)) {
            if (moe) ln_phase<0, true, I_LN1G, I_LN1B>(F, L, j);
            else ln_phase<0, false, I_LN1G, I_LN1B>(F, L, j);
        }
        SEAM(pb + 5);
        if (IN(pb + 6) && moe) { moe_gather(F, j); }
        if (moe) SEAM(pb + 6);
        if (IN(pb + 7)) {
            const CArgs* ka = kargs(); unsigned char* ws = ka->ws;
            if (moe) {
                int toff[9]; moe_tiles((unsigned*)(ws + WS_CTL), j, toff);
                pg8::MoeOrder S; S.so.init(toff[8], 2 * FF_E / 256, F.G, (int)blockIdx.x);
                S.t1 = toff[1]; S.t2 = toff[2]; S.t3 = toff[3]; S.t4 = toff[4]; S.t5 = toff[5]; S.t6 = toff[6]; S.t7 = toff[7];
                pg8::Gemm g{(const bf16*)(ws + WS_XG), (const bf16*)(ws + WS_WMGU) + (size_t)j * NEXP * 2 * FF_E * DM, DM, DM, DM};
                EpiSwiGLU E{(bf16*)(ws + WS_HID), FF_E};
                pg8::gemm_phase<EpiSwiGLU, pg8::MoeOrder, true, true>(F.lds, g, S, E, F.wave);
            } else {
                pg8::Gemm g{(const bf16*)(ws + WS_XB), (const bf16*)(ws + WS_WDGU) + (size_t)j * 2 * FF_D * DM, DM, DM, DM};
                pg8::StaticOrder S; S.init(M / 256, 2 * FF_D / 256, F.G, (int)blockIdx.x);
                EpiSwiGLU E{(bf16*)(ws + WS_HID), FF_D};
                pg8::gemm_phase<EpiSwiGLU, pg8::StaticOrder, true, true>(F.lds, g, S, E, F.wave);
            }
        }
        SEAM(pb + 7);
        if (IN(pb + 8)) {
            const CArgs* ka = kargs(); unsigned char* ws = ka->ws;
            if (moe) {
                int toff[9]; moe_tiles((unsigned*)(ws + WS_CTL), j, toff);
                pg8::MoeOrder S; S.so.init(toff[8], DM / 256, F.G, (int)blockIdx.x);
                S.t1 = toff[1]; S.t2 = toff[2]; S.t3 = toff[3]; S.t4 = toff[4]; S.t5 = toff[5]; S.t6 = toff[6]; S.t7 = toff[7];
                pg8::Gemm g{(const bf16*)(ws + WS_HID), (const bf16*)(ws + WS_WMD) + (size_t)j * NEXP * DM * FF_E, FF_E, FF_E, FF_E};
                EpiPlainBf16 E{(bf16*)(ws + WS_XG)};
                pg8::gemm_phase<EpiPlainBf16, pg8::MoeOrder, true, true>(F.lds, g, S, E, F.wave);
            } else {
                pg8::Gemm g{(const bf16*)(ws + WS_HID), (const bf16*)(ws + WS_WDD) + (size_t)j * DM * FF_D, FF_D, FF_D, FF_D};
                pg8::StaticOrder S; S.init(M / 256, DM / 256, F.G, (int)blockIdx.x);
                EpiResF32 E{(const float*)ka->out, (float*)(ws + WS_PRE)};
                pg8::gemm_phase<EpiResF32, pg8::StaticOrder, false, true>(F.lds, g, S, E, F.wave);
            }
        }
        SEAM(pb + 8);
        if (IN(pb + 9)) {
            if (moe) ln_phase<1, false, I_LN2G, I_LN2B>(F, L, j);
            else ln_phase<0, false, I_LN2G, I_LN2B>(F, L, j);
        }
        SEAM(pb + 9);
    }

__global__ void __launch_bounds__(NWAVES * 64, 2) hybrid_fwd(Args args) {
    extern __shared__ __attribute__((aligned(16))) unsigned char lds[];
    Frame F;
    F.lds = (LAS unsigned char*)lds;
    F.wave = __builtin_amdgcn_readfirstlane((int)threadIdx.x >> 6);
    F.G = gridDim.x; { const int bx = blockIdx.x; F.vcu = (F.G % 8 == 0) ? (bx % 8) * (F.G / 8) + bx / 8 : bx; }
    for (int u = threadIdx.x; u < (LDS_BYTES - LDSCTL_OFF) / 4; u += NWAVES * 64) ((LAS unsigned*)(F.lds + LDSCTL_OFF))[u] = 0u;
    __syncthreads();
    const int lo = args.ph_lo, hi = args.ph_hi;
    XcdBarrier bar; bar.bar = (unsigned*)(args.ws + WS_CTL) + CW_BAR; bar.x = 0; bar.st = nullptr;
    if (hi - lo > 1) bar = xcd_barrier_post((unsigned*)(args.ws + WS_CTL) + CW_BAR, (volatile LAS unsigned*)(F.lds + MISC_OFF) + 8);

    if (IN(0)) { p0_prologue(F); }
    SEAM(0);

    layer_body<0>(F, lo, hi, bar); layer_body<1>(F, lo, hi, bar); layer_body<2>(F, lo, hi, bar); layer_body<3>(F, lo, hi, bar);
#undef IN
#undef SEAM
}

extern "C" void kernel_launch(void* const* d_in, const int* in_sizes, int n_in, void* d_out, int out_size, void* d_ws, size_t ws_size, hipStream_t stream) {
    static int grid = 0;
    if (grid == 0) {
        if (n_in != 21 || in_sizes[0] != M * DM || out_size != M * DM || ws_size < WS_END) { fprintf(stderr, "kernel_launch: unexpected shapes / workspace (n_in %d, ws %zu, need %zu); nothing launched\n", n_in, ws_size, (size_t)WS_END); grid = -1; return; }
        int dev = 0, cus = 0, per_cu = 0;
        if (hipGetDevice(&dev) != hipSuccess || hipDeviceGetAttribute(&cus, hipDeviceAttributeMultiprocessorCount, dev) != hipSuccess) { grid = -1; return; }
        if (hipFuncSetAttribute((const void*)hybrid_fwd, hipFuncAttributeMaxDynamicSharedMemorySize, LDS_BYTES) != hipSuccess) { fprintf(stderr, "kernel_launch: hipFuncSetAttribute failed\n"); grid = -1; return; }
        if (hipOccupancyMaxActiveBlocksPerMultiprocessor(&per_cu, (const void*)hybrid_fwd, NWAVES * 64, LDS_BYTES) != hipSuccess || per_cu < 1) { fprintf(stderr, "kernel_launch: occupancy query reports %d blocks per CU\n", per_cu); }
        (void)hipGetLastError();
        grid = cus;
    }
    if (grid < 0) return;
    if (hipMemsetAsync((char*)d_ws + WS_CTL, 0, CTL_ZERO_BYTES, stream) != hipSuccess) return;
    Args a{};
    for (int i = 0; i < 21; ++i) a.in[i] = (const float*)d_in[i];
    a.out = (float*)d_out; a.ws = (unsigned char*)d_ws;
#if MK_SINGLE
    a.ph_lo = 0; a.ph_hi = NPHASES;
    hipLaunchKernelGGL(hybrid_fwd, dim3(grid), dim3(NWAVES * 64), LDS_BYTES, stream, a);
#else
    for (int p = 0; p < NPHASES; ++p) {
        if (p >= 1) { const int L = (p - 1) / PH_PER_LAYER, k = (p - 1) % PH_PER_LAYER; if (k == 6 && !(L & 1)) continue; }
        a.ph_lo = p; a.ph_hi = p + 1;
        hipLaunchKernelGGL(hybrid_fwd, dim3(grid), dim3(NWAVES * 64), LDS_BYTES, stream, a);
    }
#endif
}
```

```cpp
#include <hip/hip_runtime.h>
#include <cstdio>
#include <cstdint>

namespace pg8 {
#define PG8_LAS __attribute__((address_space(3)))
typedef unsigned short bf16_t;
typedef short bf16x8 __attribute__((ext_vector_type(8)));
typedef float f32x4 __attribute__((ext_vector_type(4)));
typedef float f32x2 __attribute__((ext_vector_type(2)));
typedef unsigned u32x4 __attribute__((ext_vector_type(4)));
constexpr int BM = 256, BK = 64, HALF = 128, HTB = HALF * BK * 2, STAGE_BYTES = 8 * HTB, NXCD = 8, WGM = 8;

__host__ __device__ __forceinline__ int lds_byte(int r, int c) { const int st = (r >> 4) * 2 + (c >> 5), rr = r & 15, cc = c & 31, ob = rr * 64 + cc * 2; return st * 1024 + (ob ^ (((ob >> 9) & 1) << 5)); }
__host__ __device__ __forceinline__ void stage_rc(int b, int& R, int& C) { const int st = b / 1024, sb = b % 1024, swz = sb ^ (((sb >> 9) & 1) << 5); R = (st >> 1) * 16 + swz / 64; C = (st & 1) * 32 + (swz % 64) / 2; }
__host__ __device__ __forceinline__ int perm32(int rho) { const int n = rho >> 4, i = rho & 15; return 8 * (i >> 2) + 4 * n + (i & 3); }

struct Unit { int pm, pn, pb; };
struct Gemm { const bf16_t* A; const bf16_t* Bt; int lda, ldb, K; };

struct StaticOrder {
    int nM, nN, nwg, G, c;
    __device__ __forceinline__ void init(int nM_, int nN_, int G_, int c_) { nM = nM_; nN = nN_; nwg = nM * nN; G = G_; c = c_; }
    __device__ __forceinline__ bool next(int i, Unit& u) const {
        const long L = (long)i * G + c; if (L >= nwg) return false;
        int wgid = (int)L; { const int q = nwg / NXCD, r = nwg % NXCD, xcd = wgid % NXCD, off = wgid / NXCD; wgid = (xcd < r ? xcd * (q + 1) : r * (q + 1) + (xcd - r) * q) + off; }
        const int nig = WGM * nN, gid = wgid / nig, fm = gid * WGM, gsz = (nM - fm) < WGM ? (nM - fm) : WGM;
        u.pm = fm + ((wgid % nig) % gsz); u.pn = (wgid % nig) / gsz; u.pb = u.pn; return true;
    }
};
struct MoeOrder {
    StaticOrder so; int t1, t2, t3, t4, t5, t6, t7;
    __device__ __forceinline__ bool next(int i, Unit& u) const {
        if (!so.next(i, u)) return false;
        const int e = (u.pm >= t1) + (u.pm >= t2) + (u.pm >= t3) + (u.pm >= t4) + (u.pm >= t5) + (u.pm >= t6) + (u.pm >= t7);
        u.pb = e * so.nN + u.pn; return true;
    }
};

__device__ __forceinline__ unsigned cvt_pk_bf16(float lo, float hi) { unsigned r; asm volatile("v_cvt_pk_bf16_f32 %0, %1, %2" : "=v"(r) : "v"(lo), "v"(hi)); return r; }

template <class Epi, class Sched, bool ALIGN_EPI, bool SP2>
__device__ __forceinline__ void gemm_phase(PG8_LAS unsigned char* lds, const Gemm g, const Sched& S, const Epi& E, int wid_in) {
    int wid = wid_in; asm volatile("" : "+s"(wid));
    int lane; asm volatile("v_mbcnt_lo_u32_b32 %0, -1, 0\n\tv_mbcnt_hi_u32_b32 %0, -1, %0" : "=v"(lane));
    const int tid = wid * 64 + lane, wr = wid >> 2, wc = wid & 3, fr = lane & 15, fq = lane >> 4;
    const int K = g.K, nt = K / BK;
    unsigned voffA[2], voffB[2];
#pragma unroll
    for (int i = 0; i < 2; ++i) { int R, C; stage_rc(tid * 16 + i * 8192, R, C); const int Rb = Epi::PERM ? ((R & ~31) + perm32(R & 31)) : R;
        voffA[i] = (unsigned)(R * g.lda + C) * 2u; voffB[i] = (unsigned)(Rb * g.ldb + C) * 2u; }
    const size_t kstep = (size_t)(BK * 2);
    const size_t hstepA = (size_t)HALF * g.lda * 2, hstepB = (size_t)HALF * g.ldb * 2;
    const size_t tstepA = 2 * hstepA, tstepB = 2 * hstepB;
    const unsigned ldsw = (unsigned)wid * 1024u;
    const int aoff = lds_byte(wr * 64 + fr, fq * 8), boff = lds_byte(wc * 32 + fr, fq * 8);
#define PG8_SA(b, h) (((b) * 2 + (h)) * HTB)
#define PG8_SB(b, h) ((4 + (b) * 2 + (h)) * HTB)
#define PG8_STAGE(bufoff, gbase, voff) do { _Pragma("unroll") for (int _i = 0; _i < 2; ++_i) \
        __builtin_amdgcn_global_load_lds((const unsigned*)((const char*)(gbase) + (voff)[_i]), (PG8_LAS unsigned*)(lds + (bufoff) + ldsw + _i * 8192), 16, 0, 0); } while (0)
#define PG8_LDA(dst, b, h) do { _Pragma("unroll") for (int m = 0; m < 4; ++m) _Pragma("unroll") for (int k = 0; k < 2; ++k) dst[m][k] = *(const PG8_LAS bf16x8*)(lds + PG8_SA(b, h) + aoff + m * 2048 + k * 1024); } while (0)
#define PG8_LDB(dst, b, h) do { _Pragma("unroll") for (int n = 0; n < 2; ++n) _Pragma("unroll") for (int k = 0; k < 2; ++k) dst[n][k] = *(const PG8_LAS bf16x8*)(lds + PG8_SB(b, h) + boff + n * 2048 + k * 1024); } while (0)
#define PG8_MMA(ai, bj, At, Bt) do { __builtin_amdgcn_s_setprio(1); _Pragma("unroll") for (int m = 0; m < 4; ++m) _Pragma("unroll") for (int n = 0; n < 2; ++n) _Pragma("unroll") for (int k = 0; k < 2; ++k) \
        acc[ai][bj][m][n] = __builtin_amdgcn_mfma_f32_16x16x32_bf16(Bt[n][k], At[m][k], acc[ai][bj][m][n], 0, 0, 0); __builtin_amdgcn_s_setprio(0); } while (0)
#define PG8_WAIT_V(n) asm volatile("s_waitcnt vmcnt(" #n ")" ::: "memory")
#define PG8_WAIT_L(n) asm volatile("s_waitcnt lgkmcnt(" #n ")" ::: "memory")
#define PG8_BAR __builtin_amdgcn_s_barrier()
#define PG8_SCHED __builtin_amdgcn_sched_barrier(0)
    Unit cur, nxt; int ui = 0;
    if (!S.next(0, cur)) return;
    f32x4 acc[2][2][4][2];
#pragma unroll
    for (int a = 0; a < 2; ++a)
#pragma unroll
        for (int b = 0; b < 2; ++b)
#pragma unroll
            for (int m = 0; m < 4; ++m)
#pragma unroll
                for (int n = 0; n < 2; ++n) acc[a][b][m][n] = (f32x4){0.f, 0.f, 0.f, 0.f};
    bf16x8 At[4][2], B0[2][2], B1[2][2];
    const char* cA = (const char*)g.A + (size_t)cur.pm * tstepA; const char* cB = (const char*)g.Bt + (size_t)cur.pb * tstepB;
    if constexpr (SP2) {
        PG8_STAGE(PG8_SB(0, 0), cB, voffB); PG8_STAGE(PG8_SB(0, 1), cB + hstepB, voffB); PG8_STAGE(PG8_SA(0, 0), cA, voffA); PG8_STAGE(PG8_SA(0, 1), cA + hstepA, voffA);
        if (wr == 1) PG8_BAR;
        PG8_WAIT_V(2); PG8_BAR;
        PG8_STAGE(PG8_SB(1, 0), cB + kstep, voffB); PG8_STAGE(PG8_SA(1, 0), cA + kstep, voffA); PG8_STAGE(PG8_SB(1, 1), cB + hstepB + kstep, voffB);
        PG8_WAIT_V(6); PG8_BAR;
    } else {
        PG8_STAGE(PG8_SB(0, 0), cB, voffB); PG8_STAGE(PG8_SA(0, 0), cA, voffA); PG8_STAGE(PG8_SB(0, 1), cB + hstepB, voffB); PG8_STAGE(PG8_SA(0, 1), cA + hstepA, voffA);
        if (wr == 1) PG8_BAR;
        PG8_WAIT_V(4); PG8_BAR;
        PG8_STAGE(PG8_SB(1, 0), cB + kstep, voffB); PG8_STAGE(PG8_SA(1, 0), cA + kstep, voffA); PG8_STAGE(PG8_SB(1, 1), cB + hstepB + kstep, voffB);
        PG8_WAIT_V(6); PG8_BAR;
    }
    for (;;) {
        const bool has_next = S.next(ui + 1, nxt);
        const char* nA = has_next ? (const char*)g.A + (size_t)nxt.pm * tstepA : cA; const char* nB = has_next ? (const char*)g.Bt + (size_t)nxt.pb * tstepB : cB;
        for (int t = 0; t < nt; t += 2) {
            const bool last = (t == nt - 2);
            const char* a1 = cA + (size_t)(t + 1) * kstep;
            const char* a2 = last ? nA : cA + (size_t)(t + 2) * kstep; const char* b2 = last ? nB : cB + (size_t)(t + 2) * kstep;
            const char* a3 = a2 + kstep; const char* b3 = b2 + kstep;
            if constexpr (SP2) {
            PG8_LDB(B0, 0, 0); PG8_LDB(B1, 0, 1); PG8_SCHED; PG8_LDA(At, 0, 0); PG8_STAGE(PG8_SA(1, 1), a1 + hstepA, voffA);
            PG8_WAIT_V(8); PG8_WAIT_L(0); PG8_BAR; PG8_MMA(0, 0, At, B0); PG8_MMA(0, 1, At, B1); PG8_BAR; PG8_SCHED;
            PG8_LDA(At, 0, 1); PG8_STAGE(PG8_SB(0, 0), b2, voffB); PG8_STAGE(PG8_SB(0, 1), b2 + hstepB, voffB); PG8_STAGE(PG8_SA(0, 0), a2, voffA);
            PG8_WAIT_V(8); PG8_WAIT_L(0); PG8_BAR; PG8_MMA(1, 0, At, B0); PG8_MMA(1, 1, At, B1); PG8_BAR; PG8_SCHED;
            PG8_LDB(B0, 1, 0); PG8_LDB(B1, 1, 1); PG8_SCHED; PG8_LDA(At, 1, 0); PG8_STAGE(PG8_SA(0, 1), a2 + hstepA, voffA);
            PG8_WAIT_V(8); PG8_WAIT_L(0); PG8_BAR; PG8_MMA(0, 0, At, B0); PG8_MMA(0, 1, At, B1); PG8_BAR; PG8_SCHED;
            PG8_LDA(At, 1, 1); PG8_STAGE(PG8_SB(1, 0), b3, voffB); PG8_STAGE(PG8_SB(1, 1), b3 + hstepB, voffB); PG8_STAGE(PG8_SA(1, 0), a3, voffA);
            PG8_WAIT_V(8); PG8_WAIT_L(0); PG8_BAR; PG8_MMA(1, 0, At, B0); PG8_MMA(1, 1, At, B1); PG8_BAR; PG8_SCHED;
            } else {
            PG8_LDB(B0, 0, 0); PG8_SCHED; PG8_LDA(At, 0, 0); PG8_STAGE(PG8_SA(1, 1), a1 + hstepA, voffA);
            PG8_WAIT_L(8); PG8_BAR; PG8_WAIT_L(0); PG8_MMA(0, 0, At, B0); PG8_BAR; PG8_SCHED;
            PG8_LDB(B1, 0, 1); PG8_STAGE(PG8_SB(0, 0), b2, voffB);
            PG8_BAR; PG8_WAIT_L(0); PG8_MMA(0, 1, At, B1); PG8_BAR;
            PG8_LDA(At, 0, 1); PG8_STAGE(PG8_SA(0, 0), a2, voffA);
            PG8_BAR; PG8_WAIT_L(0); PG8_MMA(1, 0, At, B0); PG8_BAR; PG8_SCHED;
            PG8_STAGE(PG8_SB(0, 1), b2 + hstepB, voffB);
            PG8_WAIT_V(6); PG8_BAR; PG8_MMA(1, 1, At, B1); PG8_BAR;
            PG8_LDB(B0, 1, 0); PG8_SCHED; PG8_LDA(At, 1, 0); PG8_STAGE(PG8_SA(0, 1), a2 + hstepA, voffA);
            PG8_WAIT_L(8); PG8_BAR; PG8_WAIT_L(0); PG8_MMA(0, 0, At, B0); PG8_BAR; PG8_SCHED;
            PG8_LDB(B1, 1, 1); PG8_STAGE(PG8_SB(1, 0), b3, voffB);
            PG8_BAR; PG8_WAIT_L(0); PG8_MMA(0, 1, At, B1); PG8_BAR;
            PG8_LDA(At, 1, 1); PG8_STAGE(PG8_SA(1, 0), a3, voffA);
            PG8_BAR; PG8_WAIT_L(0); PG8_MMA(1, 0, At, B0); PG8_BAR; PG8_SCHED;
            PG8_STAGE(PG8_SB(1, 1), b3 + hstepB, voffB);
            PG8_WAIT_V(6); PG8_BAR; PG8_MMA(1, 1, At, B1); PG8_BAR;
            }
        }
        if constexpr (ALIGN_EPI) { if (wr == 0) PG8_BAR; }
        E(acc, cur, wr, wc, fr, fq);
        if (!has_next) break;
#pragma unroll
        for (int a = 0; a < 2; ++a)
#pragma unroll
            for (int b = 0; b < 2; ++b)
#pragma unroll
                for (int m = 0; m < 4; ++m)
#pragma unroll
                    for (int n = 0; n < 2; ++n) acc[a][b][m][n] = (f32x4){0.f, 0.f, 0.f, 0.f};
        cur = nxt; cA = nA; cB = nB; ++ui;
        if constexpr (ALIGN_EPI) { if (wr == 1) PG8_BAR; }
    }
    PG8_WAIT_V(0);
    if constexpr (!ALIGN_EPI) { if (wr == 0) PG8_BAR; }
    PG8_BAR;
#undef PG8_SA
#undef PG8_SB
#undef PG8_STAGE
#undef PG8_LDA
#undef PG8_LDB
#undef PG8_MMA
#undef PG8_WAIT_V
#undef PG8_WAIT_L
#undef PG8_BAR
#undef PG8_SCHED
}
}

constexpr int NWAVES = 8;
constexpr int BATCH = 8, SEQ = 2048, DM = 1024, DEPTH = 4, M = BATCH * SEQ;
constexpr int HD = 64, NSA_H = 8, NSA_KVH = 2, NSA_G = 4, FOX_H = 8;
constexpr int N_CMP = 127, CMP_HID = 128;
constexpr int D_IN = 4896, NPROJ = 5120;
constexpr int FF_D = 2816, FF_E = 3584, NEXP = 8;
constexpr int XG_ROWS = 34816;
constexpr float LN_EPS = 1e-5f, DN_ALPHA = 1.681792830507429f, LOG2E = 1.4426950408889634f;
constexpr int PC_Q = 0, PC_KV = 512, PC_FOX = 1280, PC_MG = 2816, PC_MISC = 4864;
constexpr int SC_Q = 0, SC_KV = 512, SC_NG = 1280, SC_FOX = 1304, SC_FF = 2840, SC_MG = 2848;

constexpr size_t MiB = 1u << 20;
constexpr size_t WS_CTL = 0, CTL_ZERO_BYTES = 1 * MiB;
constexpr size_t WS_CBP = 1 * MiB;
constexpr size_t WS_NG = 2 * MiB;
constexpr size_t WS_LF = 4 * MiB;
constexpr size_t WS_NF2 = 4 * MiB + 512 * 1024;
constexpr size_t WS_KCC = 5 * MiB;
constexpr size_t WS_VCC = 5 * MiB + 256 * 1024;
constexpr size_t WS_TOKE = 5 * MiB + 512 * 1024;
constexpr size_t WS_TOKW = WS_TOKE + 128 * 1024;
constexpr size_t WS_TOKP = WS_TOKW + 128 * 1024;
constexpr size_t WS_TOKS = WS_TOKP + 128 * 1024;
constexpr size_t WS_WIN = 8 * MiB;
constexpr size_t WS_WC1 = 48 * MiB;
constexpr size_t WS_WNSA = 52 * MiB;
constexpr size_t WS_WFOX = 56 * MiB;
constexpr size_t WS_WO = 60 * MiB;
constexpr size_t WS_WDGU = 68 * MiB;
constexpr size_t WS_WDD = 90 * MiB;
constexpr size_t WS_WMGU = 102 * MiB;
constexpr size_t WS_WMD = 326 * MiB;
constexpr size_t WS_XB = 438 * MiB;
constexpr size_t WS_PRE = 470 * MiB;
constexpr size_t WS_XG = 534 * MiB;
constexpr size_t WS_HID = 602 * MiB;
constexpr size_t WS_QN = 602 * MiB;
constexpr size_t WS_KV6 = 618 * MiB;
constexpr size_t WS_FQKV = 642 * MiB;
constexpr size_t WS_MG = 690 * MiB;
constexpr size_t WS_YN = 754 * MiB;
constexpr size_t WS_YF = 770 * MiB;
constexpr size_t WS_MERGED = 786 * MiB;
constexpr size_t WS_END = 840 * MiB;
static_assert(WS_HID + (size_t)XG_ROWS * FF_E * 2 <= WS_END && WS_MERGED + (size_t)M * DM * 2 <= WS_END, "ws map");
constexpr int CW_BAR = 4096;
constexpr int CW_MOECNT = 16384;

constexpr int RING_BYTES = 131072;
constexpr int LDSCTL_OFF = RING_BYTES, MISC_OFF = LDSCTL_OFF + 320;
constexpr int LDS_BYTES = 147456;

#define GAS __attribute__((address_space(1)))
#define LAS __attribute__((address_space(3)))
typedef unsigned short bf16;
typedef unsigned v4u __attribute__((ext_vector_type(4)));
typedef unsigned v2u __attribute__((ext_vector_type(2)));
typedef float f32x4 __attribute__((ext_vector_type(4)));
typedef float f32x16 __attribute__((ext_vector_type(16)));
typedef short bf16x8 __attribute__((ext_vector_type(8)));
#define LDS_WAIT() asm volatile("s_waitcnt lgkmcnt(0)" ::: "memory")
#define VM_WAIT() asm volatile("s_waitcnt vmcnt(0)" ::: "memory")
__device__ __forceinline__ unsigned f2bf(float f) { unsigned u = __builtin_bit_cast(unsigned, f); return (u + 0x7fffu + ((u >> 16) & 1u)) >> 16; }
__device__ __forceinline__ unsigned pk2(float lo, float hi) { return f2bf(lo) | (f2bf(hi) << 16); }
__device__ __forceinline__ float bf2f(unsigned v) { return __builtin_bit_cast(float, v << 16); }
__device__ __forceinline__ float bflo(unsigned w) { return __builtin_bit_cast(float, w << 16); }
__device__ __forceinline__ float bfhi(unsigned w) { return __builtin_bit_cast(float, w & 0xffff0000u); }
__device__ __forceinline__ float sigmoidf_(float x) { return 1.f / (1.f + __expf(-x)); }
__device__ __forceinline__ float wave_sum(float v) {
#pragma unroll
    for (int o = 1; o < 64; o <<= 1) v += __shfl_xor(v, o);
    return v;
}
__device__ __forceinline__ float wave_max(float v) {
#pragma unroll
    for (int o = 1; o < 64; o <<= 1) v = fmaxf(v, __shfl_xor(v, o));
    return v;
}
__constant__ unsigned char T5LUT[128] = {0, 1, 2, 3, 4, 5, 6, 7, 8, 9, 10, 11, 12, 13, 14, 15, 16, 16, 16, 17, 17, 18, 18, 18, 19, 19, 19, 20, 20, 20, 20, 21, 21, 21, 21, 22, 22, 22, 22, 22, 23, 23, 23, 23, 23, 23, 24, 24, 24, 24, 24, 24, 25, 25, 25, 25, 25, 25, 25, 26, 26, 26, 26, 26, 26, 26, 26, 27, 27, 27, 27, 27, 27, 27, 27, 27, 27, 28, 28, 28, 28, 28, 28, 28, 28, 28, 28, 29, 29, 29, 29, 29, 29, 29, 29, 29, 29, 29, 29, 30, 30, 30, 30, 30, 30, 30, 30, 30, 30, 30, 30, 30, 30, 31, 31, 31, 31, 31, 31, 31, 31, 31, 31, 31, 31, 31, 31, 31};
__device__ __forceinline__ int t5b(int n) { return n < 128 ? (int)T5LUT[n] : 31; }

#define XB_TMO      128
#define XB_XCNT(j)  (256  + 64 * (j))
#define XB_XSUB(j)  (1280 + 64 * (j))
#define XB_XGEN(j)  (2304 + 64 * (j))
#define XB_TOP      3328
#define XB_TOPGEN   3392
#define XCD_BAR_WORDS 3456
#define XB_SPIN_CAP (1u << 18)

__device__ __forceinline__ unsigned xb_ld(unsigned* p)              { return __hip_atomic_load(p, __ATOMIC_RELAXED, __HIP_MEMORY_SCOPE_AGENT); }
__device__ __forceinline__ unsigned xb_add(unsigned* p, unsigned v) { return __hip_atomic_fetch_add(p, v, __ATOMIC_RELAXED, __HIP_MEMORY_SCOPE_AGENT); }
__device__ __forceinline__ unsigned xb_xcc_id() { return (unsigned)__builtin_amdgcn_s_getreg((3 << 11) | 20) & 0xFu; }
#define XB_SPIN(cond, bar) do { unsigned _sp = 0; while (cond) { __builtin_amdgcn_s_sleep(1); \
    if ((++_sp & 255u) == 0u) { if (xb_ld(&(bar)[XB_TMO])) break; if (_sp > XB_SPIN_CAP) { atomicAdd(&(bar)[XB_TMO], 1u); break; } } } } while (0)

struct XcdBarrier {
    unsigned* bar; unsigned x;
    volatile LAS unsigned* st;
};

__device__ __forceinline__ XcdBarrier xcd_barrier_post(unsigned* bar, volatile LAS unsigned* st) {
    XcdBarrier b; b.bar = bar; b.x = xb_xcc_id(); b.st = st;
    if (threadIdx.x == 0) (void)xb_add(&bar[XB_XCNT(b.x)], 1u);
    return b;
}
__device__ __forceinline__ void xcd_barrier_complete(unsigned* bar, unsigned x, unsigned& nloc, unsigned& nx) {
    const unsigned G = gridDim.x * gridDim.y * gridDim.z;
    unsigned sum, cnt, mine, sp = 0u;
    for (;;) {
        sum = 0u; cnt = 0u; mine = 0u;
#pragma unroll
        for (unsigned j = 0; j < 16; ++j) { const unsigned c = xb_ld(&bar[XB_XCNT(j)]); sum += c; cnt += (c > 0u) ? 1u : 0u; mine = (j == x) ? c : mine; }
        if (sum == G) break;
        __builtin_amdgcn_s_sleep(1);
        if ((++sp & 255u) == 0u) { if (xb_ld(&bar[XB_TMO])) break; if (sp > XB_SPIN_CAP) { atomicAdd(&bar[XB_TMO], 1u); break; } }
    }
    nloc = mine > 0u ? mine : 1u; nx = cnt > 0u ? cnt : 1u;
}

__device__ __forceinline__ void xcd_barrier(const XcdBarrier& b) {
    asm volatile("s_waitcnt vmcnt(0)" ::: "memory");
    __syncthreads();
    if (threadIdx.x == 0) {
        unsigned* bar = b.bar;
        __builtin_amdgcn_s_waitcnt(0);
        unsigned nloc = b.st[0], nx = b.st[1];
        if (nloc == 0u) { xcd_barrier_complete(bar, b.x, nloc, nx); b.st[0] = nloc; b.st[1] = nx; }
        const unsigned old = xb_add(&bar[XB_XSUB(b.x)], 1u);
        const unsigned gen = old / nloc;
        if (old + 1u == (gen + 1u) * nloc) {
            __builtin_amdgcn_fence(__ATOMIC_RELEASE, "agent");
            asm volatile("s_waitcnt vmcnt(0)" ::: "memory");
            const unsigned og = xb_add(&bar[XB_TOP], 1u);
            const unsigned tg = og / nx;
            if (og + 1u == (tg + 1u) * nx) xb_add(&bar[XB_TOPGEN], 1u);
            else XB_SPIN(xb_ld(&bar[XB_TOPGEN]) == tg, bar);
            __builtin_amdgcn_fence(__ATOMIC_ACQUIRE, "agent");
            xb_add(&bar[XB_XGEN(b.x)], 1u);
            asm volatile("s_waitcnt vmcnt(0)" ::: "memory");
        } else {
            XB_SPIN(xb_ld(&bar[XB_XGEN(b.x)]) == gen, bar);
            __builtin_amdgcn_fence(__ATOMIC_ACQUIRE, "agent");
            asm volatile("s_waitcnt vmcnt(0)" ::: "memory");
        }
    }
    __syncthreads();
}

using pg8::Unit; using pg8::cvt_pk_bf16;
typedef const f32x4 (&AccRef)[2][2][4][2];

struct EpiInProj {
    static constexpr bool PERM = true;
    unsigned char* ws; const float* fbias;
    __device__ __forceinline__ void operator()(AccRef acc, const Unit& u, int wr, int wc, int fr, int fq) const {
        const int row0 = u.pm * 256 + wr * 64 + fr;
#pragma unroll
        for (int bj = 0; bj < 2; ++bj) {
            const int cw = u.pn * 256 + bj * 128 + wc * 32;
            const int c = cw + 8 * fq;
            if (cw < PC_MG) {
                bf16* base; int nh, head; float sc = 1.f;
                if (cw < PC_KV) { base = (bf16*)(ws + WS_QN); nh = 8; head = c >> 6; sc = 0.125f * LOG2E; }
                else if (cw < PC_FOX) { const int cc = c - PC_KV; base = (bf16*)(ws + WS_KV6) + (size_t)(cc >> 7) * ((size_t)M * 128); nh = 2; head = (cc >> 6) & 1; }
                else { const int cc = c - PC_FOX; const int which = cc >> 9; base = (bf16*)(ws + WS_FQKV) + (size_t)which * ((size_t)M * 512); nh = 8; head = (cc >> 6) & 7; sc = (which == 0) ? 0.125f * LOG2E : 1.f; }
                const int d = c & 63;
#pragma unroll
                for (int ai = 0; ai < 2; ++ai)
#pragma unroll
                    for (int m = 0; m < 4; ++m) {
                        const int row = row0 + ai * 128 + m * 16, b = row >> 11, s = row & 2047;
                        const f32x4 v0 = acc[ai][bj][m][0] * sc, v1 = acc[ai][bj][m][1] * sc;
                        v4u w; w.x = cvt_pk_bf16(v0[0], v0[1]); w.y = cvt_pk_bf16(v0[2], v0[3]); w.z = cvt_pk_bf16(v1[0], v1[1]); w.w = cvt_pk_bf16(v1[2], v1[3]);
                        *(v4u*)(base + ((size_t)(b * nh + head) * SEQ + s) * 64 + d) = w;
                    }
            } else if (cw < PC_MISC) {
                bf16* mg = (bf16*)(ws + WS_MG);
#pragma unroll
                for (int ai = 0; ai < 2; ++ai)
#pragma unroll
                    for (int m = 0; m < 4; ++m) {
                        const int row = row0 + ai * 128 + m * 16;
                        const f32x4 a = acc[ai][bj][m][0], bq = acc[ai][bj][m][1];
                        v4u w; w.x = cvt_pk_bf16(sigmoidf_(a[0]), sigmoidf_(a[1])); w.y = cvt_pk_bf16(sigmoidf_(a[2]), sigmoidf_(a[3]));
                        w.z = cvt_pk_bf16(sigmoidf_(bq[0]), sigmoidf_(bq[1])); w.w = cvt_pk_bf16(sigmoidf_(bq[2]), sigmoidf_(bq[3]));
                        *(v4u*)(mg + (size_t)row * 2048 + (c - PC_MG)) = w;
                    }
            } else if (cw == PC_MISC) {
                float* ng = (float*)(ws + WS_NG); float* lf = (float*)(ws + WS_LF);
#pragma unroll
                for (int ai = 0; ai < 2; ++ai)
#pragma unroll
                    for (int m = 0; m < 4; ++m) {
                        const int row = row0 + ai * 128 + m * 16;
                        const f32x4 a = acc[ai][bj][m][0], bq = acc[ai][bj][m][1];
                        if (fq < 3) {
                            float* o = ng + (size_t)row * 24 + 8 * fq;
                            *(f32x4*)o = (f32x4){sigmoidf_(a[0]), sigmoidf_(a[1]), sigmoidf_(a[2]), sigmoidf_(a[3])};
                            *(f32x4*)(o + 4) = (f32x4){sigmoidf_(bq[0]), sigmoidf_(bq[1]), sigmoidf_(bq[2]), sigmoidf_(bq[3])};
                        } else {
                            float* o = lf + (size_t)row * 8; float r[8];
#pragma unroll
                            for (int i = 0; i < 8; ++i) { const float x = (i < 4 ? a[i & 3] : bq[i & 3]) + fbias[i]; r[i] = fminf(x, 0.f) - log1pf(__expf(-fabsf(x))); }
                            *(f32x4*)o = (f32x4){r[0], r[1], r[2], r[3]}; *(f32x4*)(o + 4) = (f32x4){r[4], r[5], r[6], r[7]};
                        }
                    }
            }
        }
    }
};

template <bool ADD> struct EpiBranch {
    static constexpr bool PERM = true;
    const bf16* mg; bf16* out; int goff;
    __device__ __forceinline__ void operator()(AccRef acc, const Unit& u, int wr, int wc, int fr, int fq) const {
        const int row0 = u.pm * 256 + wr * 64 + fr, col0 = u.pn * 256 + wc * 32 + 8 * fq;
#pragma unroll
        for (int ai = 0; ai < 2; ++ai)
#pragma unroll
            for (int m = 0; m < 4; ++m) {
                const int row = row0 + ai * 128 + m * 16;
#pragma unroll
                for (int bj = 0; bj < 2; ++bj) {
                    const int c = col0 + bj * 128;
                    const v4u g = *(const v4u*)(mg + (size_t)row * 2048 + goff + c);
                    const f32x4 a = acc[ai][bj][m][0], bq = acc[ai][bj][m][1];
                    float r[8] = {bflo(g.x) * a[0], bfhi(g.x) * a[1], bflo(g.y) * a[2], bfhi(g.y) * a[3], bflo(g.z) * bq[0], bfhi(g.z) * bq[1], bflo(g.w) * bq[2], bfhi(g.w) * bq[3]};
                    if (ADD) { const v4u p = *(const v4u*)(out + (size_t)row * DM + c);
                        r[0] += bflo(p.x); r[1] += bfhi(p.x); r[2] += bflo(p.y); r[3] += bfhi(p.y); r[4] += bflo(p.z); r[5] += bfhi(p.z); r[6] += bflo(p.w); r[7] += bfhi(p.w); }
                    v4u w; w.x = cvt_pk_bf16(r[0], r[1]); w.y = cvt_pk_bf16(r[2], r[3]); w.z = cvt_pk_bf16(r[4], r[5]); w.w = cvt_pk_bf16(r[6], r[7]);
                    *(v4u*)(out + (size_t)row * DM + c) = w;
                }
            }
    }
};

struct EpiResF32 {
    static constexpr bool PERM = false;
    const float* xres; float* pre;
    __device__ __forceinline__ void operator()(AccRef acc, const Unit& u, int wr, int wc, int fr, int fq) const {
        const int row0 = u.pm * 256 + wr * 64 + fr, col0 = u.pn * 256 + wc * 32 + 4 * fq;
#pragma unroll
        for (int ai = 0; ai < 2; ++ai)
#pragma unroll
            for (int m = 0; m < 4; ++m) {
                const size_t off = (size_t)(row0 + ai * 128 + m * 16) * DM + col0;
#pragma unroll
                for (int bj = 0; bj < 2; ++bj)
#pragma unroll
                    for (int n = 0; n < 2; ++n) { const f32x4 x = *(const f32x4*)(xres + off + bj * 128 + n * 16); *(f32x4*)(pre + off + bj * 128 + n * 16) = x * DN_ALPHA + acc[ai][bj][m][n]; }
            }
    }
};

struct EpiSwiGLU {
    static constexpr bool PERM = true;
    bf16* hid; int ldh;
    __device__ __forceinline__ void operator()(AccRef acc, const Unit& u, int wr, int wc, int fr, int fq) const {
        const int row0 = u.pm * 256 + wr * 64 + fr, col0 = u.pn * 128 + wc * 32 + 8 * fq;
#pragma unroll
        for (int ai = 0; ai < 2; ++ai)
#pragma unroll
            for (int m = 0; m < 4; ++m) {
                float r[8];
#pragma unroll
                for (int n = 0; n < 2; ++n)
#pragma unroll
                    for (int i = 0; i < 4; ++i) { const float g = acc[ai][0][m][n][i], up = acc[ai][1][m][n][i]; r[n * 4 + i] = g * sigmoidf_(g) * up; }
                v4u w; w.x = cvt_pk_bf16(r[0], r[1]); w.y = cvt_pk_bf16(r[2], r[3]); w.z = cvt_pk_bf16(r[4], r[5]); w.w = cvt_pk_bf16(r[6], r[7]);
                *(v4u*)(hid + (size_t)(row0 + ai * 128 + m * 16) * ldh + col0) = w;
            }
    }
};

struct EpiPlainBf16 {
    static constexpr bool PERM = true;
    bf16* out;
    __device__ __forceinline__ void operator()(AccRef acc, const Unit& u, int wr, int wc, int fr, int fq) const {
        const int row0 = u.pm * 256 + wr * 64 + fr, col0 = u.pn * 256 + wc * 32 + 8 * fq;
#pragma unroll
        for (int ai = 0; ai < 2; ++ai)
#pragma unroll
            for (int m = 0; m < 4; ++m)
#pragma unroll
                for (int bj = 0; bj < 2; ++bj) {
                    const f32x4 a = acc[ai][bj][m][0], bq = acc[ai][bj][m][1];
                    v4u w; w.x = cvt_pk_bf16(a[0], a[1]); w.y = cvt_pk_bf16(a[2], a[3]); w.z = cvt_pk_bf16(bq[0], bq[1]); w.w = cvt_pk_bf16(bq[2], bq[3]);
                    *(v4u*)(out + (size_t)(row0 + ai * 128 + m * 16) * DM + col0 + bj * 128) = w;
                }
    }
};

struct Args { const float* in[21]; float* out; unsigned char* ws; int ph_lo, ph_hi; };
struct Frame { LAS unsigned char* lds; int vcu, G, wave; };
__device__ __forceinline__ int lane_id() { int l; asm volatile("v_mbcnt_lo_u32_b32 %0, -1, 0\n\tv_mbcnt_hi_u32_b32 %0, -1, %0" : "=v"(l)); return l; }
typedef __attribute__((address_space(4))) const Args CArgs;
__device__ __forceinline__ const CArgs* kargs() { const CArgs* p = (const CArgs*)__builtin_amdgcn_kernarg_segment_ptr(); asm volatile("" : "+s"(p)); return p; }
#define PHASE_IDS() int wave = F.wave; asm volatile("" : "+s"(wave)); int lane = lane_id(); asm volatile("" : "+v"(lane)); const int tid = wave * 64 + lane; (void)tid
enum { I_X = 0, I_WIN, I_PE, I_W1, I_W2, I_FB, I_WNSA, I_WFOX, I_WOUT, I_REL, I_LN1G, I_LN1B, I_LN2G, I_LN2B, I_DG, I_DU, I_DD, I_ROUT, I_MG, I_MU, I_MD };

struct SegDesc { const float* W; bf16* dst; int ldw, ncols, K, mode, roff; };
__device__ __forceinline__ SegDesc seg_desc(int s, const CArgs* a) {
    SegDesc d; unsigned char* ws = a->ws;
    if (s < 44) {
        const int L = s / 11, q = s % 11;
        if (q < 6) {
            const int sc[6] = {SC_Q, SC_KV, SC_FOX, SC_MG, SC_NG, SC_FF}, nc[6] = {512, 768, 1536, 2048, 24, 8}, ro[6] = {PC_Q, PC_KV, PC_FOX, PC_MG, PC_MISC, PC_MISC + 24};
            int scq = sc[0], ncq = nc[0], roq = ro[0];
#pragma unroll
            for (int i = 1; i < 6; ++i) if (q == i) { scq = sc[i]; ncq = nc[i]; roq = ro[i]; }
            d.W = a->in[I_WIN] + (size_t)L * DM * D_IN + scq; d.ldw = D_IN; d.ncols = ncq; d.K = DM; d.dst = (bf16*)(ws + WS_WIN) + (size_t)L * NPROJ * DM; d.mode = 0; d.roff = roq;
        } else if (q == 6) { d.W = a->in[I_WNSA] + (size_t)L * 512 * DM; d.ldw = DM; d.ncols = DM; d.K = 512; d.dst = (bf16*)(ws + WS_WNSA) + (size_t)L * DM * 512; d.mode = 0; d.roff = 0; }
        else if (q == 7) { d.W = a->in[I_WFOX] + (size_t)L * 512 * DM; d.ldw = DM; d.ncols = DM; d.K = 512; d.dst = (bf16*)(ws + WS_WFOX) + (size_t)L * DM * 512; d.mode = 0; d.roff = 0; }
        else if (q == 8) { d.W = a->in[I_WOUT] + (size_t)L * DM * DM; d.ldw = DM; d.ncols = DM; d.K = DM; d.dst = (bf16*)(ws + WS_WO) + (size_t)L * DM * DM; d.mode = 0; d.roff = 0; }
        else { const int kv = q - 9; d.W = a->in[I_W1] + (size_t)(L * 2 + kv) * 2048 * 128; d.ldw = 128; d.ncols = 128; d.K = 2048; d.dst = (bf16*)(ws + WS_WC1) + (size_t)(L * 2 + kv) * 128 * 2048; d.mode = 0; d.roff = 0; }
    } else if (s < 50) {
        const int j = (s - 44) / 3, q = (s - 44) % 3;
        if (q < 2) { d.W = a->in[q == 0 ? I_DG : I_DU] + (size_t)j * DM * FF_D; d.ldw = FF_D; d.ncols = FF_D; d.K = DM; d.dst = (bf16*)(ws + WS_WDGU) + (size_t)j * 2 * FF_D * DM; d.mode = 1; d.roff = q * 128; }
        else { d.W = a->in[I_DD] + (size_t)j * FF_D * DM; d.ldw = DM; d.ncols = DM; d.K = FF_D; d.dst = (bf16*)(ws + WS_WDD) + (size_t)j * DM * FF_D; d.mode = 0; d.roff = 0; }
    } else {
        const int je = (s - 50) / 3, q = (s - 50) % 3;
        if (q < 2) { d.W = a->in[q == 0 ? I_MG : I_MU] + (size_t)je * DM * FF_E; d.ldw = FF_E; d.ncols = FF_E; d.K = DM; d.dst = (bf16*)(ws + WS_WMGU) + (size_t)je * 2 * FF_E * DM; d.mode = 1; d.roff = q * 128; }
        else { d.W = a->in[I_MD] + (size_t)je * FF_E * DM; d.ldw = DM; d.ncols = DM; d.K = FF_E; d.dst = (bf16*)(ws + WS_WMD) + (size_t)je * DM * FF_E; d.mode = 0; d.roff = 0; }
    }
    return d;
}
constexpr int NSEG = 98;

__device__ __forceinline__ void p0_prologue(const Frame& F) {
    PHASE_IDS(); const CArgs* a = kargs();
    LAS float* scr = (LAS float*)(F.lds + wave * 16384);
    const int gw = F.vcu * NWAVES + wave, NGW = F.G * NWAVES;
    int base = 0;
    for (int s = 0; s < NSEG; ++s) {
        const SegDesc d = seg_desc(s, a);
        const int nblk = (d.ncols + 31) >> 5, n_items = (d.K >> 6) * nblk;
        int start = gw - (base % NGW); if (start < 0) start += NGW;
        for (int it = start; it < n_items; it += NGW) {
            const int kb = it / nblk, nb = it % nblk, k0 = 64 * kb, n0 = 32 * nb;
            const int nn = n0 + (lane & 31); const bool okn = nn < d.ncols;
#pragma unroll 8
            for (int i = 0; i < 32; ++i) { const int kk = 2 * i + (lane >> 5); scr[kk * 33 + (lane & 31)] = okn ? d.W[(size_t)(k0 + kk) * d.ldw + nn] : 0.f; }
            LDS_WAIT(); asm volatile("" ::: "memory");
            const int c = lane & 7;
            const int rbase = d.mode ? (d.roff + ((n0 >> 7) << 8) + (n0 & 127)) : (d.roff + n0);
#pragma unroll
            for (int j = 0; j < 4; ++j) { const int n = (lane >> 3) + 8 * j; const LAS float* sp = scr + (8 * c) * 33 + n;
                v4u o; o.x = pk2(sp[0 * 33], sp[1 * 33]); o.y = pk2(sp[2 * 33], sp[3 * 33]); o.z = pk2(sp[4 * 33], sp[5 * 33]); o.w = pk2(sp[6 * 33], sp[7 * 33]);
                if (n0 + n < d.ncols) *(GAS v4u*)(d.dst + (size_t)(rbase + n) * d.K + k0 + 8 * c) = o; }
            LDS_WAIT(); asm volatile("" ::: "memory");
        }
        base += n_items;
    }
    {
        constexpr int PADROWS = NPROJ - (PC_MISC + 32), V16_PER_L = PADROWS * DM * 2 / 16;
        const int gt = gw * 64 + lane, NGT = NGW * 64;
        for (int i = gt; i < DEPTH * V16_PER_L; i += NGT) { const int L = i / V16_PER_L, r = i % V16_PER_L;
            *((GAS v4u*)((bf16*)(a->ws + WS_WIN) + ((size_t)L * NPROJ + PC_MISC + 32) * DM) + r) = (v4u){0u, 0u, 0u, 0u}; }
        const float* x = a->in[I_X]; bf16* xb = (bf16*)(a->ws + WS_XB);
        for (int i = gt; i < M * DM / 8; i += NGT) { const f32x4 p = *((const GAS f32x4*)x + 2 * (size_t)i), q = *((const GAS f32x4*)x + 2 * (size_t)i + 1);
            v4u o; o.x = pk2(p[0], p[1]); o.y = pk2(p[2], p[3]); o.z = pk2(q[0], q[1]); o.w = pk2(q[2], q[3]); *((GAS v4u*)xb + i) = o; }
    }
    if (gw < 256) {
        const int lk = gw >> 5, sl = gw & 31;
        const float* pe = a->in[I_PE] + (size_t)lk * 2048 + sl * 64; const float* w1 = a->in[I_W1] + ((size_t)lk * 2048 + sl * 64) * 128;
        float a0 = 0.f, a1 = 0.f;
        for (int k = 0; k < 64; ++k) { const float p = pe[k]; a0 += p * w1[k * 128 + lane]; a1 += p * w1[k * 128 + 64 + lane]; }
        float* cbp = (float*)(a->ws + WS_CBP) + (size_t)gw * 128; cbp[lane] = a0; cbp[64 + lane] = a1;
    }
}

__device__ __forceinline__ float gelu_tanh(float x) { const float u = 0.7978845608028654f * (x + 0.044715f * x * x * x); return 0.5f * x * (1.f + tanhf(u)); }

__device__ __forceinline__ void p2_cmp_scan(const Frame& F, int L) {
    PHASE_IDS(); const CArgs* a = kargs(); unsigned char* ws = a->ws;
    typedef float f32x2_t __attribute__((ext_vector_type(2)));
    constexpr int A_OFF = 0, P_OFF = 36864, H_OFF = P_OFF + 65536, CB_OFF = H_OFF + 8192;
    for (int u = F.vcu; u < 256; u += F.G) {
        const int kv = u >> 7, bh = (u >> 3) & 15, rg = u & 7, i0 = 16 * rg;
        const bf16* src = (const bf16*)(ws + WS_KV6) + (size_t)kv * ((size_t)M * 128) + ((size_t)bh * SEQ + 16 * i0) * 64;
        for (int i = tid; i < 2176; i += 512) { const int tok = i >> 3, c = i & 7; *(LAS v4u*)(F.lds + A_OFF + tok * 128 + (tok >> 4) * 16 + c * 16) = *((const GAS v4u*)src + i); }
        if (tid < 128) { const float* cbp = (const float*)(ws + WS_CBP) + (size_t)(L * 2 + kv) * 32 * 128 + tid; float cb = 0.f;
            for (int s = 0; s < 32; ++s) cb += cbp[s * 128];
            ((LAS float*)(F.lds + CB_OFF))[tid] = cb; }
        __syncthreads();
        {
            const int row = lane & 15, kg = lane >> 4;
            const bf16* W = (const bf16*)(ws + WS_WC1) + ((size_t)(L * 2 + kv) * 128 + row) * 2048 + 256 * wave + 8 * kg;
            f32x4 acc[8];
#pragma unroll
            for (int nb = 0; nb < 8; ++nb) acc[nb] = (f32x4){0.f, 0.f, 0.f, 0.f};
#pragma unroll
            for (int ks = 0; ks < 8; ++ks) {
                const int k = 256 * wave + 32 * ks + 8 * kg, tok = 16 * row + (k >> 6);
                const bf16x8 af = *(const LAS bf16x8*)(F.lds + A_OFF + tok * 128 + (tok >> 4) * 16 + (k & 63) * 2);
#pragma unroll
                for (int nb = 0; nb < 8; ++nb) { const bf16x8 bfr = *(const GAS bf16x8*)(W + (size_t)nb * 16 * 2048 + ks * 32);
                    acc[nb] = __builtin_amdgcn_mfma_f32_16x16x32_bf16(af, bfr, acc[nb], 0, 0, 0); }
            }
            LAS float* part = (LAS float*)(F.lds + P_OFF) + wave * 2048;
#pragma unroll
            for (int nb = 0; nb < 8; ++nb)
#pragma unroll
                for (int r = 0; r < 4; ++r) part[(4 * kg + r) * 128 + 16 * nb + row] = acc[nb][r];
        }
        __syncthreads();
        {
            const int e = tid * 4; const LAS float* part = (const LAS float*)(F.lds + P_OFF) + e;
            f32x4 s = *(const LAS f32x4*)(F.lds + CB_OFF + (e & 127) * 4);
#pragma unroll
            for (int w = 0; w < 8; ++w) s += *(const LAS f32x4*)(part + w * 2048);
            *(LAS f32x4*)(F.lds + H_OFF + e * 4) = (f32x4){gelu_tanh(s[0]), gelu_tanh(s[1]), gelu_tanh(s[2]), gelu_tanh(s[3])};
        }
        __syncthreads();
        {
            const int i = tid >> 5, d = (tid & 31) * 2;
            const float* w2 = a->in[I_W2] + (size_t)(L * 2 + kv) * 128 * 64 + d; const LAS float* Hr = (const LAS float*)(F.lds + H_OFF) + i * 128;
            float o0 = 0.f, o1 = 0.f;
#pragma unroll 8
            for (int n = 0; n < 128; ++n) { const f32x2_t wv = *(const GAS f32x2_t*)(w2 + n * 64); const float hv = Hr[n]; o0 += hv * wv[0]; o1 += hv * wv[1]; }
            const bool ok = (i0 + i) < N_CMP;
            *(GAS unsigned*)((bf16*)(ws + (kv ? WS_VCC : WS_KCC)) + ((size_t)bh * 128 + i0 + i) * 64 + d) = ok ? pk2(o0, o1) : 0u;
        }
        __syncthreads();
    }
    const int gw = F.vcu * NWAVES + wave;
    if (gw < BATCH * FOX_H) {
        const int b = gw >> 3, h = gw & 7;
        const float* lf = (const float*)(ws + WS_LF) + ((size_t)b * SEQ + 32 * lane) * 8 + h;
        float loc = 0.f;
        for (int i = 0; i < 32; ++i) loc += lf[i * 8];
        float inc = loc;
#pragma unroll
        for (int o = 1; o < 64; o <<= 1) { const float t = __shfl_up(inc, o); if (lane >= o) inc += t; }
        float run = inc - loc;
        float* out = (float*)(ws + WS_NF2) + (size_t)gw * SEQ + 32 * lane;
        for (int i = 0; i < 32; ++i) { run += lf[i * 8]; out[i] = -run * LOG2E; }
    }
}

__device__ __forceinline__ void load_q64(const bf16* q, float (&qf)[64]) {
#pragma unroll
    for (int i = 0; i < 8; ++i) { const v4u v = *(const GAS v4u*)(q + 8 * i);
        qf[8 * i + 0] = bflo(v.x); qf[8 * i + 1] = bfhi(v.x); qf[8 * i + 2] = bflo(v.y); qf[8 * i + 3] = bfhi(v.y); qf[8 * i + 4] = bflo(v.z); qf[8 * i + 5] = bfhi(v.z); qf[8 * i + 6] = bflo(v.w); qf[8 * i + 7] = bfhi(v.w); }
}
__device__ __forceinline__ float dot64(const float (&qf)[64], const bf16* k) {
    float acc = 0.f;
#pragma unroll
    for (int i = 0; i < 8; ++i) { const v4u v = *(const GAS v4u*)(k + 8 * i);
        acc += qf[8 * i + 0] * bflo(v.x) + qf[8 * i + 1] * bfhi(v.x) + qf[8 * i + 2] * bflo(v.y) + qf[8 * i + 3] * bfhi(v.y) + qf[8 * i + 4] * bflo(v.z) + qf[8 * i + 5] * bfhi(v.z) + qf[8 * i + 6] * bflo(v.w) + qf[8 * i + 7] * bfhi(v.w); }
    return acc;
}
__device__ __forceinline__ void softmax_lds(LAS float* sc, int n, int lane, float mxl) {
    const float mx = wave_max(mxl);
    float l = 0.f;
    for (int i = lane; i < n; i += 64) { const float s = sc[i]; const float p = (s > -1e29f) ? exp2f(s - mx) : 0.f; sc[i] = p; l += p; }
    l = wave_sum(l);
    const float inv = 1.f / fmaxf(l, 1e-30f);
    for (int i = lane; i < n; i += 64) sc[i] *= inv;
}

__device__ __forceinline__ void p3_fox_naive(const Frame& F) {
    PHASE_IDS(); const CArgs* a = kargs(); unsigned char* ws = a->ws;
    LAS float* sc = (LAS float*)F.lds + wave * 2048;
    const int gw = F.vcu * NWAVES + wave, NGW = F.G * NWAVES;
    const bf16* FQ = (const bf16*)(ws + WS_FQKV); const bf16* FK = FQ + (size_t)M * 512; const bf16* FV = FK + (size_t)M * 512;
    for (int it = gw; it < BATCH * FOX_H * SEQ; it += NGW) {
        const int bh = it >> 11, t = it & 2047;
        float qf[64]; load_q64(FQ + ((size_t)bh * SEQ + t) * 64, qf);
        const float* nf = (const float*)(ws + WS_NF2) + (size_t)bh * SEQ; const float nft = nf[t];
        const bf16* kb = FK + (size_t)bh * SEQ * 64; const bf16* vb = FV + (size_t)bh * SEQ * 64;
        float mx = -1e30f;
        for (int s = lane; s <= t; s += 64) { const float v = dot64(qf, kb + (size_t)s * 64) + (nf[s] - nft); sc[s] = v; mx = fmaxf(mx, v); }
        softmax_lds(sc, t + 1, lane, mx);
        float o = 0.f;
        for (int s = 0; s <= t; ++s) o += sc[s] * bf2f(vb[(size_t)s * 64 + lane]);
        const int b = bh >> 3, h = bh & 7;
        ((bf16*)(ws + WS_YF))[((size_t)b * SEQ + t) * 512 + h * 64 + lane] = (bf16)f2bf(o);
    }
}

__device__ __forceinline__ void p3_nsa_naive(const Frame& F) {
    PHASE_IDS(); const CArgs* a = kargs(); unsigned char* ws = a->ws;
    const int half = wave >> 2, g = wave & 3;
    LAS float* sc = (LAS float*)F.lds + wave * 1024;
    LAS float* pc = (LAS float*)(F.lds + 32768) + half * 512;
    const bf16* QN = (const bf16*)(ws + WS_QN); const bf16* KV6 = (const bf16*)(ws + WS_KV6);
    const float* rel = a->in[I_REL];
    for (int it = blockIdx.x * 2 + half; it < BATCH * NSA_KVH * SEQ; it += 2 * F.G) {
        const int bk = it >> 11, t = it & 2047, b = bk >> 1, kvh = bk & 1, h = kvh * 4 + g, cur = t >> 6;
        float qf[64]; load_q64(QN + ((size_t)(b * 8 + h) * SEQ + t) * 64, qf);
        const float* ng = (const float*)(ws + WS_NG) + ((size_t)b * SEQ + t) * 24 + h * 3;
        const float g0 = ng[0], g1 = ng[1], g2 = ng[2];
        const bf16* kc = (const bf16*)(ws + WS_KCC) + (size_t)bk * 128 * 64; const bf16* vc = (const bf16*)(ws + WS_VCC) + (size_t)bk * 128 * 64;
        float mx = -1e30f;
        for (int c = lane; c < 128; c += 64) { const int ce = 16 * c + 31; float v = -1e30f;
            if (c < N_CMP && ce <= t) v = dot64(qf, kc + (size_t)c * 64) + rel[t5b(t - ce) * 8 + h] * LOG2E;
            sc[c] = v; mx = fmaxf(mx, v); }
        softmax_lds(sc, 128, lane, mx);
        float oc = 0.f;
        for (int c = 0; c < 128; ++c) oc += sc[c] * bf2f(vc[(size_t)c * 64 + lane]);
        pc[g * 128 + lane] = sc[lane]; pc[g * 128 + 64 + lane] = sc[64 + lane];
        __syncthreads();
        unsigned selmask;
        {
            float imp = -1.f;
            if (lane < 32) {
                const int j = lane;
                float P[5];
#pragma unroll
                for (int q = 0; q < 5; ++q) { const int c = 4 * j - 1 + q; P[q] = (c >= 0 && c < 128) ? ((pc[c] + pc[128 + c]) + (pc[256 + c] + pc[384 + c])) : 0.f; }
                const float v = P[1] + P[2] + P[3] + 0.5f * P[4] + 0.5f * P[0];
                const bool forced = (j == 0) || (j <= cur && j > cur - 2);
                imp = forced ? 1e4f : (j <= cur ? v : -1.f);
            }
            int rank = 0;
            for (int jj = 0; jj < 32; ++jj) { const float o = __shfl(imp, jj); rank += (o > imp || (o == imp && jj < lane)) ? 1 : 0; }
            selmask = (unsigned)(__ballot(lane < 32 && rank < 16) & 0xffffffffull);
        }
        __syncthreads();
        const bf16* ks = KV6 + (size_t)2 * M * 128 + (size_t)bk * SEQ * 64; const bf16* vs = KV6 + (size_t)3 * M * 128 + (size_t)bk * SEQ * 64;
        int nsel = 0; mx = -1e30f;
        for (int j = 0; j <= cur; ++j) if ((selmask >> j) & 1u) { const int pos = 64 * j + lane; float v = -1e30f;
            if (pos <= t) v = dot64(qf, ks + (size_t)pos * 64) + rel[t5b(t - pos) * 8 + h] * LOG2E;
            sc[nsel * 64 + lane] = v; mx = fmaxf(mx, v); ++nsel; }
        softmax_lds(sc, nsel * 64, lane, mx);
        float os = 0.f; { int q = 0;
            for (int j = 0; j <= cur; ++j) if ((selmask >> j) & 1u) { for (int i = 0; i < 64; ++i) os += sc[q * 64 + i] * bf2f(vs[(size_t)(64 * j + i) * 64 + lane]); ++q; } }
        const bf16* kw = KV6 + (size_t)4 * M * 128 + (size_t)bk * SEQ * 64; const bf16* vw = KV6 + (size_t)5 * M * 128 + (size_t)bk * SEQ * 64;
        const int lo = t - 511 > 0 ? t - 511 : 0, nw = t - lo + 1;
        mx = -1e30f;
        for (int i = lane; i < nw; i += 64) { const int pos = lo + i; const float v = dot64(qf, kw + (size_t)pos * 64) + rel[t5b(t - pos) * 8 + h] * LOG2E; sc[i] = v; mx = fmaxf(mx, v); }
        softmax_lds(sc, nw, lane, mx);
        float ow = 0.f;
        for (int i = 0; i < nw; ++i) ow += sc[i] * bf2f(vw[(size_t)(lo + i) * 64 + lane]);
        ((bf16*)(ws + WS_YN))[((size_t)b * SEQ + t) * 512 + h * 64 + lane] = (bf16)f2bf(g0 * oc + g1 * os + g2 * ow);
    }
}

template <int MODE, bool ROUTE, int LNG, int LNB>
__device__ __forceinline__ void ln_phase(const Frame& F, int L, int j) {
    PHASE_IDS(); const CArgs* a = kargs(); unsigned char* ws = a->ws; unsigned* ctl = (unsigned*)(ws + WS_CTL);
    const float* gam = a->in[LNG] + L * DM; const float* bet = a->in[LNB] + L * DM;
    const int gw = F.vcu * NWAVES + wave, NGW = F.G * NWAVES;
    LAS int* lcnt = (LAS int*)F.lds;
    LAS int* lrow = (LAS int*)(F.lds + 256);
    if (ROUTE) { if (tid < 16) lcnt[tid] = 0; __syncthreads(); }
    const float* pre = (const float*)(ws + WS_PRE); float* X = a->out; bf16* XB = (bf16*)(ws + WS_XB);
    f32x4 gv[4], bv[4];
#pragma unroll
    for (int q = 0; q < 4; ++q) { gv[q] = *((const GAS f32x4*)gam + lane + 64 * q); bv[q] = *((const GAS f32x4*)bet + lane + 64 * q); }
    int ri = 0;
    for (int m = gw; m < M; m += NGW, ++ri) {
        f32x4 v[4];
        if (MODE == 0) {
#pragma unroll
            for (int q = 0; q < 4; ++q) v[q] = *((const GAS f32x4*)(pre + (size_t)m * DM) + lane + 64 * q);
        } else {
            const int* ts = (const int*)(ws + WS_TOKS) + 2 * m; const float* tw = (const float*)(ws + WS_TOKW) + 2 * m;
            const int s0 = ts[0], s1 = ts[1]; const float w0 = tw[0], w1 = tw[1];
            const bf16* ys = (const bf16*)(ws + WS_XG);
#pragma unroll
            for (int q = 0; q < 4; ++q) {
                const f32x4 x = *((const GAS f32x4*)(X + (size_t)m * DM) + lane + 64 * q);
                const v2u y0 = *((const GAS v2u*)(ys + (size_t)s0 * DM) + lane + 64 * q), y1 = *((const GAS v2u*)(ys + (size_t)s1 * DM) + lane + 64 * q);
                v[q] = x * DN_ALPHA + (f32x4){bflo(y0.x), bfhi(y0.x), bflo(y0.y), bfhi(y0.y)} * w0 + (f32x4){bflo(y1.x), bfhi(y1.x), bflo(y1.y), bfhi(y1.y)} * w1;
            }
        }
        float s = 0.f;
#pragma unroll
        for (int q = 0; q < 4; ++q) s += (v[q][0] + v[q][1]) + (v[q][2] + v[q][3]);
        const float mean = wave_sum(s) * (1.f / DM); float s2 = 0.f;
#pragma unroll
        for (int q = 0; q < 4; ++q) { v[q] = v[q] - mean; s2 += (v[q][0] * v[q][0] + v[q][1] * v[q][1]) + (v[q][2] * v[q][2] + v[q][3] * v[q][3]); }
        const float rstd = 1.f / sqrtf(wave_sum(s2) * (1.f / DM) + LN_EPS);
#pragma unroll
        for (int q = 0; q < 4; ++q) { v[q] = v[q] * rstd * gv[q] + bv[q];
            *((GAS f32x4*)(X + (size_t)m * DM) + lane + 64 * q) = v[q];
            v2u o; o.x = pk2(v[q][0], v[q][1]); o.y = pk2(v[q][2], v[q][3]); *((GAS v2u*)(XB + (size_t)m * DM) + lane + 64 * q) = o; }
        if (ROUTE) {
            const float* R = a->in[I_ROUT] + (size_t)j * DM * NEXP;
            float lg[8];
#pragma unroll
            for (int e = 0; e < 8; ++e) lg[e] = 0.f;
#pragma unroll
            for (int q = 0; q < 4; ++q)
#pragma unroll
                for (int c = 0; c < 4; ++c) { const float xv = v[q][c]; const float* rr = R + (size_t)(4 * lane + 256 * q + c) * 8; const f32x4 r0 = *(const GAS f32x4*)rr, r1 = *(const GAS f32x4*)(rr + 4);
                    lg[0] += xv * r0[0]; lg[1] += xv * r0[1]; lg[2] += xv * r0[2]; lg[3] += xv * r0[3]; lg[4] += xv * r1[0]; lg[5] += xv * r1[1]; lg[6] += xv * r1[2]; lg[7] += xv * r1[3]; }
#pragma unroll
            for (int e = 0; e < 8; ++e) lg[e] = wave_sum(lg[e]);
            int e0 = 0; float l0 = lg[0];
#pragma unroll
            for (int e = 1; e < 8; ++e) if (lg[e] > l0) { l0 = lg[e]; e0 = e; }
            int e1 = -1; float l1 = -3.0e38f;
#pragma unroll
            for (int e = 0; e < 8; ++e) if (e != e0 && lg[e] > l1) { l1 = lg[e]; e1 = e; }
            const float w0 = 1.f / (1.f + __expf(l1 - l0));
            if (lane == 0) {
                int* te = (int*)(ws + WS_TOKE) + 2 * m; float* tw = (float*)(ws + WS_TOKW) + 2 * m;
                te[0] = e0; te[1] = e1; tw[0] = w0; tw[1] = 1.f - w0;
                const int p0 = __hip_atomic_fetch_add(&lcnt[e0], 1, __ATOMIC_RELAXED, __HIP_MEMORY_SCOPE_WORKGROUP), p1 = __hip_atomic_fetch_add(&lcnt[e1], 1, __ATOMIC_RELAXED, __HIP_MEMORY_SCOPE_WORKGROUP);
                LAS int* lr = lrow + (wave * 16 + ri) * 4; lr[0] = e0; lr[1] = e1; lr[2] = p0; lr[3] = p1;
            }
        }
    }
    if (ROUTE) {
        __syncthreads();
        if (tid < 8) lcnt[8 + tid] = (int)atomicAdd(ctl + CW_MOECNT + j * 64 + tid, (unsigned)lcnt[tid]);
        __syncthreads();
        ri = 0;
        for (int m = gw; m < M; m += NGW, ++ri) if (lane < 2) { LAS int* lr = lrow + (wave * 16 + ri) * 4; ((int*)(ws + WS_TOKP))[2 * m + lane] = lr[2 + lane] + lcnt[8 + lr[lane]]; }
    }
}

struct MoeTiles { int toff[9]; };
__device__ __forceinline__ void moe_tiles(unsigned* ctl, int j, int (&toff)[9]) {
    toff[0] = 0;
#pragma unroll
    for (int e = 0; e < 8; ++e) { const unsigned c = __hip_atomic_load(ctl + CW_MOECNT + j * 64 + e, __ATOMIC_RELAXED, __HIP_MEMORY_SCOPE_AGENT); toff[e + 1] = toff[e] + (int)((c + 255u) >> 8); }
}
__device__ __forceinline__ void moe_gather(const Frame& F, int j) {
    PHASE_IDS(); const CArgs* a = kargs(); unsigned char* ws = a->ws;
    int toff[9]; moe_tiles((unsigned*)(ws + WS_CTL), j, toff);
    const int gw = F.vcu * NWAVES + wave, NGW = F.G * NWAVES;
    const bf16* XB = (const bf16*)(ws + WS_XB); bf16* XG = (bf16*)(ws + WS_XG);
    for (int it = gw; it < 2 * M; it += NGW) {
        const int e = ((const int*)(ws + WS_TOKE))[it], p = ((const int*)(ws + WS_TOKP))[it];
        int tb = toff[0];
#pragma unroll
        for (int q = 1; q < 8; ++q) tb = (e == q) ? toff[q] : tb;
        const int slot = tb * 256 + p;
        if (lane == 0) ((int*)(ws + WS_TOKS))[it] = slot;
        const GAS v4u* src = (const GAS v4u*)(XB + (size_t)(it >> 1) * DM); GAS v4u* dst = (GAS v4u*)(XG + (size_t)slot * DM);
        dst[lane] = src[lane]; dst[64 + lane] = src[64 + lane];
    }
}

namespace att {
constexpr int KSTR = 1152, KT_BYTES = 8 * KSTR, VT_BYTES = 8192;
constexpr int L_K = 0, L_V = 2 * KT_BYTES, L_F = L_V + 2 * VT_BYTES, L_WSF = L_F + 512, L_LUT = L_WSF + 8 * 256, L_SEL = L_LUT + 4096, L_ACC = L_SEL + 256, L_OST = L_ACC, L_IMP = L_ACC + 32768, L_END = L_ACC + 65536;
static_assert(L_END <= RING_BYTES, "attention LDS map");
constexpr float MASKV = -3.0e30f, MINIT = -1.0e30f;
typedef short v4i16_t __attribute__((ext_vector_type(4)));
typedef short s16x4 __attribute__((ext_vector_type(4)));
__device__ __forceinline__ int crow(int r, int hi) { return (r & 3) + 8 * (r >> 2) + 4 * hi; }
__device__ __forceinline__ float swap_max(float m) { auto rr = __builtin_amdgcn_permlane32_swap(__float_as_uint(m), __float_as_uint(m), false, false); return fmaxf(__uint_as_float(rr[0]), __uint_as_float(rr[1])); }
__device__ __forceinline__ float swap_sum(float m) { auto rr = __builtin_amdgcn_permlane32_swap(__float_as_uint(m), __float_as_uint(m), false, false); return __uint_as_float(rr[0]) + __uint_as_float(rr[1]); }
__device__ __forceinline__ float swap_other(float m) { return __shfl_xor(m, 32); }
__device__ __forceinline__ unsigned cvtpk(float lo, float hi) { unsigned r; asm volatile("v_cvt_pk_bf16_f32 %0, %1, %2" : "=v"(r) : "v"(lo), "v"(hi)); return r; }

struct TileRegs { v4u k, v; f32x4 f; };
__device__ __forceinline__ void tile_issue(TileRegs& R, const bf16* kt, const bf16* vt, int tid) {
    R.k = *((const GAS v4u*)kt + tid); R.v = *((const GAS v4u*)vt + tid);
}
__device__ __forceinline__ void tile_store(const TileRegs& R, LAS unsigned char* lds, int buf, int tid) {
    const int row = tid >> 3, c = tid & 7;
    *(LAS v4u*)(lds + L_K + buf * KT_BYTES + c * KSTR + row * 16) = R.k;
    *(LAS v4u*)(lds + L_V + buf * VT_BYTES + (c >> 2) * 4096 + row * 64 + (c & 3) * 16) = R.v;
}
__device__ __forceinline__ void qkt(f32x16& p0, f32x16& p1, const LAS unsigned char* kb, const bf16x8 (&qr)[4], int r32, int hi) {
    p0 = (f32x16){}; p1 = (f32x16){};
#pragma unroll
    for (int d0 = 0; d0 < 4; ++d0) {
        const bf16x8 b0 = *(const LAS bf16x8*)(kb + (2 * d0 + hi) * KSTR + r32 * 16);
        const bf16x8 b1 = *(const LAS bf16x8*)(kb + (2 * d0 + hi) * KSTR + r32 * 16 + 512);
        p0 = __builtin_amdgcn_mfma_f32_32x32x16_bf16(b0, qr[d0], p0, 0, 0, 0);
        p1 = __builtin_amdgcn_mfma_f32_32x32x16_bf16(b1, qr[d0], p1, 0, 0, 0);
    }
}
__device__ __forceinline__ s16x4 vtr(const LAS unsigned char* p) { return __builtin_bit_cast(s16x4, __builtin_amdgcn_ds_read_tr16_b64_v4i16((LAS v4i16_t*)p)); }
__device__ __forceinline__ void pv(f32x16 (&o)[2], const LAS unsigned char* vb, const f32x16& p0, const f32x16& p1, int lane) {
    const int hi = lane >> 5;
    const LAS unsigned char* vp = vb + ((lane >> 4) & 1) * 32 + (lane & 3) * 8 + (4 * hi + ((lane & 15) >> 2)) * 64;
    v4u pw[4];
#pragma unroll
    for (int q = 0; q < 4; ++q) { pw[0][q] = cvtpk(p0[2 * q], p0[2 * q + 1]); pw[1][q] = cvtpk(p0[8 + 2 * q], p0[8 + 2 * q + 1]); pw[2][q] = cvtpk(p1[2 * q], p1[2 * q + 1]); pw[3][q] = cvtpk(p1[8 + 2 * q], p1[8 + 2 * q + 1]); }
#pragma unroll
    for (int d0 = 0; d0 < 2; ++d0)
#pragma unroll
        for (int ks = 0; ks < 4; ++ks) {
            const s16x4 lo = vtr(vp + d0 * 4096 + ks * 1024), hh = vtr(vp + d0 * 4096 + ks * 1024 + 512);
            const bf16x8 vf = (bf16x8){lo[0], lo[1], lo[2], lo[3], hh[0], hh[1], hh[2], hh[3]};
            o[d0] = __builtin_amdgcn_mfma_f32_32x32x16_bf16(__builtin_bit_cast(bf16x8, pw[ks]), vf, o[d0], 0, 0, 0);
        }
}
__device__ __forceinline__ void scale_rows(f32x16 (&o)[2], float f, LAS float* wsf, int r32, int hi) {
    if (hi == 0) wsf[r32] = f;
    asm volatile("s_waitcnt lgkmcnt(0)" ::: "memory");
#pragma unroll
    for (int k = 0; k < 4; ++k) { const f32x4 fv = *(const LAS f32x4*)(wsf + 8 * k + 4 * hi);
#pragma unroll
        for (int i = 0; i < 4; ++i) { o[0][4 * k + i] *= fv[i]; o[1][4 * k + i] *= fv[i]; } }
    asm volatile("s_waitcnt lgkmcnt(0)" ::: "memory");
}
__device__ __forceinline__ void axpy_rows(f32x16 (&acc)[2], const f32x16 (&o)[2], float f, LAS float* wsf, int r32, int hi) {
    if (hi == 0) wsf[r32] = f;
    asm volatile("s_waitcnt lgkmcnt(0)" ::: "memory");
#pragma unroll
    for (int k = 0; k < 4; ++k) { const f32x4 fv = *(const LAS f32x4*)(wsf + 8 * k + 4 * hi);
#pragma unroll
        for (int i = 0; i < 4; ++i) { acc[0][4 * k + i] += o[0][4 * k + i] * fv[i]; acc[1][4 * k + i] += o[1][4 * k + i] * fv[i]; } }
    asm volatile("s_waitcnt lgkmcnt(0)" ::: "memory");
}
template <int MODE>
__device__ __forceinline__ void acc_rows(f32x16 (&o)[2], float f, LAS float* wsf, LAS float* accw, int r32, int hi) {
    if (hi == 0) wsf[r32] = f;
    asm volatile("s_waitcnt lgkmcnt(0)" ::: "memory");
#pragma unroll
    for (int k = 0; k < 4; ++k) { const f32x4 fv = *(const LAS f32x4*)(wsf + 8 * k + 4 * hi);
#pragma unroll
        for (int i = 0; i < 4; ++i)
#pragma unroll
            for (int d0 = 0; d0 < 2; ++d0) { LAS float* p = accw + (8 * k + 4 * hi + i) * 64 + d0 * 32 + r32; const float v = o[d0][4 * k + i] * fv[i];
                if (MODE == 0) *p = v; else if (MODE == 1) *p += v; else o[d0][4 * k + i] = *p + v; } }
    asm volatile("s_waitcnt lgkmcnt(0)" ::: "memory");
}
__device__ __forceinline__ void softmax_pv(f32x16& p0, f32x16& p1, f32x16 (&o)[2], float& m, float& l, const LAS unsigned char* vb, LAS float* wsf, int lane) {
    const int r32 = lane & 31, hi = lane >> 5;
    float mt = fmaxf(p0[0], p1[0]);
#pragma unroll
    for (int r = 1; r < 16; ++r) mt = fmaxf(mt, fmaxf(p0[r], p1[r]));
    mt = swap_max(mt);
    const float mn = fmaxf(m, mt), alpha = __builtin_amdgcn_exp2f(m - mn);
    float s = 0.f;
#pragma unroll
    for (int r = 0; r < 16; ++r) { p0[r] = __builtin_amdgcn_exp2f(p0[r] - mn); p1[r] = __builtin_amdgcn_exp2f(p1[r] - mn); s += p0[r] + p1[r]; }
    l = l * alpha + s; m = mn;
    if (__any(alpha != 1.f)) scale_rows(o, alpha, wsf, r32, hi);
    pv(o, vb, p0, p1, lane);
}
__device__ __forceinline__ void store_rows(const f32x16 (&o)[2], LAS unsigned char* ost, bf16* dst, int pitch, int lane) {
    const int r32 = lane & 31, hi = lane >> 5;
    LAS bf16* stg = (LAS bf16*)ost;
#pragma unroll
    for (int r = 0; r < 16; ++r) { const int orow = crow(r, hi);
#pragma unroll
        for (int d0 = 0; d0 < 2; ++d0) stg[orow * 64 + d0 * 32 + r32] = (bf16)f2bf(o[d0][r]); }
    asm volatile("s_waitcnt lgkmcnt(0)" ::: "memory");
#pragma unroll
    for (int i = 0; i < 4; ++i) { const int row = i * 8 + (lane >> 3), ch = lane & 7; const v4u v = *(const LAS v4u*)(stg + row * 64 + ch * 8); *(GAS v4u*)(dst + (size_t)row * pitch + ch * 8) = v; }
    asm volatile("s_waitcnt lgkmcnt(0)" ::: "memory");
}
#define ATT_BAR() do { asm volatile("s_waitcnt vmcnt(0) lgkmcnt(0)" ::: "memory"); __builtin_amdgcn_s_barrier(); asm volatile("" ::: "memory"); } while (0)
#define ATT_LBAR() do { asm volatile("s_waitcnt lgkmcnt(0)" ::: "memory"); __builtin_amdgcn_s_barrier(); asm volatile("" ::: "memory"); } while (0)

__device__ __forceinline__ void fox_unit(LAS unsigned char* lds, unsigned char* ws, int bh, int qb, int tid_in) {
    int tid = tid_in; asm volatile("" : "+v"(tid));
    const int lane = tid & 63, wave = __builtin_amdgcn_readfirstlane(tid >> 6), r32 = lane & 31, hi = lane >> 5;
    const bf16* FQ = (const bf16*)(ws + WS_FQKV) + (size_t)bh * SEQ * 64; const bf16* FK = FQ + (size_t)M * 512; const bf16* FV = FK + (size_t)M * 512;
    const float* nf = (const float*)(ws + WS_NF2) + (size_t)bh * SEQ;
    LAS float* wsf = (LAS float*)(lds + L_WSF + wave * 256);
    const int q0 = 256 * qb + 32 * wave, qg = q0 + r32;
    bf16x8 qr[4];
#pragma unroll
    for (int d0 = 0; d0 < 4; ++d0) qr[d0] = *(const GAS bf16x8*)(FQ + (size_t)qg * 64 + 16 * d0 + 8 * hi);
    const int NT = 4 * qb + 4, mylast = (q0 + 31) >> 6;
    float m = MINIT, l = 0.f; f32x16 o[2]; o[0] = (f32x16){}; o[1] = (f32x16){};
    TileRegs R;
    tile_issue(R, FK, FV, tid); if (tid < 16) R.f = *((const GAS f32x4*)nf + tid);
    tile_store(R, lds, 0, tid); if (tid < 16) *(LAS f32x4*)(lds + L_F + tid * 16) = R.f;
    ATT_BAR();
    for (int t = 0; t < NT; ++t) {
        const int buf = t & 1;
        if (t + 1 < NT) { tile_issue(R, FK + (size_t)(t + 1) * 4096, FV + (size_t)(t + 1) * 4096, tid); if (tid < 16) R.f = *((const GAS f32x4*)(nf + (t + 1) * 64) + tid); }
        if (t <= mylast) {
            f32x16 p0, p1; qkt(p0, p1, lds + L_K + buf * KT_BYTES, qr, r32, hi);
            const LAS float* fb = (const LAS float*)(lds + L_F + buf * 256);
#pragma unroll
            for (int k = 0; k < 4; ++k) { const f32x4 f0 = *(const LAS f32x4*)(fb + 8 * k + 4 * hi), f1 = *(const LAS f32x4*)(fb + 32 + 8 * k + 4 * hi);
#pragma unroll
                for (int i = 0; i < 4; ++i) { p0[4 * k + i] += f0[i]; p1[4 * k + i] += f1[i]; } }
            if (64 * t + 63 > q0) {
                const int lim = qg - 64 * t;
#pragma unroll
                for (int r = 0; r < 16; ++r) { const int kv = crow(r, hi); if (kv > lim) p0[r] = MASKV; if (kv + 32 > lim) p1[r] = MASKV; }
            }
            softmax_pv(p0, p1, o, m, l, lds + L_V + buf * VT_BYTES, wsf, lane);
        }
        if (t + 1 < NT) { tile_store(R, lds, buf ^ 1, tid); if (tid < 16) *(LAS f32x4*)(lds + L_F + (buf ^ 1) * 256 + tid * 16) = R.f; }
        ATT_BAR();
    }
    l = swap_sum(l);
    scale_rows(o, 1.f / l, wsf, r32, hi);
    const int b = bh >> 3, h = bh & 7;
    store_rows(o, lds + L_OST + wave * 4096, (bf16*)(ws + WS_YF) + ((size_t)b * SEQ + q0) * 512 + h * 64, 512, lane);
}

template <bool NEAR>
__device__ __forceinline__ void nsa_scores(f32x16& p0, f32x16& p1, int dj, int tl, int hi, bool rowsel, int lim, const LAS float* lut, float cfar) {
#pragma unroll
    for (int r = 0; r < 16; ++r) {
        const int kv = crow(r, hi), rel0 = 64 * dj + tl - kv, rel1 = rel0 - 32;
        float b0 = cfar, b1 = cfar;
        if (NEAR) { b0 = lut[min(max(rel0, 0), 255)]; b1 = lut[min(max(rel1, 0), 255)]; }
        p0[r] = (rowsel && rel0 >= 0 && rel0 < lim) ? p0[r] + b0 : MASKV;
        p1[r] = (rowsel && rel1 >= 0 && rel1 < lim) ? p1[r] + b1 : MASKV;
    }
}

__device__ __forceinline__ void nsa_unit(LAS unsigned char* lds, unsigned char* ws, const float* relb, int bk, int cur, int tid_in) {
    int tid = tid_in; asm volatile("" : "+v"(tid));
    const int lane = tid & 63, wave = __builtin_amdgcn_readfirstlane(tid >> 6), r32 = lane & 31, hi = lane >> 5;
    const int g = wave & 3, th = wave >> 2, tl = 32 * th + r32, t = 64 * cur + tl, b = bk >> 1, kvh = bk & 1, h = 4 * kvh + g;
    LAS float* wsf = (LAS float*)(lds + L_WSF + wave * 256);
    LAS float* lutall = (LAS float*)(lds + L_LUT); const LAS float* lut = lutall + g * 256;
    LAS float* impP = (LAS float*)(lds + L_IMP); LAS unsigned* selm = (LAS unsigned*)(lds + L_SEL);
    const bf16* KV6 = (const bf16*)(ws + WS_KV6);
    for (int e = tid; e < 1024; e += 512) { const int gg = e >> 8, rel = e & 255; lutall[e] = relb[t5b(rel) * 8 + 4 * kvh + gg] * LOG2E; }
    const float cfar = relb[31 * 8 + h] * LOG2E;
    bf16x8 qr[4];
    { const bf16* Q = (const bf16*)(ws + WS_QN) + ((size_t)(b * 8 + h) * SEQ + t) * 64;
#pragma unroll
      for (int d0 = 0; d0 < 4; ++d0) qr[d0] = *(const GAS bf16x8*)(Q + 16 * d0 + 8 * hi); }
    const float* ngp = (const float*)(ws + WS_NG) + ((size_t)b * SEQ + t) * 24 + h * 3;
    const float g_c = ngp[0], g_s = ngp[1], g_w = ngp[2];
    f32x16 oc[2]; oc[0] = (f32x16){}; oc[1] = (f32x16){};
    LAS float* accw = (LAS float*)(lds + L_ACC + wave * 8192);
    {
        const bf16* kc = (const bf16*)(ws + WS_KCC) + (size_t)bk * 128 * 64; const bf16* vc = (const bf16*)(ws + WS_VCC) + (size_t)bk * 128 * 64;
        { TileRegs R0, R1; tile_issue(R0, kc, vc, tid); tile_issue(R1, kc + 4096, vc + 4096, tid);
          tile_store(R0, lds, 0, tid); tile_store(R1, lds, 1, tid); }
        ATT_BAR();
        const int ntc = cur > 15 ? 2 : 1;
#define CMP_SCORES(tt) do { qkt(p0, p1, lds + L_K + (tt) * KT_BYTES, qr, r32, hi); \
        _Pragma("unroll") for (int r = 0; r < 16; ++r) { const int c0 = 64 * (tt) + crow(r, hi), rel0 = t - (16 * c0 + 31), rel1 = rel0 - 512; \
            p0[r] = (rel0 >= 0) ? p0[r] + lut[min(rel0, 255)] : MASKV; \
            p1[r] = (rel1 >= 0 && c0 + 32 < N_CMP) ? p1[r] + lut[min(max(rel1, 0), 255)] : MASKV; } } while (0)
        float mx = MASKV, s = 0.f;
        for (int tt = 0; tt < ntc; ++tt) {
            f32x16 p0, p1; CMP_SCORES(tt);
            float mt = fmaxf(p0[0], p1[0]);
#pragma unroll
            for (int r = 1; r < 16; ++r) mt = fmaxf(mt, fmaxf(p0[r], p1[r]));
            mt = swap_max(mt);
            const float mn = fmaxf(mx, mt), mref = mn < -1e29f ? 0.f : mn;
            s *= __builtin_amdgcn_exp2f(fmaxf(mx, -1e30f) - fmaxf(mn, -1e30f));
#pragma unroll
            for (int r = 0; r < 16; ++r) s += __builtin_amdgcn_exp2f(p0[r] - mref) + __builtin_amdgcn_exp2f(p1[r] - mref);
            mx = mn;
        }
        s = swap_sum(s);
        const float mref = mx < -1e29f ? 0.f : mx, inv = 1.f / fmaxf(s, 1e-30f);
        LAS float* ip = impP + (size_t)(g * 64 + tl) * 32;
        float carry = 0.f;
        for (int tt = 0; tt < 2; ++tt) {
            if (tt < ntc) {
                f32x16 p0, p1; CMP_SCORES(tt);
#pragma unroll
                for (int r = 0; r < 16; ++r) { p0[r] = __builtin_amdgcn_exp2f(p0[r] - mref) * inv; p1[r] = __builtin_amdgcn_exp2f(p1[r] - mref) * inv; }
#pragma unroll
                for (int nn = 0; nn < 8; ++nn) { const f32x16& P = (nn >> 2) ? p1 : p0; const int k4 = 4 * (nn & 3);
                    const float pe = swap_other(P[k4 + 3]);
                    const float prev = hi ? pe : carry;
                    ip[2 * (8 * tt + nn) + hi] = (P[k4] + P[k4 + 1]) + (P[k4 + 2] + 0.5f * P[k4 + 3]) + 0.5f * prev;
                    carry = pe; }
                pv(oc, lds + L_V + tt * VT_BYTES, p0, p1, lane);
            } else {
#pragma unroll
                for (int nn = 0; nn < 8; ++nn) ip[2 * (8 * tt + nn) + hi] = 0.f;
            }
        }
#undef CMP_SCORES
    }
    ATT_LBAR();
    for (int i = 0; i < 8; ++i) {
        const int tok = 8 * wave + i;
        float imp = -1.f;
        if (lane < 32) { const int j = lane; const float v = (impP[(0 * 64 + tok) * 32 + j] + impP[(1 * 64 + tok) * 32 + j]) + (impP[(2 * 64 + tok) * 32 + j] + impP[(3 * 64 + tok) * 32 + j]);
            const bool forced = (j == 0) || (j <= cur && j > cur - 2);
            imp = forced ? 1e4f : (j <= cur ? v : -1.f); }
        int rank = 0;
        for (int jj = 0; jj < 32; ++jj) { const float ov = __shfl(imp, jj); rank += (ov > imp || (ov == imp && jj < lane)) ? 1 : 0; }
        const unsigned msk = (unsigned)(__ballot(lane < 32 && rank < 16) & 0xffffffffull);
        if (lane == 0) selm[tok] = msk;
    }
    ATT_LBAR();
    acc_rows<0>(oc, g_c, wsf, accw, r32, hi);
    const unsigned vismask = (cur >= 31) ? 0xffffffffu : ((2u << cur) - 1u);
    const unsigned mysel = selm[tl] & vismask;
    unsigned U = selm[lane] & vismask;
#pragma unroll
    for (int of = 1; of < 64; of <<= 1) U |= (unsigned)__shfl_xor((int)U, of);
    U = (unsigned)__builtin_amdgcn_readfirstlane((int)U);
    {
        const bf16* ks = KV6 + (size_t)2 * M * 128 + (size_t)bk * SEQ * 64; const bf16* vs = KV6 + (size_t)3 * M * 128 + (size_t)bk * SEQ * 64;
        float m = MINIT, l = 0.f; f32x16 o[2]; o[0] = (f32x16){}; o[1] = (f32x16){};
        unsigned rem = U; int j = __builtin_ctz(rem); rem &= rem - 1u;
        TileRegs R; tile_issue(R, ks + (size_t)j * 4096, vs + (size_t)j * 4096, tid); tile_store(R, lds, 0, tid);
        ATT_BAR();
        int buf = 0;
        for (;;) {
            const int jn = rem ? __builtin_ctz(rem) : -1; rem &= rem - 1u;
            if (jn >= 0) tile_issue(R, ks + (size_t)jn * 4096, vs + (size_t)jn * 4096, tid);
            {
                f32x16 p0, p1; qkt(p0, p1, lds + L_K + buf * KT_BYTES, qr, r32, hi);
                const int dj = cur - j; const bool rowsel = (mysel >> j) & 1u;
                if (dj <= 2) nsa_scores<true>(p0, p1, dj, tl, hi, rowsel, 1 << 30, lut, cfar);
                else nsa_scores<false>(p0, p1, dj, tl, hi, rowsel, 1 << 30, lut, cfar);
                softmax_pv(p0, p1, o, m, l, lds + L_V + buf * VT_BYTES, wsf, lane);
            }
            if (jn >= 0) tile_store(R, lds, buf ^ 1, tid);
            ATT_BAR();
            if (jn < 0) break;
            j = jn; buf ^= 1;
        }
        l = swap_sum(l);
        acc_rows<1>(o, g_s / l, wsf, accw, r32, hi);
    }
    {
        const bf16* kw = KV6 + (size_t)4 * M * 128 + (size_t)bk * SEQ * 64; const bf16* vw = KV6 + (size_t)5 * M * 128 + (size_t)bk * SEQ * 64;
        float m = MINIT, l = 0.f; f32x16 o[2]; o[0] = (f32x16){}; o[1] = (f32x16){};
        const int jlo = cur - 8 > 0 ? cur - 8 : 0;
        int j = cur;
        TileRegs R; tile_issue(R, kw + (size_t)j * 4096, vw + (size_t)j * 4096, tid); tile_store(R, lds, 0, tid);
        ATT_BAR();
        int buf = 0;
        for (;;) {
            const int jn = j - 1;
            if (jn >= jlo) tile_issue(R, kw + (size_t)jn * 4096, vw + (size_t)jn * 4096, tid);
            {
                f32x16 p0, p1; qkt(p0, p1, lds + L_K + buf * KT_BYTES, qr, r32, hi);
                const int dj = cur - j;
                if (dj <= 2) nsa_scores<true>(p0, p1, dj, tl, hi, true, 512, lut, cfar);
                else nsa_scores<false>(p0, p1, dj, tl, hi, true, 512, lut, cfar);
                softmax_pv(p0, p1, o, m, l, lds + L_V + buf * VT_BYTES, wsf, lane);
            }
            if (jn >= jlo) tile_store(R, lds, buf ^ 1, tid);
            ATT_BAR();
            if (jn < jlo) break;
            j = jn; buf ^= 1;
        }
        l = swap_sum(l);
        acc_rows<2>(o, g_w / l, wsf, accw, r32, hi);
        store_rows(o, (LAS unsigned char*)accw, (bf16*)(ws + WS_YN) + ((size_t)b * SEQ + 64 * cur + 32 * th) * 512 + h * 64, 512, lane);
    }
}
}

__device__ __forceinline__ void p3_attention(const Frame& F) {
    PHASE_IDS(); const CArgs* a = kargs(); unsigned char* ws = a->ws;
    for (int u = F.vcu; u < 512; u += F.G) { const int idx = u & 255, sec = u >> 8, bh = idx >> 2, s = idx & 3; att::fox_unit(F.lds, ws, bh, sec ? s : 7 - s, tid); }
    for (int u = F.vcu; u < 512; u += F.G) { const int idx = u & 255, sec = u >> 8, bk = idx >> 4, s = idx & 15; att::nsa_unit(F.lds, ws, a->in[I_REL], bk, sec ? s : 31 - s, tid); }
}

constexpr int PH_PER_LAYER = 10, NPHASES = 1 + DEPTH * PH_PER_LAYER;
#ifndef REP_P0
#define REP_P0 1
#endif
#ifndef REP_INPROJ
#define REP_INPROJ 1
#endif
#ifndef REP_P2
#define REP_P2 1
#endif
#ifndef REP_ATTN
#define REP_ATTN 1
#endif
#ifndef REP_BRANCH
#define REP_BRANCH 1
#endif
#ifndef REP_WO
#define REP_WO 1
#endif
#ifndef REP_LN
#define REP_LN 1
#endif
#ifndef REP_UP
#define REP_UP 1
#endif
#ifndef REP_DOWN
#define REP_DOWN 1
#endif
#define REPEAT(n) for (int rep_ = 0; rep_ < (n); ++rep_)
#ifndef NAIVE_ATTN
#define NAIVE_ATTN 0
#endif
#ifndef MK_SINGLE
#define MK_SINGLE 1
#endif

#define IN(k) (lo <= (k) && (k) < hi)
#define SEAM(k) do { if (IN(k) && IN((k) + 1)) { XcdBarrier b_ = bar; asm volatile("" : "+s"(b_.bar)); xcd_barrier(b_); } } while (0)
template <int L> __device__ __forceinline__ void layer_body(const Frame& F, const int lo, const int hi, const XcdBarrier& bar) {
        const int pb = 1 + PH_PER_LAYER * L, j = L >> 1; const bool moe = (L & 1) != 0;
        if (IN(pb + 0)) REPEAT(REP_INPROJ) {
            const CArgs* ka = kargs(); unsigned char* ws = ka->ws;
            pg8::Gemm g{(const bf16*)(ws + WS_XB), (const bf16*)(ws + WS_WIN) + (size_t)L * NPROJ * DM, DM, DM, DM};
            pg8::StaticOrder S; S.init(M / 256, NPROJ / 256, F.G, (int)blockIdx.x);
            EpiInProj E{ws, ka->in[I_FB] + L * 8};
            pg8::gemm_phase<EpiInProj, pg8::StaticOrder, true, true>(F.lds, g, S, E, F.wave);
        }
        SEAM(pb + 0);
        if (IN(pb + 1)) REPEAT(REP_P2) { p2_cmp_scan(F, L); }
        SEAM(pb + 1);
        if (IN(pb + 2)) REPEAT(REP_ATTN) {
#if NAIVE_ATTN
            p3_fox_naive(F); __syncthreads(); p3_nsa_naive(F);
#else
            p3_attention(F);
#endif
        }
        SEAM(pb + 2);
        if (IN(pb + 3)) REPEAT(REP_BRANCH) {
            const CArgs* ka = kargs(); unsigned char* ws = ka->ws;
            pg8::StaticOrder S; S.init(M / 256, DM / 256, F.G, (int)blockIdx.x);
            { pg8::Gemm g{(const bf16*)(ws + WS_YN), (const bf16*)(ws + WS_WNSA) + (size_t)L * DM * 512, 512, 512, 512};
              EpiBranch<false> E{(const bf16*)(ws + WS_MG), (bf16*)(ws + WS_MERGED), 0};
              pg8::gemm_phase<EpiBranch<false>, pg8::StaticOrder, false, true>(F.lds, g, S, E, F.wave); }
            VM_WAIT(); __syncthreads();
            { pg8::Gemm g{(const bf16*)(ws + WS_YF), (const bf16*)(ws + WS_WFOX) + (size_t)L * DM * 512, 512, 512, 512};
              EpiBranch<true> E{(const bf16*)(ws + WS_MG), (bf16*)(ws + WS_MERGED), 1024};
              pg8::gemm_phase<EpiBranch<true>, pg8::StaticOrder, false, true>(F.lds, g, S, E, F.wave); }
        }
        SEAM(pb + 3);
        if (IN(pb + 4)) REPEAT(REP_WO) {
            const CArgs* ka = kargs(); unsigned char* ws = ka->ws;
            pg8::Gemm g{(const bf16*)(ws + WS_MERGED), (const bf16*)(ws + WS_WO) + (size_t)L * DM * DM, DM, DM, DM};
            pg8::StaticOrder S; S.init(M / 256, DM / 256, F.G, (int)blockIdx.x);
            EpiResF32 E{L == 0 ? ka->in[I_X] : (const float*)ka->out, (float*)(ws + WS_PRE)};
            pg8::gemm_phase<EpiResF32, pg8::StaticOrder, false, true>(F.lds, g, S, E, F.wave);
        }
        SEAM(pb + 4);
        if (IN(pb + 5)) {
            if (moe) ln_phase<0, true, I_LN1G, I_LN1B>(F, L, j);
            else ln_phase<0, false, I_LN1G, I_LN1B>(F, L, j);
        }
        SEAM(pb + 5);
        if (IN(pb + 6) && moe) { moe_gather(F, j); }
        if (moe) SEAM(pb + 6);
        if (IN(pb + 7)) REPEAT(REP_UP) {
            const CArgs* ka = kargs(); unsigned char* ws = ka->ws;
            if (moe) {
                int toff[9]; moe_tiles((unsigned*)(ws + WS_CTL), j, toff);
                pg8::MoeOrder S; S.so.init(toff[8], 2 * FF_E / 256, F.G, (int)blockIdx.x);
                S.t1 = toff[1]; S.t2 = toff[2]; S.t3 = toff[3]; S.t4 = toff[4]; S.t5 = toff[5]; S.t6 = toff[6]; S.t7 = toff[7];
                pg8::Gemm g{(const bf16*)(ws + WS_XG), (const bf16*)(ws + WS_WMGU) + (size_t)j * NEXP * 2 * FF_E * DM, DM, DM, DM};
                EpiSwiGLU E{(bf16*)(ws + WS_HID), FF_E};
                pg8::gemm_phase<EpiSwiGLU, pg8::MoeOrder, true, true>(F.lds, g, S, E, F.wave);
            } else {
                pg8::Gemm g{(const bf16*)(ws + WS_XB), (const bf16*)(ws + WS_WDGU) + (size_t)j * 2 * FF_D * DM, DM, DM, DM};
                pg8::StaticOrder S; S.init(M / 256, 2 * FF_D / 256, F.G, (int)blockIdx.x);
                EpiSwiGLU E{(bf16*)(ws + WS_HID), FF_D};
                pg8::gemm_phase<EpiSwiGLU, pg8::StaticOrder, true, true>(F.lds, g, S, E, F.wave);
            }
        }
        SEAM(pb + 7);
        if (IN(pb + 8)) REPEAT(REP_DOWN) {
            const CArgs* ka = kargs(); unsigned char* ws = ka->ws;
            if (moe) {
                int toff[9]; moe_tiles((unsigned*)(ws + WS_CTL), j, toff);
                pg8::MoeOrder S; S.so.init(toff[8], DM / 256, F.G, (int)blockIdx.x);
                S.t1 = toff[1]; S.t2 = toff[2]; S.t3 = toff[3]; S.t4 = toff[4]; S.t5 = toff[5]; S.t6 = toff[6]; S.t7 = toff[7];
                pg8::Gemm g{(const bf16*)(ws + WS_HID), (const bf16*)(ws + WS_WMD) + (size_t)j * NEXP * DM * FF_E, FF_E, FF_E, FF_E};
                EpiPlainBf16 E{(bf16*)(ws + WS_XG)};
                pg8::gemm_phase<EpiPlainBf16, pg8::MoeOrder, true, true>(F.lds, g, S, E, F.wave);
            } else {
                pg8::Gemm g{(const bf16*)(ws + WS_HID), (const bf16*)(ws + WS_WDD) + (size_t)j * DM * FF_D, FF_D, FF_D, FF_D};
                pg8::StaticOrder S; S.init(M / 256, DM / 256, F.G, (int)blockIdx.x);
                EpiResF32 E{(const float*)ka->out, (float*)(ws + WS_PRE)};
                pg8::gemm_phase<EpiResF32, pg8::StaticOrder, false, true>(F.lds, g, S, E, F.wave);
            }
        }
        SEAM(pb + 8);
        if (IN(pb + 9)) REPEAT(REP_LN) {
            if (moe) ln_phase<1, false, I_LN2G, I_LN2B>(F, L, j);
            else ln_phase<0, false, I_LN2G, I_LN2B>(F, L, j);
        }
        SEAM(pb + 9);
    }

__global__ void __launch_bounds__(NWAVES * 64, 2) hybrid_fwd(Args args) {
    extern __shared__ __attribute__((aligned(16))) unsigned char lds[];
    Frame F;
    F.lds = (LAS unsigned char*)lds;
    F.wave = __builtin_amdgcn_readfirstlane((int)threadIdx.x >> 6);
    F.G = gridDim.x; { const int bx = blockIdx.x; F.vcu = (F.G % 8 == 0) ? (bx % 8) * (F.G / 8) + bx / 8 : bx; }
    for (int u = threadIdx.x; u < (LDS_BYTES - LDSCTL_OFF) / 4; u += NWAVES * 64) ((LAS unsigned*)(F.lds + LDSCTL_OFF))[u] = 0u;
    __syncthreads();
    const int lo = args.ph_lo, hi = args.ph_hi;
    XcdBarrier bar; bar.bar = (unsigned*)(args.ws + WS_CTL) + CW_BAR; bar.x = 0; bar.st = nullptr;
    if (hi - lo > 1) bar = xcd_barrier_post((unsigned*)(args.ws + WS_CTL) + CW_BAR, (volatile LAS unsigned*)(F.lds + MISC_OFF) + 8);

    if (IN(0)) { REPEAT(REP_P0) p0_prologue(F); }
    SEAM(0);

    layer_body<0>(F, lo, hi, bar); layer_body<1>(F, lo, hi, bar); layer_body<2>(F, lo, hi, bar); layer_body<3>(F, lo, hi, bar);
#undef IN
#undef SEAM
}

extern "C" void kernel_launch(void* const* d_in, const int* in_sizes, int n_in, void* d_out, int out_size, void* d_ws, size_t ws_size, hipStream_t stream) {
    static int grid = 0;
    if (grid == 0) {
        if (n_in != 21 || in_sizes[0] != M * DM || out_size != M * DM || ws_size < WS_END) { fprintf(stderr, "kernel_launch: unexpected shapes / workspace (n_in %d, ws %zu, need %zu); nothing launched\n", n_in, ws_size, (size_t)WS_END); grid = -1; return; }
        int dev = 0, cus = 0, per_cu = 0;
        if (hipGetDevice(&dev) != hipSuccess || hipDeviceGetAttribute(&cus, hipDeviceAttributeMultiprocessorCount, dev) != hipSuccess) { grid = -1; return; }
        if (hipFuncSetAttribute((const void*)hybrid_fwd, hipFuncAttributeMaxDynamicSharedMemorySize, LDS_BYTES) != hipSuccess) { fprintf(stderr, "kernel_launch: hipFuncSetAttribute failed\n"); grid = -1; return; }
        if (hipOccupancyMaxActiveBlocksPerMultiprocessor(&per_cu, (const void*)hybrid_fwd, NWAVES * 64, LDS_BYTES) != hipSuccess || per_cu < 1) { fprintf(stderr, "kernel_launch: occupancy query reports %d blocks per CU\n", per_cu); }
        (void)hipGetLastError();
        grid = cus;
    }
    if (grid < 0) return;
    if (hipMemsetAsync((char*)d_ws + WS_CTL, 0, CTL_ZERO_BYTES, stream) != hipSuccess) return;
    Args a{};
    for (int i = 0; i < 21; ++i) a.in[i] = (const float*)d_in[i];
    a.out = (float*)d_out; a.ws = (unsigned char*)d_ws;
#if MK_SINGLE
    a.ph_lo = 0; a.ph_hi = NPHASES;
    hipLaunchKernelGGL(hybrid_fwd, dim3(grid), dim3(NWAVES * 64), LDS_BYTES, stream, a);
#else
    for (int p = 0; p < NPHASES; ++p) {
        if (p >= 1) { const int L = (p - 1) / PH_PER_LAYER, k = (p - 1) % PH_PER_LAYER; if (k == 6 && !(L & 1)) continue; }
        a.ph_lo = p; a.ph_hi = p + 1;
        hipLaunchKernelGGL(hybrid_fwd, dim3(grid), dim3(NWAVES * 64), LDS_BYTES, stream, a);
    }
#endif
}
```

```cpp
#include <hip/hip_runtime.h>
#include <cstdio>
#include <cstdint>

namespace pg8 {
#define PG8_LAS __attribute__((address_space(3)))
typedef unsigned short bf16_t;
typedef short bf16x8 __attribute__((ext_vector_type(8)));
typedef float f32x4 __attribute__((ext_vector_type(4)));
typedef float f32x2 __attribute__((ext_vector_type(2)));
typedef unsigned u32x4 __attribute__((ext_vector_type(4)));
constexpr int BM = 256, BK = 64, HALF = 128, HTB = HALF * BK * 2, STAGE_BYTES = 8 * HTB, NXCD = 8, WGM = 8;

__host__ __device__ __forceinline__ int lds_byte(int r, int c) { const int st = (r >> 4) * 2 + (c >> 5), rr = r & 15, cc = c & 31, ob = rr * 64 + cc * 2; return st * 1024 + (ob ^ (((ob >> 9) & 1) << 5)); }
__host__ __device__ __forceinline__ void stage_rc(int b, int& R, int& C) { const int st = b / 1024, sb = b % 1024, swz = sb ^ (((sb >> 9) & 1) << 5); R = (st >> 1) * 16 + swz / 64; C = (st & 1) * 32 + (swz % 64) / 2; }
__host__ __device__ __forceinline__ int perm32(int rho) { const int n = rho >> 4, i = rho & 15; return 8 * (i >> 2) + 4 * n + (i & 3); }

struct Unit { int pm, pn, pb; };
struct Gemm { const bf16_t* A; const bf16_t* Bt; int lda, ldb, K; };

struct StaticOrder {
    int nM, nN, nwg, G, c;
    __device__ __forceinline__ void init(int nM_, int nN_, int G_, int c_) { nM = nM_; nN = nN_; nwg = nM * nN; G = G_; c = c_; }
    __device__ __forceinline__ bool next(int i, Unit& u) const {
        const long L = (long)i * G + c; if (L >= nwg) return false;
        int wgid = (int)L; { const int q = nwg / NXCD, r = nwg % NXCD, xcd = wgid % NXCD, off = wgid / NXCD; wgid = (xcd < r ? xcd * (q + 1) : r * (q + 1) + (xcd - r) * q) + off; }
        const int nig = WGM * nN, gid = wgid / nig, fm = gid * WGM, gsz = (nM - fm) < WGM ? (nM - fm) : WGM;
        u.pm = fm + ((wgid % nig) % gsz); u.pn = (wgid % nig) / gsz; u.pb = u.pn; return true;
    }
};
struct MoeOrder {
    StaticOrder so; int t1, t2, t3, t4, t5, t6, t7;
    __device__ __forceinline__ bool next(int i, Unit& u) const {
        if (!so.next(i, u)) return false;
        const int e = (u.pm >= t1) + (u.pm >= t2) + (u.pm >= t3) + (u.pm >= t4) + (u.pm >= t5) + (u.pm >= t6) + (u.pm >= t7);
        u.pb = e * so.nN + u.pn; return true;
    }
};

__device__ __forceinline__ unsigned cvt_pk_bf16(float lo, float hi) { unsigned r; asm volatile("v_cvt_pk_bf16_f32 %0, %1, %2" : "=v"(r) : "v"(lo), "v"(hi)); return r; }

template <class Epi, class Sched, bool ALIGN_EPI, bool SP2>
__device__ __forceinline__ void gemm_phase(PG8_LAS unsigned char* lds, const Gemm g, const Sched& S, const Epi& E, int wid_in) {
    int wid = wid_in; asm volatile("" : "+s"(wid));
    int lane; asm volatile("v_mbcnt_lo_u32_b32 %0, -1, 0\n\tv_mbcnt_hi_u32_b32 %0, -1, %0" : "=v"(lane));
    const int tid = wid * 64 + lane, wr = wid >> 2, wc = wid & 3, fr = lane & 15, fq = lane >> 4;
    const int K = g.K, nt = K / BK;
    unsigned voffA[2], voffB[2];
#pragma unroll
    for (int i = 0; i < 2; ++i) { int R, C; stage_rc(tid * 16 + i * 8192, R, C); const int Rb = Epi::PERM ? ((R & ~31) + perm32(R & 31)) : R;
        voffA[i] = (unsigned)(R * g.lda + C) * 2u; voffB[i] = (unsigned)(Rb * g.ldb + C) * 2u; }
    const size_t kstep = (size_t)(BK * 2);
    const size_t hstepA = (size_t)HALF * g.lda * 2, hstepB = (size_t)HALF * g.ldb * 2;
    const size_t tstepA = 2 * hstepA, tstepB = 2 * hstepB;
    const unsigned ldsw = (unsigned)wid * 1024u;
    const int aoff = lds_byte(wr * 64 + fr, fq * 8), boff = lds_byte(wc * 32 + fr, fq * 8);
#define PG8_SA(b, h) (((b) * 2 + (h)) * HTB)
#define PG8_SB(b, h) ((4 + (b) * 2 + (h)) * HTB)
#define PG8_STAGE(bufoff, gbase, voff) do { _Pragma("unroll") for (int _i = 0; _i < 2; ++_i) \
        __builtin_amdgcn_global_load_lds((const unsigned*)((const char*)(gbase) + (voff)[_i]), (PG8_LAS unsigned*)(lds + (bufoff) + ldsw + _i * 8192), 16, 0, 0); } while (0)
#define PG8_LDA(dst, b, h) do { _Pragma("unroll") for (int m = 0; m < 4; ++m) _Pragma("unroll") for (int k = 0; k < 2; ++k) dst[m][k] = *(const PG8_LAS bf16x8*)(lds + PG8_SA(b, h) + aoff + m * 2048 + k * 1024); } while (0)
#define PG8_LDB(dst, b, h) do { _Pragma("unroll") for (int n = 0; n < 2; ++n) _Pragma("unroll") for (int k = 0; k < 2; ++k) dst[n][k] = *(const PG8_LAS bf16x8*)(lds + PG8_SB(b, h) + boff + n * 2048 + k * 1024); } while (0)
#define PG8_MMA(ai, bj, At, Bt) do { __builtin_amdgcn_s_setprio(1); _Pragma("unroll") for (int m = 0; m < 4; ++m) _Pragma("unroll") for (int n = 0; n < 2; ++n) _Pragma("unroll") for (int k = 0; k < 2; ++k) \
        acc[ai][bj][m][n] = __builtin_amdgcn_mfma_f32_16x16x32_bf16(Bt[n][k], At[m][k], acc[ai][bj][m][n], 0, 0, 0); __builtin_amdgcn_s_setprio(0); } while (0)
#define PG8_WAIT_V(n) asm volatile("s_waitcnt vmcnt(" #n ")" ::: "memory")
#define PG8_WAIT_L(n) asm volatile("s_waitcnt lgkmcnt(" #n ")" ::: "memory")
#define PG8_BAR __builtin_amdgcn_s_barrier()
#define PG8_SCHED __builtin_amdgcn_sched_barrier(0)
    Unit cur, nxt; int ui = 0;
    if (!S.next(0, cur)) return;
    f32x4 acc[2][2][4][2];
#pragma unroll
    for (int a = 0; a < 2; ++a)
#pragma unroll
        for (int b = 0; b < 2; ++b)
#pragma unroll
            for (int m = 0; m < 4; ++m)
#pragma unroll
                for (int n = 0; n < 2; ++n) acc[a][b][m][n] = (f32x4){0.f, 0.f, 0.f, 0.f};
    bf16x8 At[4][2], B0[2][2], B1[2][2];
    const char* cA = (const char*)g.A + (size_t)cur.pm * tstepA; const char* cB = (const char*)g.Bt + (size_t)cur.pb * tstepB;
    if constexpr (SP2) {
        PG8_STAGE(PG8_SB(0, 0), cB, voffB); PG8_STAGE(PG8_SB(0, 1), cB + hstepB, voffB); PG8_STAGE(PG8_SA(0, 0), cA, voffA); PG8_STAGE(PG8_SA(0, 1), cA + hstepA, voffA);
        if (wr == 1) PG8_BAR;
        PG8_WAIT_V(2); PG8_BAR;
        PG8_STAGE(PG8_SB(1, 0), cB + kstep, voffB); PG8_STAGE(PG8_SA(1, 0), cA + kstep, voffA); PG8_STAGE(PG8_SB(1, 1), cB + hstepB + kstep, voffB);
        PG8_WAIT_V(6); PG8_BAR;
    } else {
        PG8_STAGE(PG8_SB(0, 0), cB, voffB); PG8_STAGE(PG8_SA(0, 0), cA, voffA); PG8_STAGE(PG8_SB(0, 1), cB + hstepB, voffB); PG8_STAGE(PG8_SA(0, 1), cA + hstepA, voffA);
        if (wr == 1) PG8_BAR;
        PG8_WAIT_V(4); PG8_BAR;
        PG8_STAGE(PG8_SB(1, 0), cB + kstep, voffB); PG8_STAGE(PG8_SA(1, 0), cA + kstep, voffA); PG8_STAGE(PG8_SB(1, 1), cB + hstepB + kstep, voffB);
        PG8_WAIT_V(6); PG8_BAR;
    }
    for (;;) {
        const bool has_next = S.next(ui + 1, nxt);
        const char* nA = has_next ? (const char*)g.A + (size_t)nxt.pm * tstepA : cA; const char* nB = has_next ? (const char*)g.Bt + (size_t)nxt.pb * tstepB : cB;
        for (int t = 0; t < nt; t += 2) {
            const bool last = (t == nt - 2);
            const char* a1 = cA + (size_t)(t + 1) * kstep;
            const char* a2 = last ? nA : cA + (size_t)(t + 2) * kstep; const char* b2 = last ? nB : cB + (size_t)(t + 2) * kstep;
            const char* a3 = a2 + kstep; const char* b3 = b2 + kstep;
            if constexpr (SP2) {
            PG8_LDB(B0, 0, 0); PG8_LDB(B1, 0, 1); PG8_SCHED; PG8_LDA(At, 0, 0); PG8_STAGE(PG8_SA(1, 1), a1 + hstepA, voffA);
            PG8_WAIT_V(8); PG8_WAIT_L(0); PG8_BAR; PG8_MMA(0, 0, At, B0); PG8_MMA(0, 1, At, B1); PG8_BAR; PG8_SCHED;
            PG8_LDA(At, 0, 1); PG8_STAGE(PG8_SB(0, 0), b2, voffB); PG8_STAGE(PG8_SB(0, 1), b2 + hstepB, voffB); PG8_STAGE(PG8_SA(0, 0), a2, voffA);
            PG8_WAIT_V(8); PG8_WAIT_L(0); PG8_BAR; PG8_MMA(1, 0, At, B0); PG8_MMA(1, 1, At, B1); PG8_BAR; PG8_SCHED;
            PG8_LDB(B0, 1, 0); PG8_LDB(B1, 1, 1); PG8_SCHED; PG8_LDA(At, 1, 0); PG8_STAGE(PG8_SA(0, 1), a2 + hstepA, voffA);
            PG8_WAIT_V(8); PG8_WAIT_L(0); PG8_BAR; PG8_MMA(0, 0, At, B0); PG8_MMA(0, 1, At, B1); PG8_BAR; PG8_SCHED;
            PG8_LDA(At, 1, 1); PG8_STAGE(PG8_SB(1, 0), b3, voffB); PG8_STAGE(PG8_SB(1, 1), b3 + hstepB, voffB); PG8_STAGE(PG8_SA(1, 0), a3, voffA);
            PG8_WAIT_V(8); PG8_WAIT_L(0); PG8_BAR; PG8_MMA(1, 0, At, B0); PG8_MMA(1, 1, At, B1); PG8_BAR; PG8_SCHED;
            } else {
            PG8_LDB(B0, 0, 0); PG8_SCHED; PG8_LDA(At, 0, 0); PG8_STAGE(PG8_SA(1, 1), a1 + hstepA, voffA);
            PG8_WAIT_L(8); PG8_BAR; PG8_WAIT_L(0); PG8_MMA(0, 0, At, B0); PG8_BAR; PG8_SCHED;
            PG8_LDB(B1, 0, 1); PG8_STAGE(PG8_SB(0, 0), b2, voffB);
            PG8_BAR; PG8_WAIT_L(0); PG8_MMA(0, 1, At, B1); PG8_BAR;
            PG8_LDA(At, 0, 1); PG8_STAGE(PG8_SA(0, 0), a2, voffA);
            PG8_BAR; PG8_WAIT_L(0); PG8_MMA(1, 0, At, B0); PG8_BAR; PG8_SCHED;
            PG8_STAGE(PG8_SB(0, 1), b2 + hstepB, voffB);
            PG8_WAIT_V(6); PG8_BAR; PG8_MMA(1, 1, At, B1); PG8_BAR;
            PG8_LDB(B0, 1, 0); PG8_SCHED; PG8_LDA(At, 1, 0); PG8_STAGE(PG8_SA(0, 1), a2 + hstepA, voffA);
            PG8_WAIT_L(8); PG8_BAR; PG8_WAIT_L(0); PG8_MMA(0, 0, At, B0); PG8_BAR; PG8_SCHED;
            PG8_LDB(B1, 1, 1); PG8_STAGE(PG8_SB(1, 0), b3, voffB);
            PG8_BAR; PG8_WAIT_L(0); PG8_MMA(0, 1, At, B1); PG8_BAR;
            PG8_LDA(At, 1, 1); PG8_STAGE(PG8_SA(1, 0), a3, voffA);
            PG8_BAR; PG8_WAIT_L(0); PG8_MMA(1, 0, At, B0); PG8_BAR; PG8_SCHED;
            PG8_STAGE(PG8_SB(1, 1), b3 + hstepB, voffB);
            PG8_WAIT_V(6); PG8_BAR; PG8_MMA(1, 1, At, B1); PG8_BAR;
            }
        }
        if constexpr (ALIGN_EPI) { if (wr == 0) PG8_BAR; }
        E(acc, cur, wr, wc, fr, fq);
        if (!has_next) break;
#pragma unroll
        for (int a = 0; a < 2; ++a)
#pragma unroll
            for (int b = 0; b < 2; ++b)
#pragma unroll
                for (int m = 0; m < 4; ++m)
#pragma unroll
                    for (int n = 0; n < 2; ++n) acc[a][b][m][n] = (f32x4){0.f, 0.f, 0.f, 0.f};
        cur = nxt; cA = nA; cB = nB; ++ui;
        if constexpr (ALIGN_EPI) { if (wr == 1) PG8_BAR; }
    }
    PG8_WAIT_V(0);
    if constexpr (!ALIGN_EPI) { if (wr == 0) PG8_BAR; }
    PG8_BAR;
#undef PG8_SA
#undef PG8_SB
#undef PG8_STAGE
#undef PG8_LDA
#undef PG8_LDB
#undef PG8_MMA
#undef PG8_WAIT_V
#undef PG8_WAIT_L
#undef PG8_BAR
#undef PG8_SCHED
}
}

constexpr int NWAVES = 8;
constexpr int BATCH = 8, SEQ = 2048, DM = 1024, DEPTH = 4, M = BATCH * SEQ;
constexpr int HD = 64, NSA_H = 8, NSA_KVH = 2, NSA_G = 4, FOX_H = 8;
constexpr int N_CMP = 127, CMP_HID = 128;
constexpr int D_IN = 4896, NPROJ = 5120;
constexpr int FF_D = 2816, FF_E = 3584, NEXP = 8;
constexpr int XG_ROWS = 34816;
constexpr float LN_EPS = 1e-5f, DN_ALPHA = 1.681792830507429f, LOG2E = 1.4426950408889634f;
constexpr int PC_Q = 0, PC_KV = 512, PC_FOX = 1280, PC_MG = 2816, PC_MISC = 4864;
constexpr int SC_Q = 0, SC_KV = 512, SC_NG = 1280, SC_FOX = 1304, SC_FF = 2840, SC_MG = 2848;

constexpr size_t MiB = 1u << 20;
constexpr size_t WS_CTL = 0, CTL_ZERO_BYTES = 1 * MiB;
constexpr size_t WS_CBP = 1 * MiB;
constexpr size_t WS_NG = 2 * MiB;
constexpr size_t WS_LF = 4 * MiB;
constexpr size_t WS_NF2 = 4 * MiB + 512 * 1024;
constexpr size_t WS_KCC = 5 * MiB;
constexpr size_t WS_VCC = 5 * MiB + 256 * 1024;
constexpr size_t WS_TOKE = 5 * MiB + 512 * 1024;
constexpr size_t WS_TOKW = WS_TOKE + 128 * 1024;
constexpr size_t WS_TOKP = WS_TOKW + 128 * 1024;
constexpr size_t WS_TOKS = WS_TOKP + 128 * 1024;
constexpr size_t WS_WIN = 8 * MiB;
constexpr size_t WS_WC1 = 48 * MiB;
constexpr size_t WS_WNSA = 52 * MiB;
constexpr size_t WS_WFOX = 56 * MiB;
constexpr size_t WS_WO = 60 * MiB;
constexpr size_t WS_WDGU = 68 * MiB;
constexpr size_t WS_WDD = 90 * MiB;
constexpr size_t WS_WMGU = 102 * MiB;
constexpr size_t WS_WMD = 326 * MiB;
constexpr size_t WS_XB = 438 * MiB;
constexpr size_t WS_PRE = 470 * MiB;
constexpr size_t WS_XG = 534 * MiB;
constexpr size_t WS_HID = 602 * MiB;
constexpr size_t WS_QN = 602 * MiB;
constexpr size_t WS_KV6 = 618 * MiB;
constexpr size_t WS_FQKV = 642 * MiB;
constexpr size_t WS_MG = 690 * MiB;
constexpr size_t WS_YN = 754 * MiB;
constexpr size_t WS_YF = 770 * MiB;
constexpr size_t WS_MERGED = 786 * MiB;
constexpr size_t WS_END = 840 * MiB;
static_assert(WS_HID + (size_t)XG_ROWS * FF_E * 2 <= WS_END && WS_MERGED + (size_t)M * DM * 2 <= WS_END, "ws map");
constexpr int CW_BAR = 4096;
constexpr int CW_MOECNT = 16384;

constexpr int RING_BYTES = 131072;
constexpr int LDSCTL_OFF = RING_BYTES, MISC_OFF = LDSCTL_OFF + 320;
constexpr int LDS_BYTES = 147456;

#define GAS __attribute__((address_space(1)))
#define LAS __attribute__((address_space(3)))
typedef unsigned short bf16;
typedef unsigned v4u __attribute__((ext_vector_type(4)));
typedef unsigned v2u __attribute__((ext_vector_type(2)));
typedef float f32x4 __attribute__((ext_vector_type(4)));
typedef float f32x16 __attribute__((ext_vector_type(16)));
typedef short bf16x8 __attribute__((ext_vector_type(8)));
#define LDS_WAIT() asm volatile("s_waitcnt lgkmcnt(0)" ::: "memory")
#define VM_WAIT() asm volatile("s_waitcnt vmcnt(0)" ::: "memory")
__device__ __forceinline__ unsigned f2bf(float f) { unsigned u = __builtin_bit_cast(unsigned, f); return (u + 0x7fffu + ((u >> 16) & 1u)) >> 16; }
__device__ __forceinline__ unsigned pk2(float lo, float hi) { return f2bf(lo) | (f2bf(hi) << 16); }
__device__ __forceinline__ float bf2f(unsigned v) { return __builtin_bit_cast(float, v << 16); }
__device__ __forceinline__ float bflo(unsigned w) { return __builtin_bit_cast(float, w << 16); }
__device__ __forceinline__ float bfhi(unsigned w) { return __builtin_bit_cast(float, w & 0xffff0000u); }
__device__ __forceinline__ float sigmoidf_(float x) { return 1.f / (1.f + __expf(-x)); }
__device__ __forceinline__ float wave_sum(float v) {
#pragma unroll
    for (int o = 1; o < 64; o <<= 1) v += __shfl_xor(v, o);
    return v;
}
__device__ __forceinline__ float wave_max(float v) {
#pragma unroll
    for (int o = 1; o < 64; o <<= 1) v = fmaxf(v, __shfl_xor(v, o));
    return v;
}
__constant__ unsigned char T5LUT[128] = {0, 1, 2, 3, 4, 5, 6, 7, 8, 9, 10, 11, 12, 13, 14, 15, 16, 16, 16, 17, 17, 18, 18, 18, 19, 19, 19, 20, 20, 20, 20, 21, 21, 21, 21, 22, 22, 22, 22, 22, 23, 23, 23, 23, 23, 23, 24, 24, 24, 24, 24, 24, 25, 25, 25, 25, 25, 25, 25, 26, 26, 26, 26, 26, 26, 26, 26, 27, 27, 27, 27, 27, 27, 27, 27, 27, 27, 28, 28, 28, 28, 28, 28, 28, 28, 28, 28, 29, 29, 29, 29, 29, 29, 29, 29, 29, 29, 29, 29, 30, 30, 30, 30, 30, 30, 30, 30, 30, 30, 30, 30, 30, 30, 31, 31, 31, 31, 31, 31, 31, 31, 31, 31, 31, 31, 31, 31, 31};
__device__ __forceinline__ int t5b(int n) { return n < 128 ? (int)T5LUT[n] : 31; }

#define XB_TMO      128
#define XB_XCNT(j)  (256  + 64 * (j))
#define XB_XSUB(j)  (1280 + 64 * (j))
#define XB_XGEN(j)  (2304 + 64 * (j))
#define XB_TOP      3328
#define XB_TOPGEN   3392
#define XCD_BAR_WORDS 3456
#define XB_SPIN_CAP (1u << 18)

__device__ __forceinline__ unsigned xb_ld(unsigned* p)              { return __hip_atomic_load(p, __ATOMIC_RELAXED, __HIP_MEMORY_SCOPE_AGENT); }
__device__ __forceinline__ unsigned xb_add(unsigned* p, unsigned v) { return __hip_atomic_fetch_add(p, v, __ATOMIC_RELAXED, __HIP_MEMORY_SCOPE_AGENT); }
__device__ __forceinline__ unsigned xb_xcc_id() { return (unsigned)__builtin_amdgcn_s_getreg((3 << 11) | 20) & 0xFu; }
#define XB_SPIN(cond, bar) do { unsigned _sp = 0; while (cond) { __builtin_amdgcn_s_sleep(1); \
    if ((++_sp & 255u) == 0u) { if (xb_ld(&(bar)[XB_TMO])) break; if (_sp > XB_SPIN_CAP) { atomicAdd(&(bar)[XB_TMO], 1u); break; } } } } while (0)

struct XcdBarrier {
    unsigned* bar; unsigned x;
    volatile LAS unsigned* st;
};

__device__ __forceinline__ XcdBarrier xcd_barrier_post(unsigned* bar, volatile LAS unsigned* st) {
    XcdBarrier b; b.bar = bar; b.x = xb_xcc_id(); b.st = st;
    if (threadIdx.x == 0) (void)xb_add(&bar[XB_XCNT(b.x)], 1u);
    return b;
}
__device__ __forceinline__ void xcd_barrier_complete(unsigned* bar, unsigned x, unsigned& nloc, unsigned& nx) {
    const unsigned G = gridDim.x * gridDim.y * gridDim.z;
    unsigned sum, cnt, mine, sp = 0u;
    for (;;) {
        sum = 0u; cnt = 0u; mine = 0u;
#pragma unroll
        for (unsigned j = 0; j < 16; ++j) { const unsigned c = xb_ld(&bar[XB_XCNT(j)]); sum += c; cnt += (c > 0u) ? 1u : 0u; mine = (j == x) ? c : mine; }
        if (sum == G) break;
        __builtin_amdgcn_s_sleep(1);
        if ((++sp & 255u) == 0u) { if (xb_ld(&bar[XB_TMO])) break; if (sp > XB_SPIN_CAP) { atomicAdd(&bar[XB_TMO], 1u); break; } }
    }
    nloc = mine > 0u ? mine : 1u; nx = cnt > 0u ? cnt : 1u;
}

__device__ __forceinline__ void xcd_barrier(const XcdBarrier& b) {
    asm volatile("s_waitcnt vmcnt(0)" ::: "memory");
    __syncthreads();
    if (threadIdx.x == 0) {
        unsigned* bar = b.bar;
        __builtin_amdgcn_s_waitcnt(0);
        unsigned nloc = b.st[0], nx = b.st[1];
        if (nloc == 0u) { xcd_barrier_complete(bar, b.x, nloc, nx); b.st[0] = nloc; b.st[1] = nx; }
        const unsigned old = xb_add(&bar[XB_XSUB(b.x)], 1u);
        const unsigned gen = old / nloc;
        if (old + 1u == (gen + 1u) * nloc) {
            __builtin_amdgcn_fence(__ATOMIC_RELEASE, "agent");
            asm volatile("s_waitcnt vmcnt(0)" ::: "memory");
            const unsigned og = xb_add(&bar[XB_TOP], 1u);
            const unsigned tg = og / nx;
            if (og + 1u == (tg + 1u) * nx) xb_add(&bar[XB_TOPGEN], 1u);
            else XB_SPIN(xb_ld(&bar[XB_TOPGEN]) == tg, bar);
            __builtin_amdgcn_fence(__ATOMIC_ACQUIRE, "agent");
            xb_add(&bar[XB_XGEN(b.x)], 1u);
            asm volatile("s_waitcnt vmcnt(0)" ::: "memory");
        } else {
            XB_SPIN(xb_ld(&bar[XB_XGEN(b.x)]) == gen, bar);
            __builtin_amdgcn_fence(__ATOMIC_ACQUIRE, "agent");
            asm volatile("s_waitcnt vmcnt(0)" ::: "memory");
        }
    }
    __syncthreads();
}

using pg8::Unit; using pg8::cvt_pk_bf16;
typedef const f32x4 (&AccRef)[2][2][4][2];

struct EpiInProj {
    static constexpr bool PERM = true;
    unsigned char* ws; const float* fbias;
    __device__ __forceinline__ void operator()(AccRef acc, const Unit& u, int wr, int wc, int fr, int fq) const {
        const int row0 = u.pm * 256 + wr * 64 + fr;
#pragma unroll
        for (int bj = 0; bj < 2; ++bj) {
            const int cw = u.pn * 256 + bj * 128 + wc * 32;
            const int c = cw + 8 * fq;
            if (cw < PC_MG) {
                bf16* base; int nh, head; float sc = 1.f;
                if (cw < PC_KV) { base = (bf16*)(ws + WS_QN); nh = 8; head = c >> 6; sc = 0.125f * LOG2E; }
                else if (cw < PC_FOX) { const int cc = c - PC_KV; base = (bf16*)(ws + WS_KV6) + (size_t)(cc >> 7) * ((size_t)M * 128); nh = 2; head = (cc >> 6) & 1; }
                else { const int cc = c - PC_FOX; const int which = cc >> 9; base = (bf16*)(ws + WS_FQKV) + (size_t)which * ((size_t)M * 512); nh = 8; head = (cc >> 6) & 7; sc = (which == 0) ? 0.125f * LOG2E : 1.f; }
                const int d = c & 63;
#pragma unroll
                for (int ai = 0; ai < 2; ++ai)
#pragma unroll
                    for (int m = 0; m < 4; ++m) {
                        const int row = row0 + ai * 128 + m * 16, b = row >> 11, s = row & 2047;
                        const f32x4 v0 = acc[ai][bj][m][0] * sc, v1 = acc[ai][bj][m][1] * sc;
                        v4u w; w.x = cvt_pk_bf16(v0[0], v0[1]); w.y = cvt_pk_bf16(v0[2], v0[3]); w.z = cvt_pk_bf16(v1[0], v1[1]); w.w = cvt_pk_bf16(v1[2], v1[3]);
                        *(v4u*)(base + ((size_t)(b * nh + head) * SEQ + s) * 64 + d) = w;
                    }
            } else if (cw < PC_MISC) {
                bf16* mg = (bf16*)(ws + WS_MG);
#pragma unroll
                for (int ai = 0; ai < 2; ++ai)
#pragma unroll
                    for (int m = 0; m < 4; ++m) {
                        const int row = row0 + ai * 128 + m * 16;
                        const f32x4 a = acc[ai][bj][m][0], bq = acc[ai][bj][m][1];
                        v4u w; w.x = cvt_pk_bf16(sigmoidf_(a[0]), sigmoidf_(a[1])); w.y = cvt_pk_bf16(sigmoidf_(a[2]), sigmoidf_(a[3]));
                        w.z = cvt_pk_bf16(sigmoidf_(bq[0]), sigmoidf_(bq[1])); w.w = cvt_pk_bf16(sigmoidf_(bq[2]), sigmoidf_(bq[3]));
                        *(v4u*)(mg + (size_t)row * 2048 + (c - PC_MG)) = w;
                    }
            } else if (cw == PC_MISC) {
                float* ng = (float*)(ws + WS_NG); float* lf = (float*)(ws + WS_LF);
#pragma unroll
                for (int ai = 0; ai < 2; ++ai)
#pragma unroll
                    for (int m = 0; m < 4; ++m) {
                        const int row = row0 + ai * 128 + m * 16;
                        const f32x4 a = acc[ai][bj][m][0], bq = acc[ai][bj][m][1];
                        if (fq < 3) {
                            float* o = ng + (size_t)row * 24 + 8 * fq;
                            *(f32x4*)o = (f32x4){sigmoidf_(a[0]), sigmoidf_(a[1]), sigmoidf_(a[2]), sigmoidf_(a[3])};
                            *(f32x4*)(o + 4) = (f32x4){sigmoidf_(bq[0]), sigmoidf_(bq[1]), sigmoidf_(bq[2]), sigmoidf_(bq[3])};
                        } else {
                            float* o = lf + (size_t)row * 8; float r[8];
#pragma unroll
                            for (int i = 0; i < 8; ++i) { const float x = (i < 4 ? a[i & 3] : bq[i & 3]) + fbias[i]; r[i] = fminf(x, 0.f) - log1pf(__expf(-fabsf(x))); }
                            *(f32x4*)o = (f32x4){r[0], r[1], r[2], r[3]}; *(f32x4*)(o + 4) = (f32x4){r[4], r[5], r[6], r[7]};
                        }
                    }
            }
        }
    }
};

template <bool ADD> struct EpiBranch {
    static constexpr bool PERM = true;
    const bf16* mg; bf16* out; int goff;
    __device__ __forceinline__ void operator()(AccRef acc, const Unit& u, int wr, int wc, int fr, int fq) const {
        const int row0 = u.pm * 256 + wr * 64 + fr, col0 = u.pn * 256 + wc * 32 + 8 * fq;
#pragma unroll
        for (int ai = 0; ai < 2; ++ai)
#pragma unroll
            for (int m = 0; m < 4; ++m) {
                const int row = row0 + ai * 128 + m * 16;
#pragma unroll
                for (int bj = 0; bj < 2; ++bj) {
                    const int c = col0 + bj * 128;
                    const v4u g = *(const v4u*)(mg + (size_t)row * 2048 + goff + c);
                    const f32x4 a = acc[ai][bj][m][0], bq = acc[ai][bj][m][1];
                    float r[8] = {bflo(g.x) * a[0], bfhi(g.x) * a[1], bflo(g.y) * a[2], bfhi(g.y) * a[3], bflo(g.z) * bq[0], bfhi(g.z) * bq[1], bflo(g.w) * bq[2], bfhi(g.w) * bq[3]};
                    if (ADD) { const v4u p = *(const v4u*)(out + (size_t)row * DM + c);
                        r[0] += bflo(p.x); r[1] += bfhi(p.x); r[2] += bflo(p.y); r[3] += bfhi(p.y); r[4] += bflo(p.z); r[5] += bfhi(p.z); r[6] += bflo(p.w); r[7] += bfhi(p.w); }
                    v4u w; w.x = cvt_pk_bf16(r[0], r[1]); w.y = cvt_pk_bf16(r[2], r[3]); w.z = cvt_pk_bf16(r[4], r[5]); w.w = cvt_pk_bf16(r[6], r[7]);
                    *(v4u*)(out + (size_t)row * DM + c) = w;
                }
            }
    }
};

struct EpiResF32 {
    static constexpr bool PERM = false;
    const float* xres; float* pre;
    __device__ __forceinline__ void operator()(AccRef acc, const Unit& u, int wr, int wc, int fr, int fq) const {
        const int row0 = u.pm * 256 + wr * 64 + fr, col0 = u.pn * 256 + wc * 32 + 4 * fq;
#pragma unroll
        for (int ai = 0; ai < 2; ++ai)
#pragma unroll
            for (int m = 0; m < 4; ++m) {
                const size_t off = (size_t)(row0 + ai * 128 + m * 16) * DM + col0;
#pragma unroll
                for (int bj = 0; bj < 2; ++bj)
#pragma unroll
                    for (int n = 0; n < 2; ++n) { const f32x4 x = *(const f32x4*)(xres + off + bj * 128 + n * 16); *(f32x4*)(pre + off + bj * 128 + n * 16) = x * DN_ALPHA + acc[ai][bj][m][n]; }
            }
    }
};

struct EpiSwiGLU {
    static constexpr bool PERM = true;
    bf16* hid; int ldh;
    __device__ __forceinline__ void operator()(AccRef acc, const Unit& u, int wr, int wc, int fr, int fq) const {
        const int row0 = u.pm * 256 + wr * 64 + fr, col0 = u.pn * 128 + wc * 32 + 8 * fq;
#pragma unroll
        for (int ai = 0; ai < 2; ++ai)
#pragma unroll
            for (int m = 0; m < 4; ++m) {
                float r[8];
#pragma unroll
                for (int n = 0; n < 2; ++n)
#pragma unroll
                    for (int i = 0; i < 4; ++i) { const float g = acc[ai][0][m][n][i], up = acc[ai][1][m][n][i]; r[n * 4 + i] = g * sigmoidf_(g) * up; }
                v4u w; w.x = cvt_pk_bf16(r[0], r[1]); w.y = cvt_pk_bf16(r[2], r[3]); w.z = cvt_pk_bf16(r[4], r[5]); w.w = cvt_pk_bf16(r[6], r[7]);
                *(v4u*)(hid + (size_t)(row0 + ai * 128 + m * 16) * ldh + col0) = w;
            }
    }
};

struct EpiPlainBf16 {
    static constexpr bool PERM = true;
    bf16* out;
    __device__ __forceinline__ void operator()(AccRef acc, const Unit& u, int wr, int wc, int fr, int fq) const {
        const int row0 = u.pm * 256 + wr * 64 + fr, col0 = u.pn * 256 + wc * 32 + 8 * fq;
#pragma unroll
        for (int ai = 0; ai < 2; ++ai)
#pragma unroll
            for (int m = 0; m < 4; ++m)
#pragma unroll
                for (int bj = 0; bj < 2; ++bj) {
                    const f32x4 a = acc[ai][bj][m][0], bq = acc[ai][bj][m][1];
                    v4u w; w.x = cvt_pk_bf16(a[0], a[1]); w.y = cvt_pk_bf16(a[2], a[3]); w.z = cvt_pk_bf16(bq[0], bq[1]); w.w = cvt_pk_bf16(bq[2], bq[3]);
                    *(v4u*)(out + (size_t)(row0 + ai * 128 + m * 16) * DM + col0 + bj * 128) = w;
                }
    }
};

struct Args { const float* in[21]; float* out; unsigned char* ws; int ph_lo, ph_hi; };
struct Frame { LAS unsigned char* lds; int vcu, G, wave; };
__device__ __forceinline__ int lane_id() { int l; asm volatile("v_mbcnt_lo_u32_b32 %0, -1, 0\n\tv_mbcnt_hi_u32_b32 %0, -1, %0" : "=v"(l)); return l; }
typedef __attribute__((address_space(4))) const Args CArgs;
__device__ __forceinline__ const CArgs* kargs() { const CArgs* p = (const CArgs*)__builtin_amdgcn_kernarg_segment_ptr(); asm volatile("" : "+s"(p)); return p; }
#define PHASE_IDS() int wave = F.wave; asm volatile("" : "+s"(wave)); int lane = lane_id(); asm volatile("" : "+v"(lane)); const int tid = wave * 64 + lane; (void)tid
enum { I_X = 0, I_WIN, I_PE, I_W1, I_W2, I_FB, I_WNSA, I_WFOX, I_WOUT, I_REL, I_LN1G, I_LN1B, I_LN2G, I_LN2B, I_DG, I_DU, I_DD, I_ROUT, I_MG, I_MU, I_MD };

struct SegDesc { const float* W; bf16* dst; int ldw, ncols, K, mode, roff; };
__device__ __forceinline__ SegDesc seg_desc(int s, const CArgs* a) {
    SegDesc d; unsigned char* ws = a->ws;
    if (s < 44) {
        const int L = s / 11, q = s % 11;
        if (q < 6) {
            const int sc[6] = {SC_Q, SC_KV, SC_FOX, SC_MG, SC_NG, SC_FF}, nc[6] = {512, 768, 1536, 2048, 24, 8}, ro[6] = {PC_Q, PC_KV, PC_FOX, PC_MG, PC_MISC, PC_MISC + 24};
            int scq = sc[0], ncq = nc[0], roq = ro[0];
#pragma unroll
            for (int i = 1; i < 6; ++i) if (q == i) { scq = sc[i]; ncq = nc[i]; roq = ro[i]; }
            d.W = a->in[I_WIN] + (size_t)L * DM * D_IN + scq; d.ldw = D_IN; d.ncols = ncq; d.K = DM; d.dst = (bf16*)(ws + WS_WIN) + (size_t)L * NPROJ * DM; d.mode = 0; d.roff = roq;
        } else if (q == 6) { d.W = a->in[I_WNSA] + (size_t)L * 512 * DM; d.ldw = DM; d.ncols = DM; d.K = 512; d.dst = (bf16*)(ws + WS_WNSA) + (size_t)L * DM * 512; d.mode = 0; d.roff = 0; }
        else if (q == 7) { d.W = a->in[I_WFOX] + (size_t)L * 512 * DM; d.ldw = DM; d.ncols = DM; d.K = 512; d.dst = (bf16*)(ws + WS_WFOX) + (size_t)L * DM * 512; d.mode = 0; d.roff = 0; }
        else if (q == 8) { d.W = a->in[I_WOUT] + (size_t)L * DM * DM; d.ldw = DM; d.ncols = DM; d.K = DM; d.dst = (bf16*)(ws + WS_WO) + (size_t)L * DM * DM; d.mode = 0; d.roff = 0; }
        else { const int kv = q - 9; d.W = a->in[I_W1] + (size_t)(L * 2 + kv) * 2048 * 128; d.ldw = 128; d.ncols = 128; d.K = 2048; d.dst = (bf16*)(ws + WS_WC1) + (size_t)(L * 2 + kv) * 128 * 2048; d.mode = 0; d.roff = 0; }
    } else if (s < 50) {
        const int j = (s - 44) / 3, q = (s - 44) % 3;
        if (q < 2) { d.W = a->in[q == 0 ? I_DG : I_DU] + (size_t)j * DM * FF_D; d.ldw = FF_D; d.ncols = FF_D; d.K = DM; d.dst = (bf16*)(ws + WS_WDGU) + (size_t)j * 2 * FF_D * DM; d.mode = 1; d.roff = q * 128; }
        else { d.W = a->in[I_DD] + (size_t)j * FF_D * DM; d.ldw = DM; d.ncols = DM; d.K = FF_D; d.dst = (bf16*)(ws + WS_WDD) + (size_t)j * DM * FF_D; d.mode = 0; d.roff = 0; }
    } else {
        const int je = (s - 50) / 3, q = (s - 50) % 3;
        if (q < 2) { d.W = a->in[q == 0 ? I_MG : I_MU] + (size_t)je * DM * FF_E; d.ldw = FF_E; d.ncols = FF_E; d.K = DM; d.dst = (bf16*)(ws + WS_WMGU) + (size_t)je * 2 * FF_E * DM; d.mode = 1; d.roff = q * 128; }
        else { d.W = a->in[I_MD] + (size_t)je * FF_E * DM; d.ldw = DM; d.ncols = DM; d.K = FF_E; d.dst = (bf16*)(ws + WS_WMD) + (size_t)je * DM * FF_E; d.mode = 0; d.roff = 0; }
    }
    return d;
}
constexpr int NSEG = 98;

__device__ __forceinline__ void p0_prologue(const Frame& F) {
    PHASE_IDS(); const CArgs* a = kargs();
    LAS unsigned char* scr = F.lds + wave * 9216;
    const int gw = F.vcu * NWAVES + wave, NGW = F.G * NWAVES;
    typedef short v4i16_t __attribute__((ext_vector_type(4)));
    const int kr = lane >> 4, nq = lane & 15, grp = lane >> 4, q4 = (lane & 15) >> 2, p4 = lane & 3;
    int base = 0;
    for (int s = 0; s < NSEG; ++s) {
        const SegDesc d = seg_desc(s, a);
        const int nblk = (d.ncols + 63) >> 6, n_items = (d.K >> 6) * nblk;
        int start = gw - (base % NGW); if (start < 0) start += NGW;
        for (int it = start; it < n_items; it += NGW) {
            const int kb = it / nblk, nb = it % nblk, k0 = 64 * kb, n0 = 64 * nb;
            const bool okn = n0 + 4 * nq < d.ncols;
            const float* src = d.W + (size_t)(k0 + kr) * d.ldw + n0 + 4 * nq;
            f32x4 v[16];
#pragma unroll
            for (int i = 0; i < 16; ++i) v[i] = okn ? *(const GAS f32x4*)(src + (size_t)(4 * i) * d.ldw) : (f32x4){0.f, 0.f, 0.f, 0.f};
#pragma unroll
            for (int i = 0; i < 16; ++i) { v2u w; w.x = pk2(v[i][0], v[i][1]); w.y = pk2(v[i][2], v[i][3]); *(LAS v2u*)(scr + (4 * i + kr) * 144 + 8 * nq) = w; }
            LDS_WAIT(); asm volatile("" ::: "memory");
            const int rbase = d.mode ? (d.roff + ((n0 >> 7) << 8) + (n0 & 127)) : (d.roff + n0);
#pragma unroll
            for (int nb4 = 0; nb4 < 4; ++nb4)
#pragma unroll
                for (int h = 0; h < 2; ++h) {
                    const int kc = 4 * h + grp;
                    const LAS unsigned char* rp = scr + (8 * kc + q4) * 144 + (16 * nb4 + 4 * p4) * 2;
                    const v4i16_t lo = __builtin_amdgcn_ds_read_tr16_b64_v4i16((LAS v4i16_t*)rp), hi4 = __builtin_amdgcn_ds_read_tr16_b64_v4i16((LAS v4i16_t*)(rp + 4 * 144));
                    v2u a2 = __builtin_bit_cast(v2u, lo), b2 = __builtin_bit_cast(v2u, hi4); asm volatile("" : "+v"(a2), "+v"(b2));
                    const int n = 16 * nb4 + (lane & 15);
                    if (n0 + n < d.ncols) *(GAS v4u*)(d.dst + (size_t)(rbase + n) * d.K + k0 + 8 * kc) = (v4u){a2.x, a2.y, b2.x, b2.y};
                }
            LDS_WAIT(); asm volatile("" ::: "memory");
        }
        base += n_items;
    }
    {
        constexpr int PADROWS = NPROJ - (PC_MISC + 32), V16_PER_L = PADROWS * DM * 2 / 16;
        const int gt = gw * 64 + lane, NGT = NGW * 64;
        for (int i = gt; i < DEPTH * V16_PER_L; i += NGT) { const int L = i / V16_PER_L, r = i % V16_PER_L;
            *((GAS v4u*)((bf16*)(a->ws + WS_WIN) + ((size_t)L * NPROJ + PC_MISC + 32) * DM) + r) = (v4u){0u, 0u, 0u, 0u}; }
        const float* x = a->in[I_X]; bf16* xb = (bf16*)(a->ws + WS_XB);
        for (int i = gt; i < M * DM / 8; i += NGT) { const f32x4 p = *((const GAS f32x4*)x + 2 * (size_t)i), q = *((const GAS f32x4*)x + 2 * (size_t)i + 1);
            v4u o; o.x = pk2(p[0], p[1]); o.y = pk2(p[2], p[3]); o.z = pk2(q[0], q[1]); o.w = pk2(q[2], q[3]); *((GAS v4u*)xb + i) = o; }
    }
    if (gw < 256) {
        const int lk = gw >> 5, sl = gw & 31;
        const float* pe = a->in[I_PE] + (size_t)lk * 2048 + sl * 64; const float* w1 = a->in[I_W1] + ((size_t)lk * 2048 + sl * 64) * 128;
        float a0 = 0.f, a1 = 0.f;
        for (int k = 0; k < 64; ++k) { const float p = pe[k]; a0 += p * w1[k * 128 + lane]; a1 += p * w1[k * 128 + 64 + lane]; }
        float* cbp = (float*)(a->ws + WS_CBP) + (size_t)gw * 128; cbp[lane] = a0; cbp[64 + lane] = a1;
    }
}

__device__ __forceinline__ float gelu_tanh(float x) { const float u = 0.7978845608028654f * (x + 0.044715f * x * x * x); return 0.5f * x * (1.f + tanhf(u)); }

__device__ __forceinline__ void p2_cmp_scan(const Frame& F, int L) {
    PHASE_IDS(); const CArgs* a = kargs(); unsigned char* ws = a->ws;
    typedef float f32x2_t __attribute__((ext_vector_type(2)));
    constexpr int A_OFF = 0, P_OFF = 36864, H_OFF = P_OFF + 65536, CB_OFF = H_OFF + 8192;
    for (int u = F.vcu; u < 256; u += F.G) {
        const int kv = u >> 7, bh = (u >> 3) & 15, rg = u & 7, i0 = 16 * rg;
        const bf16* src = (const bf16*)(ws + WS_KV6) + (size_t)kv * ((size_t)M * 128) + ((size_t)bh * SEQ + 16 * i0) * 64;
        for (int i = tid; i < 2176; i += 512) { const int tok = i >> 3, c = i & 7; *(LAS v4u*)(F.lds + A_OFF + tok * 128 + (tok >> 4) * 16 + c * 16) = *((const GAS v4u*)src + i); }
        if (tid < 128) { const float* cbp = (const float*)(ws + WS_CBP) + (size_t)(L * 2 + kv) * 32 * 128 + tid; float cb = 0.f;
            for (int s = 0; s < 32; ++s) cb += cbp[s * 128];
            ((LAS float*)(F.lds + CB_OFF))[tid] = cb; }
        __syncthreads();
        {
            const int row = lane & 15, kg = lane >> 4;
            const bf16* W = (const bf16*)(ws + WS_WC1) + ((size_t)(L * 2 + kv) * 128 + row) * 2048 + 256 * wave + 8 * kg;
            f32x4 acc[8];
#pragma unroll
            for (int nb = 0; nb < 8; ++nb) acc[nb] = (f32x4){0.f, 0.f, 0.f, 0.f};
#pragma unroll
            for (int ks = 0; ks < 8; ++ks) {
                const int k = 256 * wave + 32 * ks + 8 * kg, tok = 16 * row + (k >> 6);
                const bf16x8 af = *(const LAS bf16x8*)(F.lds + A_OFF + tok * 128 + (tok >> 4) * 16 + (k & 63) * 2);
#pragma unroll
                for (int nb = 0; nb < 8; ++nb) { const bf16x8 bfr = *(const GAS bf16x8*)(W + (size_t)nb * 16 * 2048 + ks * 32);
                    acc[nb] = __builtin_amdgcn_mfma_f32_16x16x32_bf16(af, bfr, acc[nb], 0, 0, 0); }
            }
            LAS float* part = (LAS float*)(F.lds + P_OFF) + wave * 2048;
#pragma unroll
            for (int nb = 0; nb < 8; ++nb)
#pragma unroll
                for (int r = 0; r < 4; ++r) part[(4 * kg + r) * 128 + 16 * nb + row] = acc[nb][r];
        }
        __syncthreads();
        {
            const int e = tid * 4; const LAS float* part = (const LAS float*)(F.lds + P_OFF) + e;
            f32x4 s = *(const LAS f32x4*)(F.lds + CB_OFF + (e & 127) * 4);
#pragma unroll
            for (int w = 0; w < 8; ++w) s += *(const LAS f32x4*)(part + w * 2048);
            *(LAS f32x4*)(F.lds + H_OFF + e * 4) = (f32x4){gelu_tanh(s[0]), gelu_tanh(s[1]), gelu_tanh(s[2]), gelu_tanh(s[3])};
        }
        __syncthreads();
        {
            const int i = tid >> 5, d = (tid & 31) * 2;
            const float* w2 = a->in[I_W2] + (size_t)(L * 2 + kv) * 128 * 64 + d; const LAS float* Hr = (const LAS float*)(F.lds + H_OFF) + i * 128;
            float o0 = 0.f, o1 = 0.f;
#pragma unroll 8
            for (int n = 0; n < 128; ++n) { const f32x2_t wv = *(const GAS f32x2_t*)(w2 + n * 64); const float hv = Hr[n]; o0 += hv * wv[0]; o1 += hv * wv[1]; }
            const bool ok = (i0 + i) < N_CMP;
            *(GAS unsigned*)((bf16*)(ws + (kv ? WS_VCC : WS_KCC)) + ((size_t)bh * 128 + i0 + i) * 64 + d) = ok ? pk2(o0, o1) : 0u;
        }
        __syncthreads();
    }
    const int gw = F.vcu * NWAVES + wave;
    if (gw < BATCH * FOX_H) {
        const int b = gw >> 3, h = gw & 7;
        const float* lf = (const float*)(ws + WS_LF) + ((size_t)b * SEQ + 32 * lane) * 8 + h;
        float loc = 0.f;
        for (int i = 0; i < 32; ++i) loc += lf[i * 8];
        float inc = loc;
#pragma unroll
        for (int o = 1; o < 64; o <<= 1) { const float t = __shfl_up(inc, o); if (lane >= o) inc += t; }
        float run = inc - loc;
        float* out = (float*)(ws + WS_NF2) + (size_t)gw * SEQ + 32 * lane;
        for (int i = 0; i < 32; ++i) { run += lf[i * 8]; out[i] = -run * LOG2E; }
    }
}

__device__ __forceinline__ void load_q64(const bf16* q, float (&qf)[64]) {
#pragma unroll
    for (int i = 0; i < 8; ++i) { const v4u v = *(const GAS v4u*)(q + 8 * i);
        qf[8 * i + 0] = bflo(v.x); qf[8 * i + 1] = bfhi(v.x); qf[8 * i + 2] = bflo(v.y); qf[8 * i + 3] = bfhi(v.y); qf[8 * i + 4] = bflo(v.z); qf[8 * i + 5] = bfhi(v.z); qf[8 * i + 6] = bflo(v.w); qf[8 * i + 7] = bfhi(v.w); }
}
__device__ __forceinline__ float dot64(const float (&qf)[64], const bf16* k) {
    float acc = 0.f;
#pragma unroll
    for (int i = 0; i < 8; ++i) { const v4u v = *(const GAS v4u*)(k + 8 * i);
        acc += qf[8 * i + 0] * bflo(v.x) + qf[8 * i + 1] * bfhi(v.x) + qf[8 * i + 2] * bflo(v.y) + qf[8 * i + 3] * bfhi(v.y) + qf[8 * i + 4] * bflo(v.z) + qf[8 * i + 5] * bfhi(v.z) + qf[8 * i + 6] * bflo(v.w) + qf[8 * i + 7] * bfhi(v.w); }
    return acc;
}
__device__ __forceinline__ void softmax_lds(LAS float* sc, int n, int lane, float mxl) {
    const float mx = wave_max(mxl);
    float l = 0.f;
    for (int i = lane; i < n; i += 64) { const float s = sc[i]; const float p = (s > -1e29f) ? exp2f(s - mx) : 0.f; sc[i] = p; l += p; }
    l = wave_sum(l);
    const float inv = 1.f / fmaxf(l, 1e-30f);
    for (int i = lane; i < n; i += 64) sc[i] *= inv;
}

__device__ __forceinline__ void p3_fox_naive(const Frame& F) {
    PHASE_IDS(); const CArgs* a = kargs(); unsigned char* ws = a->ws;
    LAS float* sc = (LAS float*)F.lds + wave * 2048;
    const int gw = F.vcu * NWAVES + wave, NGW = F.G * NWAVES;
    const bf16* FQ = (const bf16*)(ws + WS_FQKV); const bf16* FK = FQ + (size_t)M * 512; const bf16* FV = FK + (size_t)M * 512;
    for (int it = gw; it < BATCH * FOX_H * SEQ; it += NGW) {
        const int bh = it >> 11, t = it & 2047;
        float qf[64]; load_q64(FQ + ((size_t)bh * SEQ + t) * 64, qf);
        const float* nf = (const float*)(ws + WS_NF2) + (size_t)bh * SEQ; const float nft = nf[t];
        const bf16* kb = FK + (size_t)bh * SEQ * 64; const bf16* vb = FV + (size_t)bh * SEQ * 64;
        float mx = -1e30f;
        for (int s = lane; s <= t; s += 64) { const float v = dot64(qf, kb + (size_t)s * 64) + (nf[s] - nft); sc[s] = v; mx = fmaxf(mx, v); }
        softmax_lds(sc, t + 1, lane, mx);
        float o = 0.f;
        for (int s = 0; s <= t; ++s) o += sc[s] * bf2f(vb[(size_t)s * 64 + lane]);
        const int b = bh >> 3, h = bh & 7;
        ((bf16*)(ws + WS_YF))[((size_t)b * SEQ + t) * 512 + h * 64 + lane] = (bf16)f2bf(o);
    }
}

__device__ __forceinline__ void p3_nsa_naive(const Frame& F) {
    PHASE_IDS(); const CArgs* a = kargs(); unsigned char* ws = a->ws;
    const int half = wave >> 2, g = wave & 3;
    LAS float* sc = (LAS float*)F.lds + wave * 1024;
    LAS float* pc = (LAS float*)(F.lds + 32768) + half * 512;
    const bf16* QN = (const bf16*)(ws + WS_QN); const bf16* KV6 = (const bf16*)(ws + WS_KV6);
    const float* rel = a->in[I_REL];
    for (int it = blockIdx.x * 2 + half; it < BATCH * NSA_KVH * SEQ; it += 2 * F.G) {
        const int bk = it >> 11, t = it & 2047, b = bk >> 1, kvh = bk & 1, h = kvh * 4 + g, cur = t >> 6;
        float qf[64]; load_q64(QN + ((size_t)(b * 8 + h) * SEQ + t) * 64, qf);
        const float* ng = (const float*)(ws + WS_NG) + ((size_t)b * SEQ + t) * 24 + h * 3;
        const float g0 = ng[0], g1 = ng[1], g2 = ng[2];
        const bf16* kc = (const bf16*)(ws + WS_KCC) + (size_t)bk * 128 * 64; const bf16* vc = (const bf16*)(ws + WS_VCC) + (size_t)bk * 128 * 64;
        float mx = -1e30f;
        for (int c = lane; c < 128; c += 64) { const int ce = 16 * c + 31; float v = -1e30f;
            if (c < N_CMP && ce <= t) v = dot64(qf, kc + (size_t)c * 64) + rel[t5b(t - ce) * 8 + h] * LOG2E;
            sc[c] = v; mx = fmaxf(mx, v); }
        softmax_lds(sc, 128, lane, mx);
        float oc = 0.f;
        for (int c = 0; c < 128; ++c) oc += sc[c] * bf2f(vc[(size_t)c * 64 + lane]);
        pc[g * 128 + lane] = sc[lane]; pc[g * 128 + 64 + lane] = sc[64 + lane];
        __syncthreads();
        unsigned selmask;
        {
            float imp = -1.f;
            if (lane < 32) {
                const int j = lane;
                float P[5];
#pragma unroll
                for (int q = 0; q < 5; ++q) { const int c = 4 * j - 1 + q; P[q] = (c >= 0 && c < 128) ? ((pc[c] + pc[128 + c]) + (pc[256 + c] + pc[384 + c])) : 0.f; }
                const float v = P[1] + P[2] + P[3] + 0.5f * P[4] + 0.5f * P[0];
                const bool forced = (j == 0) || (j <= cur && j > cur - 2);
                imp = forced ? 1e4f : (j <= cur ? v : -1.f);
            }
            int rank = 0;
            for (int jj = 0; jj < 32; ++jj) { const float o = __shfl(imp, jj); rank += (o > imp || (o == imp && jj < lane)) ? 1 : 0; }
            selmask = (unsigned)(__ballot(lane < 32 && rank < 16) & 0xffffffffull);
        }
        __syncthreads();
        const bf16* ks = KV6 + (size_t)2 * M * 128 + (size_t)bk * SEQ * 64; const bf16* vs = KV6 + (size_t)3 * M * 128 + (size_t)bk * SEQ * 64;
        int nsel = 0; mx = -1e30f;
        for (int j = 0; j <= cur; ++j) if ((selmask >> j) & 1u) { const int pos = 64 * j + lane; float v = -1e30f;
            if (pos <= t) v = dot64(qf, ks + (size_t)pos * 64) + rel[t5b(t - pos) * 8 + h] * LOG2E;
            sc[nsel * 64 + lane] = v; mx = fmaxf(mx, v); ++nsel; }
        softmax_lds(sc, nsel * 64, lane, mx);
        float os = 0.f; { int q = 0;
            for (int j = 0; j <= cur; ++j) if ((selmask >> j) & 1u) { for (int i = 0; i < 64; ++i) os += sc[q * 64 + i] * bf2f(vs[(size_t)(64 * j + i) * 64 + lane]); ++q; } }
        const bf16* kw = KV6 + (size_t)4 * M * 128 + (size_t)bk * SEQ * 64; const bf16* vw = KV6 + (size_t)5 * M * 128 + (size_t)bk * SEQ * 64;
        const int lo = t - 511 > 0 ? t - 511 : 0, nw = t - lo + 1;
        mx = -1e30f;
        for (int i = lane; i < nw; i += 64) { const int pos = lo + i; const float v = dot64(qf, kw + (size_t)pos * 64) + rel[t5b(t - pos) * 8 + h] * LOG2E; sc[i] = v; mx = fmaxf(mx, v); }
        softmax_lds(sc, nw, lane, mx);
        float ow = 0.f;
        for (int i = 0; i < nw; ++i) ow += sc[i] * bf2f(vw[(size_t)(lo + i) * 64 + lane]);
        ((bf16*)(ws + WS_YN))[((size_t)b * SEQ + t) * 512 + h * 64 + lane] = (bf16)f2bf(g0 * oc + g1 * os + g2 * ow);
    }
}

template <int MODE, bool ROUTE, int LNG, int LNB>
__device__ __forceinline__ void ln_phase(const Frame& F, int L, int j) {
    PHASE_IDS(); const CArgs* a = kargs(); unsigned char* ws = a->ws; unsigned* ctl = (unsigned*)(ws + WS_CTL);
    const float* gam = a->in[LNG] + L * DM; const float* bet = a->in[LNB] + L * DM;
    const int gw = F.vcu * NWAVES + wave, NGW = F.G * NWAVES;
    LAS int* lcnt = (LAS int*)F.lds;
    LAS int* lrow = (LAS int*)(F.lds + 256);
    if (ROUTE) { if (tid < 16) lcnt[tid] = 0; __syncthreads(); }
    const float* pre = (const float*)(ws + WS_PRE); float* X = a->out; bf16* XB = (bf16*)(ws + WS_XB);
    f32x4 gv[4], bv[4];
#pragma unroll
    for (int q = 0; q < 4; ++q) { gv[q] = *((const GAS f32x4*)gam + lane + 64 * q); bv[q] = *((const GAS f32x4*)bet + lane + 64 * q); }
    int ri = 0;
    for (int m = gw; m < M; m += NGW, ++ri) {
        f32x4 v[4];
        if (MODE == 0) {
#pragma unroll
            for (int q = 0; q < 4; ++q) v[q] = *((const GAS f32x4*)(pre + (size_t)m * DM) + lane + 64 * q);
        } else {
            const int* ts = (const int*)(ws + WS_TOKS) + 2 * m; const float* tw = (const float*)(ws + WS_TOKW) + 2 * m;
            const int s0 = ts[0], s1 = ts[1]; const float w0 = tw[0], w1 = tw[1];
            const bf16* ys = (const bf16*)(ws + WS_XG);
#pragma unroll
            for (int q = 0; q < 4; ++q) {
                const f32x4 x = *((const GAS f32x4*)(X + (size_t)m * DM) + lane + 64 * q);
                const v2u y0 = *((const GAS v2u*)(ys + (size_t)s0 * DM) + lane + 64 * q), y1 = *((const GAS v2u*)(ys + (size_t)s1 * DM) + lane + 64 * q);
                v[q] = x * DN_ALPHA + (f32x4){bflo(y0.x), bfhi(y0.x), bflo(y0.y), bfhi(y0.y)} * w0 + (f32x4){bflo(y1.x), bfhi(y1.x), bflo(y1.y), bfhi(y1.y)} * w1;
            }
        }
        float s = 0.f;
#pragma unroll
        for (int q = 0; q < 4; ++q) s += (v[q][0] + v[q][1]) + (v[q][2] + v[q][3]);
        const float mean = wave_sum(s) * (1.f / DM); float s2 = 0.f;
#pragma unroll
        for (int q = 0; q < 4; ++q) { v[q] = v[q] - mean; s2 += (v[q][0] * v[q][0] + v[q][1] * v[q][1]) + (v[q][2] * v[q][2] + v[q][3] * v[q][3]); }
        const float rstd = 1.f / sqrtf(wave_sum(s2) * (1.f / DM) + LN_EPS);
#pragma unroll
        for (int q = 0; q < 4; ++q) { v[q] = v[q] * rstd * gv[q] + bv[q];
            *((GAS f32x4*)(X + (size_t)m * DM) + lane + 64 * q) = v[q];
            v2u o; o.x = pk2(v[q][0], v[q][1]); o.y = pk2(v[q][2], v[q][3]); *((GAS v2u*)(XB + (size_t)m * DM) + lane + 64 * q) = o; }
        if (ROUTE) {
            const float* R = a->in[I_ROUT] + (size_t)j * DM * NEXP;
            float lg[8];
#pragma unroll
            for (int e = 0; e < 8; ++e) lg[e] = 0.f;
#pragma unroll
            for (int q = 0; q < 4; ++q)
#pragma unroll
                for (int c = 0; c < 4; ++c) { const float xv = v[q][c]; const float* rr = R + (size_t)(4 * lane + 256 * q + c) * 8; const f32x4 r0 = *(const GAS f32x4*)rr, r1 = *(const GAS f32x4*)(rr + 4);
                    lg[0] += xv * r0[0]; lg[1] += xv * r0[1]; lg[2] += xv * r0[2]; lg[3] += xv * r0[3]; lg[4] += xv * r1[0]; lg[5] += xv * r1[1]; lg[6] += xv * r1[2]; lg[7] += xv * r1[3]; }
#pragma unroll
            for (int e = 0; e < 8; ++e) lg[e] = wave_sum(lg[e]);
            int e0 = 0; float l0 = lg[0];
#pragma unroll
            for (int e = 1; e < 8; ++e) if (lg[e] > l0) { l0 = lg[e]; e0 = e; }
            int e1 = -1; float l1 = -3.0e38f;
#pragma unroll
            for (int e = 0; e < 8; ++e) if (e != e0 && lg[e] > l1) { l1 = lg[e]; e1 = e; }
            const float w0 = 1.f / (1.f + __expf(l1 - l0));
            if (lane == 0) {
                int* te = (int*)(ws + WS_TOKE) + 2 * m; float* tw = (float*)(ws + WS_TOKW) + 2 * m;
                te[0] = e0; te[1] = e1; tw[0] = w0; tw[1] = 1.f - w0;
                const int p0 = __hip_atomic_fetch_add(&lcnt[e0], 1, __ATOMIC_RELAXED, __HIP_MEMORY_SCOPE_WORKGROUP), p1 = __hip_atomic_fetch_add(&lcnt[e1], 1, __ATOMIC_RELAXED, __HIP_MEMORY_SCOPE_WORKGROUP);
                LAS int* lr = lrow + (wave * 16 + ri) * 4; lr[0] = e0; lr[1] = e1; lr[2] = p0; lr[3] = p1;
            }
        }
    }
    if (ROUTE) {
        __syncthreads();
        if (tid < 8) lcnt[8 + tid] = (int)atomicAdd(ctl + CW_MOECNT + j * 64 + tid, (unsigned)lcnt[tid]);
        __syncthreads();
        ri = 0;
        for (int m = gw; m < M; m += NGW, ++ri) if (lane < 2) { LAS int* lr = lrow + (wave * 16 + ri) * 4; ((int*)(ws + WS_TOKP))[2 * m + lane] = lr[2 + lane] + lcnt[8 + lr[lane]]; }
    }
}

struct MoeTiles { int toff[9]; };
__device__ __forceinline__ void moe_tiles(unsigned* ctl, int j, int (&toff)[9]) {
    toff[0] = 0;
#pragma unroll
    for (int e = 0; e < 8; ++e) { const unsigned c = __hip_atomic_load(ctl + CW_MOECNT + j * 64 + e, __ATOMIC_RELAXED, __HIP_MEMORY_SCOPE_AGENT); toff[e + 1] = toff[e] + (int)((c + 255u) >> 8); }
}
__device__ __forceinline__ void moe_gather(const Frame& F, int j) {
    PHASE_IDS(); const CArgs* a = kargs(); unsigned char* ws = a->ws;
    int toff[9]; moe_tiles((unsigned*)(ws + WS_CTL), j, toff);
    const int gw = F.vcu * NWAVES + wave, NGW = F.G * NWAVES;
    const bf16* XB = (const bf16*)(ws + WS_XB); bf16* XG = (bf16*)(ws + WS_XG);
    for (int it = gw; it < 2 * M; it += NGW) {
        const int e = ((const int*)(ws + WS_TOKE))[it], p = ((const int*)(ws + WS_TOKP))[it];
        int tb = toff[0];
#pragma unroll
        for (int q = 1; q < 8; ++q) tb = (e == q) ? toff[q] : tb;
        const int slot = tb * 256 + p;
        if (lane == 0) ((int*)(ws + WS_TOKS))[it] = slot;
        const GAS v4u* src = (const GAS v4u*)(XB + (size_t)(it >> 1) * DM); GAS v4u* dst = (GAS v4u*)(XG + (size_t)slot * DM);
        dst[lane] = src[lane]; dst[64 + lane] = src[64 + lane];
    }
}

namespace att {
constexpr int KSTR = 1152, KT_BYTES = 8 * KSTR, VT_BYTES = 8192;
constexpr int L_K = 0, L_V = 2 * KT_BYTES, L_F = L_V + 2 * VT_BYTES, L_WSF = L_F + 512, L_LUT = L_WSF + 8 * 256, L_SEL = L_LUT + 4096, L_ACC = L_SEL + 256, L_OST = L_ACC, L_IMP = L_ACC + 32768, L_END = L_ACC + 65536;
static_assert(L_END <= RING_BYTES, "attention LDS map");
constexpr float MASKV = -3.0e30f, MINIT = -1.0e30f;
typedef short v4i16_t __attribute__((ext_vector_type(4)));
typedef short s16x4 __attribute__((ext_vector_type(4)));
__device__ __forceinline__ int crow(int r, int hi) { return (r & 3) + 8 * (r >> 2) + 4 * hi; }
__device__ __forceinline__ float swap_max(float m) { auto rr = __builtin_amdgcn_permlane32_swap(__float_as_uint(m), __float_as_uint(m), false, false); return fmaxf(__uint_as_float(rr[0]), __uint_as_float(rr[1])); }
__device__ __forceinline__ float swap_sum(float m) { auto rr = __builtin_amdgcn_permlane32_swap(__float_as_uint(m), __float_as_uint(m), false, false); return __uint_as_float(rr[0]) + __uint_as_float(rr[1]); }
__device__ __forceinline__ float swap_other(float m) { return __shfl_xor(m, 32); }
__device__ __forceinline__ unsigned cvtpk(float lo, float hi) { unsigned r; asm volatile("v_cvt_pk_bf16_f32 %0, %1, %2" : "=v"(r) : "v"(lo), "v"(hi)); return r; }

struct TileRegs { v4u k, v; f32x4 f; };
__device__ __forceinline__ void tile_issue(TileRegs& R, const bf16* kt, const bf16* vt, int tid) {
    R.k = *((const GAS v4u*)kt + tid); R.v = *((const GAS v4u*)vt + tid);
}
__device__ __forceinline__ void tile_store(const TileRegs& R, LAS unsigned char* lds, int buf, int tid) {
    const int row = tid >> 3, c = tid & 7;
    *(LAS v4u*)(lds + L_K + buf * KT_BYTES + c * KSTR + row * 16) = R.k;
    *(LAS v4u*)(lds + L_V + buf * VT_BYTES + (c >> 2) * 4096 + row * 64 + (c & 3) * 16) = R.v;
}
__device__ __forceinline__ void qkt(f32x16& p0, f32x16& p1, const LAS unsigned char* kb, const bf16x8 (&qr)[4], int r32, int hi) {
    p0 = (f32x16){}; p1 = (f32x16){};
#pragma unroll
    for (int d0 = 0; d0 < 4; ++d0) {
        const bf16x8 b0 = *(const LAS bf16x8*)(kb + (2 * d0 + hi) * KSTR + r32 * 16);
        const bf16x8 b1 = *(const LAS bf16x8*)(kb + (2 * d0 + hi) * KSTR + r32 * 16 + 512);
        p0 = __builtin_amdgcn_mfma_f32_32x32x16_bf16(b0, qr[d0], p0, 0, 0, 0);
        p1 = __builtin_amdgcn_mfma_f32_32x32x16_bf16(b1, qr[d0], p1, 0, 0, 0);
    }
}
__device__ __forceinline__ s16x4 vtr(const LAS unsigned char* p) { return __builtin_bit_cast(s16x4, __builtin_amdgcn_ds_read_tr16_b64_v4i16((LAS v4i16_t*)p)); }
__device__ __forceinline__ void pv(f32x16 (&o)[2], const LAS unsigned char* vb, const f32x16& p0, const f32x16& p1, int lane) {
    const int hi = lane >> 5;
    const LAS unsigned char* vp = vb + ((lane >> 4) & 1) * 32 + (lane & 3) * 8 + (4 * hi + ((lane & 15) >> 2)) * 64;
    v4u pw[4];
#pragma unroll
    for (int q = 0; q < 4; ++q) { pw[0][q] = cvtpk(p0[2 * q], p0[2 * q + 1]); pw[1][q] = cvtpk(p0[8 + 2 * q], p0[8 + 2 * q + 1]); pw[2][q] = cvtpk(p1[2 * q], p1[2 * q + 1]); pw[3][q] = cvtpk(p1[8 + 2 * q], p1[8 + 2 * q + 1]); }
#pragma unroll
    for (int d0 = 0; d0 < 2; ++d0)
#pragma unroll
        for (int ks = 0; ks < 4; ++ks) {
            const s16x4 lo = vtr(vp + d0 * 4096 + ks * 1024), hh = vtr(vp + d0 * 4096 + ks * 1024 + 512);
            const bf16x8 vf = (bf16x8){lo[0], lo[1], lo[2], lo[3], hh[0], hh[1], hh[2], hh[3]};
            o[d0] = __builtin_amdgcn_mfma_f32_32x32x16_bf16(__builtin_bit_cast(bf16x8, pw[ks]), vf, o[d0], 0, 0, 0);
        }
}
__device__ __forceinline__ void scale_rows(f32x16 (&o)[2], float f, LAS float* wsf, int r32, int hi) {
    if (hi == 0) wsf[r32] = f;
    asm volatile("s_waitcnt lgkmcnt(0)" ::: "memory");
#pragma unroll
    for (int k = 0; k < 4; ++k) { const f32x4 fv = *(const LAS f32x4*)(wsf + 8 * k + 4 * hi);
#pragma unroll
        for (int i = 0; i < 4; ++i) { o[0][4 * k + i] *= fv[i]; o[1][4 * k + i] *= fv[i]; } }
    asm volatile("s_waitcnt lgkmcnt(0)" ::: "memory");
}
__device__ __forceinline__ void axpy_rows(f32x16 (&acc)[2], const f32x16 (&o)[2], float f, LAS float* wsf, int r32, int hi) {
    if (hi == 0) wsf[r32] = f;
    asm volatile("s_waitcnt lgkmcnt(0)" ::: "memory");
#pragma unroll
    for (int k = 0; k < 4; ++k) { const f32x4 fv = *(const LAS f32x4*)(wsf + 8 * k + 4 * hi);
#pragma unroll
        for (int i = 0; i < 4; ++i) { acc[0][4 * k + i] += o[0][4 * k + i] * fv[i]; acc[1][4 * k + i] += o[1][4 * k + i] * fv[i]; } }
    asm volatile("s_waitcnt lgkmcnt(0)" ::: "memory");
}
template <int MODE>
__device__ __forceinline__ void acc_rows(f32x16 (&o)[2], float f, LAS float* wsf, LAS float* accw, int r32, int hi) {
    if (hi == 0) wsf[r32] = f;
    asm volatile("s_waitcnt lgkmcnt(0)" ::: "memory");
#pragma unroll
    for (int k = 0; k < 4; ++k) { const f32x4 fv = *(const LAS f32x4*)(wsf + 8 * k + 4 * hi);
#pragma unroll
        for (int i = 0; i < 4; ++i)
#pragma unroll
            for (int d0 = 0; d0 < 2; ++d0) { LAS float* p = accw + (8 * k + 4 * hi + i) * 64 + d0 * 32 + r32; const float v = o[d0][4 * k + i] * fv[i];
                if (MODE == 0) *p = v; else if (MODE == 1) *p += v; else o[d0][4 * k + i] = *p + v; } }
    asm volatile("s_waitcnt lgkmcnt(0)" ::: "memory");
}
__device__ __forceinline__ void softmax_pv(f32x16& p0, f32x16& p1, f32x16 (&o)[2], float& m, float& l, const LAS unsigned char* vb, LAS float* wsf, int lane) {
    const int r32 = lane & 31, hi = lane >> 5;
    float mt = fmaxf(p0[0], p1[0]);
#pragma unroll
    for (int r = 1; r < 16; ++r) mt = fmaxf(mt, fmaxf(p0[r], p1[r]));
    mt = swap_max(mt);
    const float mn = fmaxf(m, mt), alpha = __builtin_amdgcn_exp2f(m - mn);
    float s = 0.f;
#pragma unroll
    for (int r = 0; r < 16; ++r) { p0[r] = __builtin_amdgcn_exp2f(p0[r] - mn); p1[r] = __builtin_amdgcn_exp2f(p1[r] - mn); s += p0[r] + p1[r]; }
    l = l * alpha + s; m = mn;
    if (__any(alpha != 1.f)) scale_rows(o, alpha, wsf, r32, hi);
    pv(o, vb, p0, p1, lane);
}
__device__ __forceinline__ void store_rows(const f32x16 (&o)[2], LAS unsigned char* ost, bf16* dst, int pitch, int lane) {
    const int r32 = lane & 31, hi = lane >> 5;
    LAS bf16* stg = (LAS bf16*)ost;
#pragma unroll
    for (int r = 0; r < 16; ++r) { const int orow = crow(r, hi);
#pragma unroll
        for (int d0 = 0; d0 < 2; ++d0) stg[orow * 64 + d0 * 32 + r32] = (bf16)f2bf(o[d0][r]); }
    asm volatile("s_waitcnt lgkmcnt(0)" ::: "memory");
#pragma unroll
    for (int i = 0; i < 4; ++i) { const int row = i * 8 + (lane >> 3), ch = lane & 7; const v4u v = *(const LAS v4u*)(stg + row * 64 + ch * 8); *(GAS v4u*)(dst + (size_t)row * pitch + ch * 8) = v; }
    asm volatile("s_waitcnt lgkmcnt(0)" ::: "memory");
}
#define ATT_BAR() do { asm volatile("s_waitcnt vmcnt(0) lgkmcnt(0)" ::: "memory"); __builtin_amdgcn_s_barrier(); asm volatile("" ::: "memory"); } while (0)
#define ATT_LBAR() do { asm volatile("s_waitcnt lgkmcnt(0)" ::: "memory"); __builtin_amdgcn_s_barrier(); asm volatile("" ::: "memory"); } while (0)

__device__ __forceinline__ void fox_unit(LAS unsigned char* lds, unsigned char* ws, int bh, int qb, int tid_in) {
    int tid = tid_in; asm volatile("" : "+v"(tid));
    const int lane = tid & 63, wave = __builtin_amdgcn_readfirstlane(tid >> 6), r32 = lane & 31, hi = lane >> 5;
    const bf16* FQ = (const bf16*)(ws + WS_FQKV) + (size_t)bh * SEQ * 64; const bf16* FK = FQ + (size_t)M * 512; const bf16* FV = FK + (size_t)M * 512;
    const float* nf = (const float*)(ws + WS_NF2) + (size_t)bh * SEQ;
    LAS float* wsf = (LAS float*)(lds + L_WSF + wave * 256);
    const int q0 = 256 * qb + 32 * wave, qg = q0 + r32;
    bf16x8 qr[4];
#pragma unroll
    for (int d0 = 0; d0 < 4; ++d0) qr[d0] = *(const GAS bf16x8*)(FQ + (size_t)qg * 64 + 16 * d0 + 8 * hi);
    const int NT = 4 * qb + 4, mylast = (q0 + 31) >> 6;
    float m = MINIT, l = 0.f; f32x16 o[2]; o[0] = (f32x16){}; o[1] = (f32x16){};
    TileRegs R;
    tile_issue(R, FK, FV, tid); if (tid < 16) R.f = *((const GAS f32x4*)nf + tid);
    tile_store(R, lds, 0, tid); if (tid < 16) *(LAS f32x4*)(lds + L_F + tid * 16) = R.f;
    ATT_BAR();
    for (int t = 0; t < NT; ++t) {
        const int buf = t & 1;
        if (t + 1 < NT) { tile_issue(R, FK + (size_t)(t + 1) * 4096, FV + (size_t)(t + 1) * 4096, tid); if (tid < 16) R.f = *((const GAS f32x4*)(nf + (t + 1) * 64) + tid); }
        if (t <= mylast) {
            f32x16 p0, p1; qkt(p0, p1, lds + L_K + buf * KT_BYTES, qr, r32, hi);
            const LAS float* fb = (const LAS float*)(lds + L_F + buf * 256);
#pragma unroll
            for (int k = 0; k < 4; ++k) { const f32x4 f0 = *(const LAS f32x4*)(fb + 8 * k + 4 * hi), f1 = *(const LAS f32x4*)(fb + 32 + 8 * k + 4 * hi);
#pragma unroll
                for (int i = 0; i < 4; ++i) { p0[4 * k + i] += f0[i]; p1[4 * k + i] += f1[i]; } }
            if (64 * t + 63 > q0) {
                const int lim = qg - 64 * t;
#pragma unroll
                for (int r = 0; r < 16; ++r) { const int kv = crow(r, hi); if (kv > lim) p0[r] = MASKV; if (kv + 32 > lim) p1[r] = MASKV; }
            }
            softmax_pv(p0, p1, o, m, l, lds + L_V + buf * VT_BYTES, wsf, lane);
        }
        if (t + 1 < NT) { tile_store(R, lds, buf ^ 1, tid); if (tid < 16) *(LAS f32x4*)(lds + L_F + (buf ^ 1) * 256 + tid * 16) = R.f; }
        ATT_BAR();
    }
    l = swap_sum(l);
    scale_rows(o, 1.f / l, wsf, r32, hi);
    const int b = bh >> 3, h = bh & 7;
    store_rows(o, lds + L_OST + wave * 4096, (bf16*)(ws + WS_YF) + ((size_t)b * SEQ + q0) * 512 + h * 64, 512, lane);
}

template <bool NEAR>
__device__ __forceinline__ void nsa_scores(f32x16& p0, f32x16& p1, int dj, int tl, int hi, bool rowsel, int lim, const LAS float* lut, float cfar) {
#pragma unroll
    for (int r = 0; r < 16; ++r) {
        const int kv = crow(r, hi), rel0 = 64 * dj + tl - kv, rel1 = rel0 - 32;
        float b0 = cfar, b1 = cfar;
        if (NEAR) { b0 = lut[min(max(rel0, 0), 255)]; b1 = lut[min(max(rel1, 0), 255)]; }
        p0[r] = (rowsel && rel0 >= 0 && rel0 < lim) ? p0[r] + b0 : MASKV;
        p1[r] = (rowsel && rel1 >= 0 && rel1 < lim) ? p1[r] + b1 : MASKV;
    }
}

__device__ __forceinline__ void nsa_unit(LAS unsigned char* lds, unsigned char* ws, const float* relb, int bk, int cur, int tid_in) {
    int tid = tid_in; asm volatile("" : "+v"(tid));
    const int lane = tid & 63, wave = __builtin_amdgcn_readfirstlane(tid >> 6), r32 = lane & 31, hi = lane >> 5;
    const int g = wave & 3, th = wave >> 2, tl = 32 * th + r32, t = 64 * cur + tl, b = bk >> 1, kvh = bk & 1, h = 4 * kvh + g;
    LAS float* wsf = (LAS float*)(lds + L_WSF + wave * 256);
    LAS float* lutall = (LAS float*)(lds + L_LUT); const LAS float* lut = lutall + g * 256;
    LAS float* impP = (LAS float*)(lds + L_IMP); LAS unsigned* selm = (LAS unsigned*)(lds + L_SEL);
    const bf16* KV6 = (const bf16*)(ws + WS_KV6);
    for (int e = tid; e < 1024; e += 512) { const int gg = e >> 8, rel = e & 255; lutall[e] = relb[t5b(rel) * 8 + 4 * kvh + gg] * LOG2E; }
    const float cfar = relb[31 * 8 + h] * LOG2E;
    bf16x8 qr[4];
    { const bf16* Q = (const bf16*)(ws + WS_QN) + ((size_t)(b * 8 + h) * SEQ + t) * 64;
#pragma unroll
      for (int d0 = 0; d0 < 4; ++d0) qr[d0] = *(const GAS bf16x8*)(Q + 16 * d0 + 8 * hi); }
    const float* ngp = (const float*)(ws + WS_NG) + ((size_t)b * SEQ + t) * 24 + h * 3;
    const float g_c = ngp[0], g_s = ngp[1], g_w = ngp[2];
    f32x16 oc[2]; oc[0] = (f32x16){}; oc[1] = (f32x16){};
    LAS float* accw = (LAS float*)(lds + L_ACC + wave * 8192);
    {
        const bf16* kc = (const bf16*)(ws + WS_KCC) + (size_t)bk * 128 * 64; const bf16* vc = (const bf16*)(ws + WS_VCC) + (size_t)bk * 128 * 64;
        { TileRegs R0, R1; tile_issue(R0, kc, vc, tid); tile_issue(R1, kc + 4096, vc + 4096, tid);
          tile_store(R0, lds, 0, tid); tile_store(R1, lds, 1, tid); }
        ATT_BAR();
        const int ntc = cur > 15 ? 2 : 1;
#define CMP_SCORES(tt) do { qkt(p0, p1, lds + L_K + (tt) * KT_BYTES, qr, r32, hi); \
        _Pragma("unroll") for (int r = 0; r < 16; ++r) { const int c0 = 64 * (tt) + crow(r, hi), rel0 = t - (16 * c0 + 31), rel1 = rel0 - 512; \
            p0[r] = (rel0 >= 0) ? p0[r] + lut[min(rel0, 255)] : MASKV; \
            p1[r] = (rel1 >= 0 && c0 + 32 < N_CMP) ? p1[r] + lut[min(max(rel1, 0), 255)] : MASKV; } } while (0)
        float mx = MASKV, s = 0.f;
        for (int tt = 0; tt < ntc; ++tt) {
            f32x16 p0, p1; CMP_SCORES(tt);
            float mt = fmaxf(p0[0], p1[0]);
#pragma unroll
            for (int r = 1; r < 16; ++r) mt = fmaxf(mt, fmaxf(p0[r], p1[r]));
            mt = swap_max(mt);
            const float mn = fmaxf(mx, mt), mref = mn < -1e29f ? 0.f : mn;
            s *= __builtin_amdgcn_exp2f(fmaxf(mx, -1e30f) - fmaxf(mn, -1e30f));
#pragma unroll
            for (int r = 0; r < 16; ++r) s += __builtin_amdgcn_exp2f(p0[r] - mref) + __builtin_amdgcn_exp2f(p1[r] - mref);
            mx = mn;
        }
        s = swap_sum(s);
        const float mref = mx < -1e29f ? 0.f : mx, inv = 1.f / fmaxf(s, 1e-30f);
        LAS float* ip = impP + (size_t)(g * 64 + tl) * 32;
        float carry = 0.f;
        for (int tt = 0; tt < 2; ++tt) {
            if (tt < ntc) {
                f32x16 p0, p1; CMP_SCORES(tt);
#pragma unroll
                for (int r = 0; r < 16; ++r) { p0[r] = __builtin_amdgcn_exp2f(p0[r] - mref) * inv; p1[r] = __builtin_amdgcn_exp2f(p1[r] - mref) * inv; }
#pragma unroll
                for (int nn = 0; nn < 8; ++nn) { const f32x16& P = (nn >> 2) ? p1 : p0; const int k4 = 4 * (nn & 3);
                    const float pe = swap_other(P[k4 + 3]);
                    const float prev = hi ? pe : carry;
                    ip[2 * (8 * tt + nn) + hi] = (P[k4] + P[k4 + 1]) + (P[k4 + 2] + 0.5f * P[k4 + 3]) + 0.5f * prev;
                    carry = pe; }
                pv(oc, lds + L_V + tt * VT_BYTES, p0, p1, lane);
            } else {
#pragma unroll
                for (int nn = 0; nn < 8; ++nn) ip[2 * (8 * tt + nn) + hi] = 0.f;
            }
        }
#undef CMP_SCORES
    }
    ATT_LBAR();
    for (int i = 0; i < 8; ++i) {
        const int tok = 8 * wave + i;
        float imp = -1.f;
        if (lane < 32) { const int j = lane; const float v = (impP[(0 * 64 + tok) * 32 + j] + impP[(1 * 64 + tok) * 32 + j]) + (impP[(2 * 64 + tok) * 32 + j] + impP[(3 * 64 + tok) * 32 + j]);
            const bool forced = (j == 0) || (j <= cur && j > cur - 2);
            imp = forced ? 1e4f : (j <= cur ? v : -1.f); }
        int rank = 0;
        for (int jj = 0; jj < 32; ++jj) { const float ov = __shfl(imp, jj); rank += (ov > imp || (ov == imp && jj < lane)) ? 1 : 0; }
        const unsigned msk = (unsigned)(__ballot(lane < 32 && rank < 16) & 0xffffffffull);
        if (lane == 0) selm[tok] = msk;
    }
    ATT_LBAR();
    acc_rows<0>(oc, g_c, wsf, accw, r32, hi);
    const unsigned vismask = (cur >= 31) ? 0xffffffffu : ((2u << cur) - 1u);
    const unsigned mysel = selm[tl] & vismask;
    unsigned U = selm[lane] & vismask;
#pragma unroll
    for (int of = 1; of < 64; of <<= 1) U |= (unsigned)__shfl_xor((int)U, of);
    U = (unsigned)__builtin_amdgcn_readfirstlane((int)U);
    {
        const bf16* ks = KV6 + (size_t)2 * M * 128 + (size_t)bk * SEQ * 64; const bf16* vs = KV6 + (size_t)3 * M * 128 + (size_t)bk * SEQ * 64;
        float m = MINIT, l = 0.f; f32x16 o[2]; o[0] = (f32x16){}; o[1] = (f32x16){};
        unsigned rem = U; int j = __builtin_ctz(rem); rem &= rem - 1u;
        TileRegs R; tile_issue(R, ks + (size_t)j * 4096, vs + (size_t)j * 4096, tid); tile_store(R, lds, 0, tid);
        ATT_BAR();
        int buf = 0;
        for (;;) {
            const int jn = rem ? __builtin_ctz(rem) : -1; rem &= rem - 1u;
            if (jn >= 0) tile_issue(R, ks + (size_t)jn * 4096, vs + (size_t)jn * 4096, tid);
            {
                f32x16 p0, p1; qkt(p0, p1, lds + L_K + buf * KT_BYTES, qr, r32, hi);
                const int dj = cur - j; const bool rowsel = (mysel >> j) & 1u;
                if (dj <= 2) nsa_scores<true>(p0, p1, dj, tl, hi, rowsel, 1 << 30, lut, cfar);
                else nsa_scores<false>(p0, p1, dj, tl, hi, rowsel, 1 << 30, lut, cfar);
                softmax_pv(p0, p1, o, m, l, lds + L_V + buf * VT_BYTES, wsf, lane);
            }
            if (jn >= 0) tile_store(R, lds, buf ^ 1, tid);
            ATT_BAR();
            if (jn < 0) break;
            j = jn; buf ^= 1;
        }
        l = swap_sum(l);
        acc_rows<1>(o, g_s / l, wsf, accw, r32, hi);
    }
    {
        const bf16* kw = KV6 + (size_t)4 * M * 128 + (size_t)bk * SEQ * 64; const bf16* vw = KV6 + (size_t)5 * M * 128 + (size_t)bk * SEQ * 64;
        float m = MINIT, l = 0.f; f32x16 o[2]; o[0] = (f32x16){}; o[1] = (f32x16){};
        const int jlo = cur - 8 > 0 ? cur - 8 : 0;
        int j = cur;
        TileRegs R; tile_issue(R, kw + (size_t)j * 4096, vw + (size_t)j * 4096, tid); tile_store(R, lds, 0, tid);
        ATT_BAR();
        int buf = 0;
        for (;;) {
            const int jn = j - 1;
            if (jn >= jlo) tile_issue(R, kw + (size_t)jn * 4096, vw + (size_t)jn * 4096, tid);
            {
                f32x16 p0, p1; qkt(p0, p1, lds + L_K + buf * KT_BYTES, qr, r32, hi);
                const int dj = cur - j;
                if (dj <= 2) nsa_scores<true>(p0, p1, dj, tl, hi, true, 512, lut, cfar);
                else nsa_scores<false>(p0, p1, dj, tl, hi, true, 512, lut, cfar);
                softmax_pv(p0, p1, o, m, l, lds + L_V + buf * VT_BYTES, wsf, lane);
            }
            if (jn >= jlo) tile_store(R, lds, buf ^ 1, tid);
            ATT_BAR();
            if (jn < jlo) break;
            j = jn; buf ^= 1;
        }
        l = swap_sum(l);
        acc_rows<2>(o, g_w / l, wsf, accw, r32, hi);
        store_rows(o, (LAS unsigned char*)accw, (bf16*)(ws + WS_YN) + ((size_t)b * SEQ + 64 * cur + 32 * th) * 512 + h * 64, 512, lane);
    }
}
}

__device__ __forceinline__ void p3_attention(const Frame& F) {
    PHASE_IDS(); const CArgs* a = kargs(); unsigned char* ws = a->ws;
    for (int u = F.vcu; u < 512; u += F.G) { const int idx = u & 255, sec = u >> 8, bh = idx >> 2, s = idx & 3; att::fox_unit(F.lds, ws, bh, sec ? s : 7 - s, tid); }
    for (int u = F.vcu; u < 512; u += F.G) { const int idx = u & 255, sec = u >> 8, bk = idx >> 4, s = idx & 15; att::nsa_unit(F.lds, ws, a->in[I_REL], bk, sec ? s : 31 - s, tid); }
}

constexpr int PH_PER_LAYER = 10, NPHASES = 1 + DEPTH * PH_PER_LAYER;
#ifndef REP_P0
#define REP_P0 1
#endif
#ifndef REP_INPROJ
#define REP_INPROJ 1
#endif
#ifndef REP_P2
#define REP_P2 1
#endif
#ifndef REP_ATTN
#define REP_ATTN 1
#endif
#ifndef REP_BRANCH
#define REP_BRANCH 1
#endif
#ifndef REP_WO
#define REP_WO 1
#endif
#ifndef REP_LN
#define REP_LN 1
#endif
#ifndef REP_UP
#define REP_UP 1
#endif
#ifndef REP_DOWN
#define REP_DOWN 1
#endif
#define REPEAT(n) for (int rep_ = 0; rep_ < (n); ++rep_)
#ifndef NAIVE_ATTN
#define NAIVE_ATTN 0
#endif
#ifndef MK_SINGLE
#define MK_SINGLE 1
#endif

#define IN(k) (lo <= (k) && (k) < hi)
#define SEAM(k) do { if (IN(k) && IN((k) + 1)) { XcdBarrier b_ = bar; asm volatile("" : "+s"(b_.bar)); xcd_barrier(b_); } } while (0)
template <int L> __device__ __forceinline__ void layer_body(const Frame& F, const int lo, const int hi, const XcdBarrier& bar) {
        const int pb = 1 + PH_PER_LAYER * L, j = L >> 1; const bool moe = (L & 1) != 0;
        if (IN(pb + 0)) REPEAT(REP_INPROJ) {
            const CArgs* ka = kargs(); unsigned char* ws = ka->ws;
            pg8::Gemm g{(const bf16*)(ws + WS_XB), (const bf16*)(ws + WS_WIN) + (size_t)L * NPROJ * DM, DM, DM, DM};
            pg8::StaticOrder S; S.init(M / 256, NPROJ / 256, F.G, (int)blockIdx.x);
            EpiInProj E{ws, ka->in[I_FB] + L * 8};
            pg8::gemm_phase<EpiInProj, pg8::StaticOrder, true, true>(F.lds, g, S, E, F.wave);
        }
        SEAM(pb + 0);
        if (IN(pb + 1)) REPEAT(REP_P2) { p2_cmp_scan(F, L); }
        SEAM(pb + 1);
        if (IN(pb + 2)) REPEAT(REP_ATTN) {
#if NAIVE_ATTN
            p3_fox_naive(F); __syncthreads(); p3_nsa_naive(F);
#else
            p3_attention(F);
#endif
        }
        SEAM(pb + 2);
        if (IN(pb + 3)) REPEAT(REP_BRANCH) {
            const CArgs* ka = kargs(); unsigned char* ws = ka->ws;
            pg8::StaticOrder S; S.init(M / 256, DM / 256, F.G, (int)blockIdx.x);
            { pg8::Gemm g{(const bf16*)(ws + WS_YN), (const bf16*)(ws + WS_WNSA) + (size_t)L * DM * 512, 512, 512, 512};
              EpiBranch<false> E{(const bf16*)(ws + WS_MG), (bf16*)(ws + WS_MERGED), 0};
              pg8::gemm_phase<EpiBranch<false>, pg8::StaticOrder, false, true>(F.lds, g, S, E, F.wave); }
            VM_WAIT(); __syncthreads();
            { pg8::Gemm g{(const bf16*)(ws + WS_YF), (const bf16*)(ws + WS_WFOX) + (size_t)L * DM * 512, 512, 512, 512};
              EpiBranch<true> E{(const bf16*)(ws + WS_MG), (bf16*)(ws + WS_MERGED), 1024};
              pg8::gemm_phase<EpiBranch<true>, pg8::StaticOrder, false, true>(F.lds, g, S, E, F.wave); }
        }
        SEAM(pb + 3);
        if (IN(pb + 4)) REPEAT(REP_WO) {
            const CArgs* ka = kargs(); unsigned char* ws = ka->ws;
            pg8::Gemm g{(const bf16*)(ws + WS_MERGED), (const bf16*)(ws + WS_WO) + (size_t)L * DM * DM, DM, DM, DM};
            pg8::StaticOrder S; S.init(M / 256, DM / 256, F.G, (int)blockIdx.x);
            EpiResF32 E{L == 0 ? ka->in[I_X] : (const float*)ka->out, (float*)(ws + WS_PRE)};
            pg8::gemm_phase<EpiResF32, pg8::StaticOrder, false, true>(F.lds, g, S, E, F.wave);
        }
        SEAM(pb + 4);
        if (IN(pb + 5)) {
            if (moe) ln_phase<0, true, I_LN1G, I_LN1B>(F, L, j);
            else ln_phase<0, false, I_LN1G, I_LN1B>(F, L, j);
        }
        SEAM(pb + 5);
        if (IN(pb + 6) && moe) { moe_gather(F, j); }
        if (moe) SEAM(pb + 6);
        if (IN(pb + 7)) REPEAT(REP_UP) {
            const CArgs* ka = kargs(); unsigned char* ws = ka->ws;
            if (moe) {
                int toff[9]; moe_tiles((unsigned*)(ws + WS_CTL), j, toff);
                pg8::MoeOrder S; S.so.init(toff[8], 2 * FF_E / 256, F.G, (int)blockIdx.x);
                S.t1 = toff[1]; S.t2 = toff[2]; S.t3 = toff[3]; S.t4 = toff[4]; S.t5 = toff[5]; S.t6 = toff[6]; S.t7 = toff[7];
                pg8::Gemm g{(const bf16*)(ws + WS_XG), (const bf16*)(ws + WS_WMGU) + (size_t)j * NEXP * 2 * FF_E * DM, DM, DM, DM};
                EpiSwiGLU E{(bf16*)(ws + WS_HID), FF_E};
                pg8::gemm_phase<EpiSwiGLU, pg8::MoeOrder, true, true>(F.lds, g, S, E, F.wave);
            } else {
                pg8::Gemm g{(const bf16*)(ws + WS_XB), (const bf16*)(ws + WS_WDGU) + (size_t)j * 2 * FF_D * DM, DM, DM, DM};
                pg8::StaticOrder S; S.init(M / 256, 2 * FF_D / 256, F.G, (int)blockIdx.x);
                EpiSwiGLU E{(bf16*)(ws + WS_HID), FF_D};
                pg8::gemm_phase<EpiSwiGLU, pg8::StaticOrder, true, true>(F.lds, g, S, E, F.wave);
            }
        }
        SEAM(pb + 7);
        if (IN(pb + 8)) REPEAT(REP_DOWN) {
            const CArgs* ka = kargs(); unsigned char* ws = ka->ws;
            if (moe) {
                int toff[9]; moe_tiles((unsigned*)(ws + WS_CTL), j, toff);
                pg8::MoeOrder S; S.so.init(toff[8], DM / 256, F.G, (int)blockIdx.x);
                S.t1 = toff[1]; S.t2 = toff[2]; S.t3 = toff[3]; S.t4 = toff[4]; S.t5 = toff[5]; S.t6 = toff[6]; S.t7 = toff[7];
                pg8::Gemm g{(const bf16*)(ws + WS_HID), (const bf16*)(ws + WS_WMD) + (size_t)j * NEXP * DM * FF_E, FF_E, FF_E, FF_E};
                EpiPlainBf16 E{(bf16*)(ws + WS_XG)};
                pg8::gemm_phase<EpiPlainBf16, pg8::MoeOrder, true, true>(F.lds, g, S, E, F.wave);
            } else {
                pg8::Gemm g{(const bf16*)(ws + WS_HID), (const bf16*)(ws + WS_WDD) + (size_t)j * DM * FF_D, FF_D, FF_D, FF_D};
                pg8::StaticOrder S; S.init(M / 256, DM / 256, F.G, (int)blockIdx.x);
                EpiResF32 E{(const float*)ka->out, (float*)(ws + WS_PRE)};
                pg8::gemm_phase<EpiResF32, pg8::StaticOrder, false, true>(F.lds, g, S, E, F.wave);
            }
        }
        SEAM(pb + 8);
        if (IN(pb + 9)) REPEAT(REP_LN) {
            if (moe) ln_phase<1, false, I_LN2G, I_LN2B>(F, L, j);
            else ln_phase<0, false, I_LN2G, I_LN2B>(F, L, j);
        }
        SEAM(pb + 9);
    }

__global__ void __launch_bounds__(NWAVES * 64, 2) hybrid_fwd(Args args) {
    extern __shared__ __attribute__((aligned(16))) unsigned char lds[];
    Frame F;
    F.lds = (LAS unsigned char*)lds;
    F.wave = __builtin_amdgcn_readfirstlane((int)threadIdx.x >> 6);
    F.G = gridDim.x; { const int bx = blockIdx.x; F.vcu = (F.G % 8 == 0) ? (bx % 8) * (F.G / 8) + bx / 8 : bx; }
    for (int u = threadIdx.x; u < (LDS_BYTES - LDSCTL_OFF) / 4; u += NWAVES * 64) ((LAS unsigned*)(F.lds + LDSCTL_OFF))[u] = 0u;
    __syncthreads();
    const int lo = args.ph_lo, hi = args.ph_hi;
    XcdBarrier bar; bar.bar = (unsigned*)(args.ws + WS_CTL) + CW_BAR; bar.x = 0; bar.st = nullptr;
    if (hi - lo > 1) bar = xcd_barrier_post((unsigned*)(args.ws + WS_CTL) + CW_BAR, (volatile LAS unsigned*)(F.lds + MISC_OFF) + 8);

    if (IN(0)) { REPEAT(REP_P0) p0_prologue(F); }
    SEAM(0);

    layer_body<0>(F, lo, hi, bar); layer_body<1>(F, lo, hi, bar); layer_body<2>(F, lo, hi, bar); layer_body<3>(F, lo, hi, bar);
#undef IN
#undef SEAM
}

extern "C" void kernel_launch(void* const* d_in, const int* in_sizes, int n_in, void* d_out, int out_size, void* d_ws, size_t ws_size, hipStream_t stream) {
    static int grid = 0;
    if (grid == 0) {
        if (n_in != 21 || in_sizes[0] != M * DM || out_size != M * DM || ws_size < WS_END) { fprintf(stderr, "kernel_launch: unexpected shapes / workspace (n_in %d, ws %zu, need %zu); nothing launched\n", n_in, ws_size, (size_t)WS_END); grid = -1; return; }
        int dev = 0, cus = 0, per_cu = 0;
        if (hipGetDevice(&dev) != hipSuccess || hipDeviceGetAttribute(&cus, hipDeviceAttributeMultiprocessorCount, dev) != hipSuccess) { grid = -1; return; }
        if (hipFuncSetAttribute((const void*)hybrid_fwd, hipFuncAttributeMaxDynamicSharedMemorySize, LDS_BYTES) != hipSuccess) { fprintf(stderr, "kernel_launch: hipFuncSetAttribute failed\n"); grid = -1; return; }
        if (hipOccupancyMaxActiveBlocksPerMultiprocessor(&per_cu, (const void*)hybrid_fwd, NWAVES * 64, LDS_BYTES) != hipSuccess || per_cu < 1) { fprintf(stderr, "kernel_launch: occupancy query reports %d blocks per CU\n", per_cu); }
        (void)hipGetLastError();
        grid = cus;
    }
    if (grid < 0) return;
    if (hipMemsetAsync((char*)d_ws + WS_CTL, 0, CTL_ZERO_BYTES, stream) != hipSuccess) return;
    Args a{};
    for (int i = 0; i < 21; ++i) a.in[i] = (const float*)d_in[i];
    a.out = (float*)d_out; a.ws = (unsigned char*)d_ws;
#if MK_SINGLE
    a.ph_lo = 0; a.ph_hi = NPHASES;
    hipLaunchKernelGGL(hybrid_fwd, dim3(grid), dim3(NWAVES * 64), LDS_BYTES, stream, a);
#else
    for (int p = 0; p < NPHASES; ++p) {
        if (p >= 1) { const int L = (p - 1) / PH_PER_LAYER, k = (p - 1) % PH_PER_LAYER; if (k == 6 && !(L & 1)) continue; }
        a.ph_lo = p; a.ph_hi = p + 1;
        hipLaunchKernelGGL(hybrid_fwd, dim3(grid), dim3(NWAVES * 64), LDS_BYTES, stream, a);
    }
#endif
}
```

```cpp
#include <hip/hip_runtime.h>
#include <cstdio>
#include <cstdint>

namespace pg8 {
#define PG8_LAS __attribute__((address_space(3)))
typedef unsigned short bf16_t;
typedef short bf16x8 __attribute__((ext_vector_type(8)));
typedef float f32x4 __attribute__((ext_vector_type(4)));
typedef float f32x2 __attribute__((ext_vector_type(2)));
typedef unsigned u32x4 __attribute__((ext_vector_type(4)));
constexpr int BM = 256, BK = 64, HALF = 128, HTB = HALF * BK * 2, STAGE_BYTES = 8 * HTB, NXCD = 8, WGM = 8;

__host__ __device__ __forceinline__ int lds_byte(int r, int c) { const int st = (r >> 4) * 2 + (c >> 5), rr = r & 15, cc = c & 31, ob = rr * 64 + cc * 2; return st * 1024 + (ob ^ (((ob >> 9) & 1) << 5)); }
__host__ __device__ __forceinline__ void stage_rc(int b, int& R, int& C) { const int st = b / 1024, sb = b % 1024, swz = sb ^ (((sb >> 9) & 1) << 5); R = (st >> 1) * 16 + swz / 64; C = (st & 1) * 32 + (swz % 64) / 2; }
__host__ __device__ __forceinline__ int perm32(int rho) { const int n = rho >> 4, i = rho & 15; return 8 * (i >> 2) + 4 * n + (i & 3); }

struct Unit { int pm, pn, pb; };
struct Gemm { const bf16_t* A; const bf16_t* Bt; int lda, ldb, K; };

struct StaticOrder {
    int nM, nN, nwg, G, c;
    __device__ __forceinline__ void init(int nM_, int nN_, int G_, int c_) { nM = nM_; nN = nN_; nwg = nM * nN; G = G_; c = c_; }
    __device__ __forceinline__ bool next(int i, Unit& u) const {
        const long L = (long)i * G + c; if (L >= nwg) return false;
        int wgid = (int)L; { const int q = nwg / NXCD, r = nwg % NXCD, xcd = wgid % NXCD, off = wgid / NXCD; wgid = (xcd < r ? xcd * (q + 1) : r * (q + 1) + (xcd - r) * q) + off; }
        const int nig = WGM * nN, gid = wgid / nig, fm = gid * WGM, gsz = (nM - fm) < WGM ? (nM - fm) : WGM;
        u.pm = fm + ((wgid % nig) % gsz); u.pn = (wgid % nig) / gsz; u.pb = u.pn; return true;
    }
};
struct MoeOrder {
    StaticOrder so; int t1, t2, t3, t4, t5, t6, t7;
    __device__ __forceinline__ bool next(int i, Unit& u) const {
        if (!so.next(i, u)) return false;
        const int e = (u.pm >= t1) + (u.pm >= t2) + (u.pm >= t3) + (u.pm >= t4) + (u.pm >= t5) + (u.pm >= t6) + (u.pm >= t7);
        u.pb = e * so.nN + u.pn; return true;
    }
};

__device__ __forceinline__ unsigned cvt_pk_bf16(float lo, float hi) { unsigned r; asm volatile("v_cvt_pk_bf16_f32 %0, %1, %2" : "=v"(r) : "v"(lo), "v"(hi)); return r; }

template <class Epi, class Sched, bool ALIGN_EPI, bool SP2>
__device__ __forceinline__ void gemm_phase(PG8_LAS unsigned char* lds, const Gemm g, const Sched& S, const Epi& E, int wid_in) {
    int wid = wid_in; asm volatile("" : "+s"(wid));
    int lane; asm volatile("v_mbcnt_lo_u32_b32 %0, -1, 0\n\tv_mbcnt_hi_u32_b32 %0, -1, %0" : "=v"(lane));
    const int tid = wid * 64 + lane, wr = wid >> 2, wc = wid & 3, fr = lane & 15, fq = lane >> 4;
    const int K = g.K, nt = K / BK;
    unsigned voffA[2], voffB[2];
#pragma unroll
    for (int i = 0; i < 2; ++i) { int R, C; stage_rc(tid * 16 + i * 8192, R, C); const int Rb = Epi::PERM ? ((R & ~31) + perm32(R & 31)) : R;
        voffA[i] = (unsigned)(R * g.lda + C) * 2u; voffB[i] = (unsigned)(Rb * g.ldb + C) * 2u; }
    const size_t kstep = (size_t)(BK * 2);
    const size_t hstepA = (size_t)HALF * g.lda * 2, hstepB = (size_t)HALF * g.ldb * 2;
    const size_t tstepA = 2 * hstepA, tstepB = 2 * hstepB;
    const unsigned ldsw = (unsigned)wid * 1024u;
    const int aoff = lds_byte(wr * 64 + fr, fq * 8), boff = lds_byte(wc * 32 + fr, fq * 8);
#define PG8_SA(b, h) (((b) * 2 + (h)) * HTB)
#define PG8_SB(b, h) ((4 + (b) * 2 + (h)) * HTB)
#define PG8_STAGE(bufoff, gbase, voff) do { _Pragma("unroll") for (int _i = 0; _i < 2; ++_i) \
        __builtin_amdgcn_global_load_lds((const unsigned*)((const char*)(gbase) + (voff)[_i]), (PG8_LAS unsigned*)(lds + (bufoff) + ldsw + _i * 8192), 16, 0, 0); } while (0)
#define PG8_LDA(dst, b, h) do { _Pragma("unroll") for (int m = 0; m < 4; ++m) _Pragma("unroll") for (int k = 0; k < 2; ++k) dst[m][k] = *(const PG8_LAS bf16x8*)(lds + PG8_SA(b, h) + aoff + m * 2048 + k * 1024); } while (0)
#define PG8_LDB(dst, b, h) do { _Pragma("unroll") for (int n = 0; n < 2; ++n) _Pragma("unroll") for (int k = 0; k < 2; ++k) dst[n][k] = *(const PG8_LAS bf16x8*)(lds + PG8_SB(b, h) + boff + n * 2048 + k * 1024); } while (0)
#define PG8_MMA(ai, bj, At, Bt) do { __builtin_amdgcn_s_setprio(1); _Pragma("unroll") for (int m = 0; m < 4; ++m) _Pragma("unroll") for (int n = 0; n < 2; ++n) _Pragma("unroll") for (int k = 0; k < 2; ++k) \
        acc[ai][bj][m][n] = __builtin_amdgcn_mfma_f32_16x16x32_bf16(Bt[n][k], At[m][k], acc[ai][bj][m][n], 0, 0, 0); __builtin_amdgcn_s_setprio(0); } while (0)
#define PG8_WAIT_V(n) asm volatile("s_waitcnt vmcnt(" #n ")" ::: "memory")
#define PG8_WAIT_L(n) asm volatile("s_waitcnt lgkmcnt(" #n ")" ::: "memory")
#define PG8_BAR __builtin_amdgcn_s_barrier()
#define PG8_SCHED __builtin_amdgcn_sched_barrier(0)
    Unit cur, nxt; int ui = 0;
    if (!S.next(0, cur)) return;
    f32x4 acc[2][2][4][2];
#pragma unroll
    for (int a = 0; a < 2; ++a)
#pragma unroll
        for (int b = 0; b < 2; ++b)
#pragma unroll
            for (int m = 0; m < 4; ++m)
#pragma unroll
                for (int n = 0; n < 2; ++n) acc[a][b][m][n] = (f32x4){0.f, 0.f, 0.f, 0.f};
    bf16x8 At[4][2], B0[2][2], B1[2][2];
    const char* cA = (const char*)g.A + (size_t)cur.pm * tstepA; const char* cB = (const char*)g.Bt + (size_t)cur.pb * tstepB;
    if constexpr (SP2) {
        PG8_STAGE(PG8_SB(0, 0), cB, voffB); PG8_STAGE(PG8_SB(0, 1), cB + hstepB, voffB); PG8_STAGE(PG8_SA(0, 0), cA, voffA); PG8_STAGE(PG8_SA(0, 1), cA + hstepA, voffA);
        if (wr == 1) PG8_BAR;
        PG8_WAIT_V(2); PG8_BAR;
        PG8_STAGE(PG8_SB(1, 0), cB + kstep, voffB); PG8_STAGE(PG8_SA(1, 0), cA + kstep, voffA); PG8_STAGE(PG8_SB(1, 1), cB + hstepB + kstep, voffB);
        PG8_WAIT_V(6); PG8_BAR;
    } else {
        PG8_STAGE(PG8_SB(0, 0), cB, voffB); PG8_STAGE(PG8_SA(0, 0), cA, voffA); PG8_STAGE(PG8_SB(0, 1), cB + hstepB, voffB); PG8_STAGE(PG8_SA(0, 1), cA + hstepA, voffA);
        if (wr == 1) PG8_BAR;
        PG8_WAIT_V(4); PG8_BAR;
        PG8_STAGE(PG8_SB(1, 0), cB + kstep, voffB); PG8_STAGE(PG8_SA(1, 0), cA + kstep, voffA); PG8_STAGE(PG8_SB(1, 1), cB + hstepB + kstep, voffB);
        PG8_WAIT_V(6); PG8_BAR;
    }
    for (;;) {
        const bool has_next = S.next(ui + 1, nxt);
        const char* nA = has_next ? (const char*)g.A + (size_t)nxt.pm * tstepA : cA; const char* nB = has_next ? (const char*)g.Bt + (size_t)nxt.pb * tstepB : cB;
        for (int t = 0; t < nt; t += 2) {
            const bool last = (t == nt - 2);
            const char* a1 = cA + (size_t)(t + 1) * kstep;
            const char* a2 = last ? nA : cA + (size_t)(t + 2) * kstep; const char* b2 = last ? nB : cB + (size_t)(t + 2) * kstep;
            const char* a3 = a2 + kstep; const char* b3 = b2 + kstep;
            if constexpr (SP2) {
            PG8_LDB(B0, 0, 0); PG8_LDB(B1, 0, 1); PG8_SCHED; PG8_LDA(At, 0, 0); PG8_STAGE(PG8_SA(1, 1), a1 + hstepA, voffA);
            PG8_WAIT_V(8); PG8_WAIT_L(0); PG8_BAR; PG8_MMA(0, 0, At, B0); PG8_MMA(0, 1, At, B1); PG8_BAR; PG8_SCHED;
            PG8_LDA(At, 0, 1); PG8_STAGE(PG8_SB(0, 0), b2, voffB); PG8_STAGE(PG8_SB(0, 1), b2 + hstepB, voffB); PG8_STAGE(PG8_SA(0, 0), a2, voffA);
            PG8_WAIT_V(8); PG8_WAIT_L(0); PG8_BAR; PG8_MMA(1, 0, At, B0); PG8_MMA(1, 1, At, B1); PG8_BAR; PG8_SCHED;
            PG8_LDB(B0, 1, 0); PG8_LDB(B1, 1, 1); PG8_SCHED; PG8_LDA(At, 1, 0); PG8_STAGE(PG8_SA(0, 1), a2 + hstepA, voffA);
            PG8_WAIT_V(8); PG8_WAIT_L(0); PG8_BAR; PG8_MMA(0, 0, At, B0); PG8_MMA(0, 1, At, B1); PG8_BAR; PG8_SCHED;
            PG8_LDA(At, 1, 1); PG8_STAGE(PG8_SB(1, 0), b3, voffB); PG8_STAGE(PG8_SB(1, 1), b3 + hstepB, voffB); PG8_STAGE(PG8_SA(1, 0), a3, voffA);
            PG8_WAIT_V(8); PG8_WAIT_L(0); PG8_BAR; PG8_MMA(1, 0, At, B0); PG8_MMA(1, 1, At, B1); PG8_BAR; PG8_SCHED;
            } else {
            PG8_LDB(B0, 0, 0); PG8_SCHED; PG8_LDA(At, 0, 0); PG8_STAGE(PG8_SA(1, 1), a1 + hstepA, voffA);
            PG8_WAIT_L(8); PG8_BAR; PG8_WAIT_L(0); PG8_MMA(0, 0, At, B0); PG8_BAR; PG8_SCHED;
            PG8_LDB(B1, 0, 1); PG8_STAGE(PG8_SB(0, 0), b2, voffB);
            PG8_BAR; PG8_WAIT_L(0); PG8_MMA(0, 1, At, B1); PG8_BAR;
            PG8_LDA(At, 0, 1); PG8_STAGE(PG8_SA(0, 0), a2, voffA);
            PG8_BAR; PG8_WAIT_L(0); PG8_MMA(1, 0, At, B0); PG8_BAR; PG8_SCHED;
            PG8_STAGE(PG8_SB(0, 1), b2 + hstepB, voffB);
            PG8_WAIT_V(6); PG8_BAR; PG8_MMA(1, 1, At, B1); PG8_BAR;
            PG8_LDB(B0, 1, 0); PG8_SCHED; PG8_LDA(At, 1, 0); PG8_STAGE(PG8_SA(0, 1), a2 + hstepA, voffA);
            PG8_WAIT_L(8); PG8_BAR; PG8_WAIT_L(0); PG8_MMA(0, 0, At, B0); PG8_BAR; PG8_SCHED;
            PG8_LDB(B1, 1, 1); PG8_STAGE(PG8_SB(1, 0), b3, voffB);
            PG8_BAR; PG8_WAIT_L(0); PG8_MMA(0, 1, At, B1); PG8_BAR;
            PG8_LDA(At, 1, 1); PG8_STAGE(PG8_SA(1, 0), a3, voffA);
            PG8_BAR; PG8_WAIT_L(0); PG8_MMA(1, 0, At, B0); PG8_BAR; PG8_SCHED;
            PG8_STAGE(PG8_SB(1, 1), b3 + hstepB, voffB);
            PG8_WAIT_V(6); PG8_BAR; PG8_MMA(1, 1, At, B1); PG8_BAR;
            }
        }
        if constexpr (ALIGN_EPI) { if (wr == 0) PG8_BAR; }
        E(acc, cur, wr, wc, fr, fq);
        if (!has_next) break;
#pragma unroll
        for (int a = 0; a < 2; ++a)
#pragma unroll
            for (int b = 0; b < 2; ++b)
#pragma unroll
                for (int m = 0; m < 4; ++m)
#pragma unroll
                    for (int n = 0; n < 2; ++n) acc[a][b][m][n] = (f32x4){0.f, 0.f, 0.f, 0.f};
        cur = nxt; cA = nA; cB = nB; ++ui;
        if constexpr (ALIGN_EPI) { if (wr == 1) PG8_BAR; }
    }
    PG8_WAIT_V(0);
    if constexpr (!ALIGN_EPI) { if (wr == 0) PG8_BAR; }
    PG8_BAR;
#undef PG8_SA
#undef PG8_SB
#undef PG8_STAGE
#undef PG8_LDA
#undef PG8_LDB
#undef PG8_MMA
#undef PG8_WAIT_V
#undef PG8_WAIT_L
#undef PG8_BAR
#undef PG8_SCHED
}
}

constexpr int NWAVES = 8;
constexpr int BATCH = 8, SEQ = 2048, DM = 1024, DEPTH = 4, M = BATCH * SEQ;
constexpr int HD = 64, NSA_H = 8, NSA_KVH = 2, NSA_G = 4, FOX_H = 8;
constexpr int N_CMP = 127, CMP_HID = 128;
constexpr int D_IN = 4896, NPROJ = 5120;
constexpr int FF_D = 2816, FF_E = 3584, NEXP = 8;
constexpr int XG_ROWS = 34816;
constexpr float LN_EPS = 1e-5f, DN_ALPHA = 1.681792830507429f, LOG2E = 1.4426950408889634f;
constexpr int PC_Q = 0, PC_KV = 512, PC_FOX = 1280, PC_MG = 2816, PC_MISC = 4864;
constexpr int SC_Q = 0, SC_KV = 512, SC_NG = 1280, SC_FOX = 1304, SC_FF = 2840, SC_MG = 2848;

constexpr size_t MiB = 1u << 20;
constexpr size_t WS_CTL = 0, CTL_ZERO_BYTES = 1 * MiB;
constexpr size_t WS_CBP = 1 * MiB;
constexpr size_t WS_NG = 2 * MiB;
constexpr size_t WS_LF = 4 * MiB;
constexpr size_t WS_NF2 = 4 * MiB + 512 * 1024;
constexpr size_t WS_KCC = 5 * MiB;
constexpr size_t WS_VCC = 5 * MiB + 256 * 1024;
constexpr size_t WS_TOKE = 5 * MiB + 512 * 1024;
constexpr size_t WS_TOKW = WS_TOKE + 128 * 1024;
constexpr size_t WS_TOKP = WS_TOKW + 128 * 1024;
constexpr size_t WS_TOKS = WS_TOKP + 128 * 1024;
constexpr size_t WS_WIN = 8 * MiB;
constexpr size_t WS_WC1 = 48 * MiB;
constexpr size_t WS_WNSA = 52 * MiB;
constexpr size_t WS_WFOX = 56 * MiB;
constexpr size_t WS_WO = 60 * MiB;
constexpr size_t WS_WDGU = 68 * MiB;
constexpr size_t WS_WDD = 90 * MiB;
constexpr size_t WS_WMGU = 102 * MiB;
constexpr size_t WS_WMD = 326 * MiB;
constexpr size_t WS_XB = 438 * MiB;
constexpr size_t WS_PRE = 470 * MiB;
constexpr size_t WS_XG = 534 * MiB;
constexpr size_t WS_HID = 602 * MiB;
constexpr size_t WS_QN = 602 * MiB;
constexpr size_t WS_KV6 = 618 * MiB;
constexpr size_t WS_FQKV = 642 * MiB;
constexpr size_t WS_MG = 690 * MiB;
constexpr size_t WS_YN = 754 * MiB;
constexpr size_t WS_YF = 770 * MiB;
constexpr size_t WS_MERGED = 786 * MiB;
constexpr size_t WS_END = 840 * MiB;
static_assert(WS_HID + (size_t)XG_ROWS * FF_E * 2 <= WS_END && WS_MERGED + (size_t)M * DM * 2 <= WS_END, "ws map");
constexpr int CW_BAR = 4096;
constexpr int CW_MOECNT = 16384;

constexpr int RING_BYTES = 131072;
constexpr int ATT_LDS_LIMIT = 143360;
constexpr int LDSCTL_OFF = ATT_LDS_LIMIT, MISC_OFF = LDSCTL_OFF + 320;
constexpr int LDS_BYTES = 147456;

#define GAS __attribute__((address_space(1)))
#define LAS __attribute__((address_space(3)))
typedef unsigned short bf16;
typedef unsigned v4u __attribute__((ext_vector_type(4)));
typedef unsigned v2u __attribute__((ext_vector_type(2)));
typedef float f32x4 __attribute__((ext_vector_type(4)));
typedef float f32x16 __attribute__((ext_vector_type(16)));
typedef short bf16x8 __attribute__((ext_vector_type(8)));
#define LDS_WAIT() asm volatile("s_waitcnt lgkmcnt(0)" ::: "memory")
#define VM_WAIT() asm volatile("s_waitcnt vmcnt(0)" ::: "memory")
__device__ __forceinline__ unsigned f2bf(float f) { unsigned u = __builtin_bit_cast(unsigned, f); return (u + 0x7fffu + ((u >> 16) & 1u)) >> 16; }
__device__ __forceinline__ unsigned pk2(float lo, float hi) { return f2bf(lo) | (f2bf(hi) << 16); }
__device__ __forceinline__ float bf2f(unsigned v) { return __builtin_bit_cast(float, v << 16); }
__device__ __forceinline__ float bflo(unsigned w) { return __builtin_bit_cast(float, w << 16); }
__device__ __forceinline__ float bfhi(unsigned w) { return __builtin_bit_cast(float, w & 0xffff0000u); }
__device__ __forceinline__ float sigmoidf_(float x) { return 1.f / (1.f + __expf(-x)); }
__device__ __forceinline__ float wave_sum(float v) {
#pragma unroll
    for (int o = 1; o < 64; o <<= 1) v += __shfl_xor(v, o);
    return v;
}
__device__ __forceinline__ float wave_max(float v) {
#pragma unroll
    for (int o = 1; o < 64; o <<= 1) v = fmaxf(v, __shfl_xor(v, o));
    return v;
}
__constant__ unsigned char T5LUT[128] = {0, 1, 2, 3, 4, 5, 6, 7, 8, 9, 10, 11, 12, 13, 14, 15, 16, 16, 16, 17, 17, 18, 18, 18, 19, 19, 19, 20, 20, 20, 20, 21, 21, 21, 21, 22, 22, 22, 22, 22, 23, 23, 23, 23, 23, 23, 24, 24, 24, 24, 24, 24, 25, 25, 25, 25, 25, 25, 25, 26, 26, 26, 26, 26, 26, 26, 26, 27, 27, 27, 27, 27, 27, 27, 27, 27, 27, 28, 28, 28, 28, 28, 28, 28, 28, 28, 28, 29, 29, 29, 29, 29, 29, 29, 29, 29, 29, 29, 29, 30, 30, 30, 30, 30, 30, 30, 30, 30, 30, 30, 30, 30, 30, 31, 31, 31, 31, 31, 31, 31, 31, 31, 31, 31, 31, 31, 31, 31};
__device__ __forceinline__ int t5b(int n) { return n < 128 ? (int)T5LUT[n] : 31; }

#define XB_TMO      128
#define XB_XCNT(j)  (256  + 64 * (j))
#define XB_XSUB(j)  (1280 + 64 * (j))
#define XB_XGEN(j)  (2304 + 64 * (j))
#define XB_TOP      3328
#define XB_TOPGEN   3392
#define XCD_BAR_WORDS 3456
#define XB_SPIN_CAP (1u << 18)

__device__ __forceinline__ unsigned xb_ld(unsigned* p)              { return __hip_atomic_load(p, __ATOMIC_RELAXED, __HIP_MEMORY_SCOPE_AGENT); }
__device__ __forceinline__ unsigned xb_add(unsigned* p, unsigned v) { return __hip_atomic_fetch_add(p, v, __ATOMIC_RELAXED, __HIP_MEMORY_SCOPE_AGENT); }
__device__ __forceinline__ unsigned xb_xcc_id() { return (unsigned)__builtin_amdgcn_s_getreg((3 << 11) | 20) & 0xFu; }
#define XB_SPIN(cond, bar) do { unsigned _sp = 0; while (cond) { __builtin_amdgcn_s_sleep(1); \
    if ((++_sp & 255u) == 0u) { if (xb_ld(&(bar)[XB_TMO])) break; if (_sp > XB_SPIN_CAP) { atomicAdd(&(bar)[XB_TMO], 1u); break; } } } } while (0)

struct XcdBarrier {
    unsigned* bar; unsigned x;
    volatile LAS unsigned* st;
};

__device__ __forceinline__ XcdBarrier xcd_barrier_post(unsigned* bar, volatile LAS unsigned* st) {
    XcdBarrier b; b.bar = bar; b.x = xb_xcc_id(); b.st = st;
    if (threadIdx.x == 0) (void)xb_add(&bar[XB_XCNT(b.x)], 1u);
    return b;
}
__device__ __forceinline__ void xcd_barrier_complete(unsigned* bar, unsigned x, unsigned& nloc, unsigned& nx) {
    const unsigned G = gridDim.x * gridDim.y * gridDim.z;
    unsigned sum, cnt, mine, sp = 0u;
    for (;;) {
        sum = 0u; cnt = 0u; mine = 0u;
#pragma unroll
        for (unsigned j = 0; j < 16; ++j) { const unsigned c = xb_ld(&bar[XB_XCNT(j)]); sum += c; cnt += (c > 0u) ? 1u : 0u; mine = (j == x) ? c : mine; }
        if (sum == G) break;
        __builtin_amdgcn_s_sleep(1);
        if ((++sp & 255u) == 0u) { if (xb_ld(&bar[XB_TMO])) break; if (sp > XB_SPIN_CAP) { atomicAdd(&bar[XB_TMO], 1u); break; } }
    }
    nloc = mine > 0u ? mine : 1u; nx = cnt > 0u ? cnt : 1u;
}

__device__ __forceinline__ void xcd_barrier(const XcdBarrier& b) {
    asm volatile("s_waitcnt vmcnt(0)" ::: "memory");
    __syncthreads();
    if (threadIdx.x == 0) {
        unsigned* bar = b.bar;
        __builtin_amdgcn_s_waitcnt(0);
        unsigned nloc = b.st[0], nx = b.st[1];
        if (nloc == 0u) { xcd_barrier_complete(bar, b.x, nloc, nx); b.st[0] = nloc; b.st[1] = nx; }
        const unsigned old = xb_add(&bar[XB_XSUB(b.x)], 1u);
        const unsigned gen = old / nloc;
        if (old + 1u == (gen + 1u) * nloc) {
            __builtin_amdgcn_fence(__ATOMIC_RELEASE, "agent");
            asm volatile("s_waitcnt vmcnt(0)" ::: "memory");
            const unsigned og = xb_add(&bar[XB_TOP], 1u);
            const unsigned tg = og / nx;
            if (og + 1u == (tg + 1u) * nx) xb_add(&bar[XB_TOPGEN], 1u);
            else XB_SPIN(xb_ld(&bar[XB_TOPGEN]) == tg, bar);
            __builtin_amdgcn_fence(__ATOMIC_ACQUIRE, "agent");
            xb_add(&bar[XB_XGEN(b.x)], 1u);
            asm volatile("s_waitcnt vmcnt(0)" ::: "memory");
        } else {
            XB_SPIN(xb_ld(&bar[XB_XGEN(b.x)]) == gen, bar);
            __builtin_amdgcn_fence(__ATOMIC_ACQUIRE, "agent");
            asm volatile("s_waitcnt vmcnt(0)" ::: "memory");
        }
    }
    __syncthreads();
}

using pg8::Unit; using pg8::cvt_pk_bf16;
typedef const f32x4 (&AccRef)[2][2][4][2];

struct EpiInProj {
    static constexpr bool PERM = true;
    unsigned char* ws; const float* fbias;
    __device__ __forceinline__ void operator()(AccRef acc, const Unit& u, int wr, int wc, int fr, int fq) const {
        const int row0 = u.pm * 256 + wr * 64 + fr;
#pragma unroll
        for (int bj = 0; bj < 2; ++bj) {
            const int cw = u.pn * 256 + bj * 128 + wc * 32;
            const int c = cw + 8 * fq;
            if (cw < PC_MG) {
                bf16* base; int nh, head; float sc = 1.f;
                if (cw < PC_KV) { base = (bf16*)(ws + WS_QN); nh = 8; head = c >> 6; sc = 0.125f * LOG2E; }
                else if (cw < PC_FOX) { const int cc = c - PC_KV; base = (bf16*)(ws + WS_KV6) + (size_t)(cc >> 7) * ((size_t)M * 128); nh = 2; head = (cc >> 6) & 1; }
                else { const int cc = c - PC_FOX; const int which = cc >> 9; base = (bf16*)(ws + WS_FQKV) + (size_t)which * ((size_t)M * 512); nh = 8; head = (cc >> 6) & 7; sc = (which == 0) ? 0.125f * LOG2E : 1.f; }
                const int d = c & 63;
#pragma unroll
                for (int ai = 0; ai < 2; ++ai)
#pragma unroll
                    for (int m = 0; m < 4; ++m) {
                        const int row = row0 + ai * 128 + m * 16, b = row >> 11, s = row & 2047;
                        const f32x4 v0 = acc[ai][bj][m][0] * sc, v1 = acc[ai][bj][m][1] * sc;
                        v4u w; w.x = cvt_pk_bf16(v0[0], v0[1]); w.y = cvt_pk_bf16(v0[2], v0[3]); w.z = cvt_pk_bf16(v1[0], v1[1]); w.w = cvt_pk_bf16(v1[2], v1[3]);
                        *(v4u*)(base + ((size_t)(b * nh + head) * SEQ + s) * 64 + d) = w;
                    }
            } else if (cw < PC_MISC) {
                bf16* mg = (bf16*)(ws + WS_MG);
#pragma unroll
                for (int ai = 0; ai < 2; ++ai)
#pragma unroll
                    for (int m = 0; m < 4; ++m) {
                        const int row = row0 + ai * 128 + m * 16;
                        const f32x4 a = acc[ai][bj][m][0], bq = acc[ai][bj][m][1];
                        v4u w; w.x = cvt_pk_bf16(sigmoidf_(a[0]), sigmoidf_(a[1])); w.y = cvt_pk_bf16(sigmoidf_(a[2]), sigmoidf_(a[3]));
                        w.z = cvt_pk_bf16(sigmoidf_(bq[0]), sigmoidf_(bq[1])); w.w = cvt_pk_bf16(sigmoidf_(bq[2]), sigmoidf_(bq[3]));
                        *(v4u*)(mg + (size_t)row * 2048 + (c - PC_MG)) = w;
                    }
            } else if (cw == PC_MISC) {
                float* ng = (float*)(ws + WS_NG); float* lf = (float*)(ws + WS_LF);
#pragma unroll
                for (int ai = 0; ai < 2; ++ai)
#pragma unroll
                    for (int m = 0; m < 4; ++m) {
                        const int row = row0 + ai * 128 + m * 16;
                        const f32x4 a = acc[ai][bj][m][0], bq = acc[ai][bj][m][1];
                        if (fq < 3) {
                            float* o = ng + (size_t)row * 24 + 8 * fq;
                            *(f32x4*)o = (f32x4){sigmoidf_(a[0]), sigmoidf_(a[1]), sigmoidf_(a[2]), sigmoidf_(a[3])};
                            *(f32x4*)(o + 4) = (f32x4){sigmoidf_(bq[0]), sigmoidf_(bq[1]), sigmoidf_(bq[2]), sigmoidf_(bq[3])};
                        } else {
                            float* o = lf + (size_t)row * 8; float r[8];
#pragma unroll
                            for (int i = 0; i < 8; ++i) { const float x = (i < 4 ? a[i & 3] : bq[i & 3]) + fbias[i]; r[i] = fminf(x, 0.f) - log1pf(__expf(-fabsf(x))); }
                            *(f32x4*)o = (f32x4){r[0], r[1], r[2], r[3]}; *(f32x4*)(o + 4) = (f32x4){r[4], r[5], r[6], r[7]};
                        }
                    }
            }
        }
    }
};

template <bool ADD> struct EpiBranch {
    static constexpr bool PERM = true;
    const bf16* mg; bf16* out; int goff;
    __device__ __forceinline__ void operator()(AccRef acc, const Unit& u, int wr, int wc, int fr, int fq) const {
        const int row0 = u.pm * 256 + wr * 64 + fr, col0 = u.pn * 256 + wc * 32 + 8 * fq;
#pragma unroll
        for (int ai = 0; ai < 2; ++ai)
#pragma unroll
            for (int m = 0; m < 4; ++m) {
                const int row = row0 + ai * 128 + m * 16;
#pragma unroll
                for (int bj = 0; bj < 2; ++bj) {
                    const int c = col0 + bj * 128;
                    const v4u g = *(const v4u*)(mg + (size_t)row * 2048 + goff + c);
                    const f32x4 a = acc[ai][bj][m][0], bq = acc[ai][bj][m][1];
                    float r[8] = {bflo(g.x) * a[0], bfhi(g.x) * a[1], bflo(g.y) * a[2], bfhi(g.y) * a[3], bflo(g.z) * bq[0], bfhi(g.z) * bq[1], bflo(g.w) * bq[2], bfhi(g.w) * bq[3]};
                    if (ADD) { const v4u p = *(const v4u*)(out + (size_t)row * DM + c);
                        r[0] += bflo(p.x); r[1] += bfhi(p.x); r[2] += bflo(p.y); r[3] += bfhi(p.y); r[4] += bflo(p.z); r[5] += bfhi(p.z); r[6] += bflo(p.w); r[7] += bfhi(p.w); }
                    v4u w; w.x = cvt_pk_bf16(r[0], r[1]); w.y = cvt_pk_bf16(r[2], r[3]); w.z = cvt_pk_bf16(r[4], r[5]); w.w = cvt_pk_bf16(r[6], r[7]);
                    *(v4u*)(out + (size_t)row * DM + c) = w;
                }
            }
    }
};

struct EpiResF32 {
    static constexpr bool PERM = false;
    const float* xres; float* pre;
    __device__ __forceinline__ void operator()(AccRef acc, const Unit& u, int wr, int wc, int fr, int fq) const {
        const int row0 = u.pm * 256 + wr * 64 + fr, col0 = u.pn * 256 + wc * 32 + 4 * fq;
#pragma unroll
        for (int ai = 0; ai < 2; ++ai)
#pragma unroll
            for (int m = 0; m < 4; ++m) {
                const size_t off = (size_t)(row0 + ai * 128 + m * 16) * DM + col0;
#pragma unroll
                for (int bj = 0; bj < 2; ++bj)
#pragma unroll
                    for (int n = 0; n < 2; ++n) { const f32x4 x = *(const f32x4*)(xres + off + bj * 128 + n * 16); *(f32x4*)(pre + off + bj * 128 + n * 16) = x * DN_ALPHA + acc[ai][bj][m][n]; }
            }
    }
};

struct EpiSwiGLU {
    static constexpr bool PERM = true;
    bf16* hid; int ldh;
    __device__ __forceinline__ void operator()(AccRef acc, const Unit& u, int wr, int wc, int fr, int fq) const {
        const int row0 = u.pm * 256 + wr * 64 + fr, col0 = u.pn * 128 + wc * 32 + 8 * fq;
#pragma unroll
        for (int ai = 0; ai < 2; ++ai)
#pragma unroll
            for (int m = 0; m < 4; ++m) {
                float r[8];
#pragma unroll
                for (int n = 0; n < 2; ++n)
#pragma unroll
                    for (int i = 0; i < 4; ++i) { const float g = acc[ai][0][m][n][i], up = acc[ai][1][m][n][i]; r[n * 4 + i] = g * sigmoidf_(g) * up; }
                v4u w; w.x = cvt_pk_bf16(r[0], r[1]); w.y = cvt_pk_bf16(r[2], r[3]); w.z = cvt_pk_bf16(r[4], r[5]); w.w = cvt_pk_bf16(r[6], r[7]);
                *(v4u*)(hid + (size_t)(row0 + ai * 128 + m * 16) * ldh + col0) = w;
            }
    }
};

struct EpiPlainBf16 {
    static constexpr bool PERM = true;
    bf16* out;
    __device__ __forceinline__ void operator()(AccRef acc, const Unit& u, int wr, int wc, int fr, int fq) const {
        const int row0 = u.pm * 256 + wr * 64 + fr, col0 = u.pn * 256 + wc * 32 + 8 * fq;
#pragma unroll
        for (int ai = 0; ai < 2; ++ai)
#pragma unroll
            for (int m = 0; m < 4; ++m)
#pragma unroll
                for (int bj = 0; bj < 2; ++bj) {
                    const f32x4 a = acc[ai][bj][m][0], bq = acc[ai][bj][m][1];
                    v4u w; w.x = cvt_pk_bf16(a[0], a[1]); w.y = cvt_pk_bf16(a[2], a[3]); w.z = cvt_pk_bf16(bq[0], bq[1]); w.w = cvt_pk_bf16(bq[2], bq[3]);
                    *(v4u*)(out + (size_t)(row0 + ai * 128 + m * 16) * DM + col0 + bj * 128) = w;
                }
    }
};

struct Args { const float* in[21]; float* out; unsigned char* ws; int ph_lo, ph_hi; };
struct Frame { LAS unsigned char* lds; int vcu, G, wave; };
__device__ __forceinline__ int lane_id() { int l; asm volatile("v_mbcnt_lo_u32_b32 %0, -1, 0\n\tv_mbcnt_hi_u32_b32 %0, -1, %0" : "=v"(l)); return l; }
typedef __attribute__((address_space(4))) const Args CArgs;
__device__ __forceinline__ const CArgs* kargs() { const CArgs* p = (const CArgs*)__builtin_amdgcn_kernarg_segment_ptr(); asm volatile("" : "+s"(p)); return p; }
#define PHASE_IDS() int wave = F.wave; asm volatile("" : "+s"(wave)); int lane = lane_id(); asm volatile("" : "+v"(lane)); const int tid = wave * 64 + lane; (void)tid
enum { I_X = 0, I_WIN, I_PE, I_W1, I_W2, I_FB, I_WNSA, I_WFOX, I_WOUT, I_REL, I_LN1G, I_LN1B, I_LN2G, I_LN2B, I_DG, I_DU, I_DD, I_ROUT, I_MG, I_MU, I_MD };

struct SegDesc { const float* W; bf16* dst; int ldw, ncols, K, mode, roff; };
__device__ __forceinline__ SegDesc seg_desc(int s, const CArgs* a) {
    SegDesc d; unsigned char* ws = a->ws;
    if (s < 44) {
        const int L = s / 11, q = s % 11;
        if (q < 6) {
            const int sc[6] = {SC_Q, SC_KV, SC_FOX, SC_MG, SC_NG, SC_FF}, nc[6] = {512, 768, 1536, 2048, 24, 8}, ro[6] = {PC_Q, PC_KV, PC_FOX, PC_MG, PC_MISC, PC_MISC + 24};
            int scq = sc[0], ncq = nc[0], roq = ro[0];
#pragma unroll
            for (int i = 1; i < 6; ++i) if (q == i) { scq = sc[i]; ncq = nc[i]; roq = ro[i]; }
            d.W = a->in[I_WIN] + (size_t)L * DM * D_IN + scq; d.ldw = D_IN; d.ncols = ncq; d.K = DM; d.dst = (bf16*)(ws + WS_WIN) + (size_t)L * NPROJ * DM; d.mode = 0; d.roff = roq;
        } else if (q == 6) { d.W = a->in[I_WNSA] + (size_t)L * 512 * DM; d.ldw = DM; d.ncols = DM; d.K = 512; d.dst = (bf16*)(ws + WS_WNSA) + (size_t)L * DM * 512; d.mode = 0; d.roff = 0; }
        else if (q == 7) { d.W = a->in[I_WFOX] + (size_t)L * 512 * DM; d.ldw = DM; d.ncols = DM; d.K = 512; d.dst = (bf16*)(ws + WS_WFOX) + (size_t)L * DM * 512; d.mode = 0; d.roff = 0; }
        else if (q == 8) { d.W = a->in[I_WOUT] + (size_t)L * DM * DM; d.ldw = DM; d.ncols = DM; d.K = DM; d.dst = (bf16*)(ws + WS_WO) + (size_t)L * DM * DM; d.mode = 0; d.roff = 0; }
        else { const int kv = q - 9; d.W = a->in[I_W1] + (size_t)(L * 2 + kv) * 2048 * 128; d.ldw = 128; d.ncols = 128; d.K = 2048; d.dst = (bf16*)(ws + WS_WC1) + (size_t)(L * 2 + kv) * 128 * 2048; d.mode = 0; d.roff = 0; }
    } else if (s < 50) {
        const int j = (s - 44) / 3, q = (s - 44) % 3;
        if (q < 2) { d.W = a->in[q == 0 ? I_DG : I_DU] + (size_t)j * DM * FF_D; d.ldw = FF_D; d.ncols = FF_D; d.K = DM; d.dst = (bf16*)(ws + WS_WDGU) + (size_t)j * 2 * FF_D * DM; d.mode = 1; d.roff = q * 128; }
        else { d.W = a->in[I_DD] + (size_t)j * FF_D * DM; d.ldw = DM; d.ncols = DM; d.K = FF_D; d.dst = (bf16*)(ws + WS_WDD) + (size_t)j * DM * FF_D; d.mode = 0; d.roff = 0; }
    } else {
        const int je = (s - 50) / 3, q = (s - 50) % 3;
        if (q < 2) { d.W = a->in[q == 0 ? I_MG : I_MU] + (size_t)je * DM * FF_E; d.ldw = FF_E; d.ncols = FF_E; d.K = DM; d.dst = (bf16*)(ws + WS_WMGU) + (size_t)je * 2 * FF_E * DM; d.mode = 1; d.roff = q * 128; }
        else { d.W = a->in[I_MD] + (size_t)je * FF_E * DM; d.ldw = DM; d.ncols = DM; d.K = FF_E; d.dst = (bf16*)(ws + WS_WMD) + (size_t)je * DM * FF_E; d.mode = 0; d.roff = 0; }
    }
    return d;
}
constexpr int NSEG = 98;

__device__ __forceinline__ void p0_prologue(const Frame& F) {
    PHASE_IDS(); const CArgs* a = kargs();
    LAS unsigned char* scr = F.lds + wave * 9216;
    const int gw = F.vcu * NWAVES + wave, NGW = F.G * NWAVES;
    typedef short v4i16_t __attribute__((ext_vector_type(4)));
    const int kr = lane >> 4, nq = lane & 15, grp = lane >> 4, q4 = (lane & 15) >> 2, p4 = lane & 3;
    int base = 0;
    for (int s = 0; s < NSEG; ++s) {
        const SegDesc d = seg_desc(s, a);
        const int nblk = (d.ncols + 63) >> 6, n_items = (d.K >> 6) * nblk;
        int start = gw - (base % NGW); if (start < 0) start += NGW;
        for (int it = start; it < n_items; it += NGW) {
            const int kb = it / nblk, nb = it % nblk, k0 = 64 * kb, n0 = 64 * nb;
            const bool okn = n0 + 4 * nq < d.ncols;
            const float* src = d.W + (size_t)(k0 + kr) * d.ldw + n0 + 4 * nq;
            f32x4 v[16];
#pragma unroll
            for (int i = 0; i < 16; ++i) v[i] = okn ? *(const GAS f32x4*)(src + (size_t)(4 * i) * d.ldw) : (f32x4){0.f, 0.f, 0.f, 0.f};
#pragma unroll
            for (int i = 0; i < 16; ++i) { v2u w; w.x = pk2(v[i][0], v[i][1]); w.y = pk2(v[i][2], v[i][3]); *(LAS v2u*)(scr + (4 * i + kr) * 144 + 8 * nq) = w; }
            LDS_WAIT(); asm volatile("" ::: "memory");
            const int rbase = d.mode ? (d.roff + ((n0 >> 7) << 8) + (n0 & 127)) : (d.roff + n0);
#pragma unroll
            for (int nb4 = 0; nb4 < 4; ++nb4)
#pragma unroll
                for (int h = 0; h < 2; ++h) {
                    const int kc = 4 * h + grp;
                    const LAS unsigned char* rp = scr + (8 * kc + q4) * 144 + (16 * nb4 + 4 * p4) * 2;
                    const v4i16_t lo = __builtin_amdgcn_ds_read_tr16_b64_v4i16((LAS v4i16_t*)rp), hi4 = __builtin_amdgcn_ds_read_tr16_b64_v4i16((LAS v4i16_t*)(rp + 4 * 144));
                    v2u a2 = __builtin_bit_cast(v2u, lo), b2 = __builtin_bit_cast(v2u, hi4); asm volatile("" : "+v"(a2), "+v"(b2));
                    const int n = 16 * nb4 + (lane & 15);
                    if (n0 + n < d.ncols) *(GAS v4u*)(d.dst + (size_t)(rbase + n) * d.K + k0 + 8 * kc) = (v4u){a2.x, a2.y, b2.x, b2.y};
                }
            LDS_WAIT(); asm volatile("" ::: "memory");
        }
        base += n_items;
    }
    {
        constexpr int PADROWS = NPROJ - (PC_MISC + 32), V16_PER_L = PADROWS * DM * 2 / 16;
        const int gt = gw * 64 + lane, NGT = NGW * 64;
        for (int i = gt; i < DEPTH * V16_PER_L; i += NGT) { const int L = i / V16_PER_L, r = i % V16_PER_L;
            *((GAS v4u*)((bf16*)(a->ws + WS_WIN) + ((size_t)L * NPROJ + PC_MISC + 32) * DM) + r) = (v4u){0u, 0u, 0u, 0u}; }
        const float* x = a->in[I_X]; bf16* xb = (bf16*)(a->ws + WS_XB);
        for (int i = gt; i < M * DM / 8; i += NGT) { const f32x4 p = *((const GAS f32x4*)x + 2 * (size_t)i), q = *((const GAS f32x4*)x + 2 * (size_t)i + 1);
            v4u o; o.x = pk2(p[0], p[1]); o.y = pk2(p[2], p[3]); o.z = pk2(q[0], q[1]); o.w = pk2(q[2], q[3]); *((GAS v4u*)xb + i) = o; }
    }
    if (gw < 256) {
        const int lk = gw >> 5, sl = gw & 31;
        const float* pe = a->in[I_PE] + (size_t)lk * 2048 + sl * 64; const float* w1 = a->in[I_W1] + ((size_t)lk * 2048 + sl * 64) * 128;
        float a0 = 0.f, a1 = 0.f;
        for (int k = 0; k < 64; ++k) { const float p = pe[k]; a0 += p * w1[k * 128 + lane]; a1 += p * w1[k * 128 + 64 + lane]; }
        float* cbp = (float*)(a->ws + WS_CBP) + (size_t)gw * 128; cbp[lane] = a0; cbp[64 + lane] = a1;
    }
}

__device__ __forceinline__ float gelu_tanh(float x) { const float u = 0.7978845608028654f * (x + 0.044715f * x * x * x); return 0.5f * x * (1.f + tanhf(u)); }

__device__ __forceinline__ void p2_cmp_scan(const Frame& F, int L) {
    PHASE_IDS(); const CArgs* a = kargs(); unsigned char* ws = a->ws;
    typedef float f32x2_t __attribute__((ext_vector_type(2)));
    constexpr int A_OFF = 0, P_OFF = 36864, H_OFF = P_OFF + 65536, CB_OFF = H_OFF + 8192;
    for (int u = F.vcu; u < 256; u += F.G) {
        const int kv = u >> 7, bh = (u >> 3) & 15, rg = u & 7, i0 = 16 * rg;
        const bf16* src = (const bf16*)(ws + WS_KV6) + (size_t)kv * ((size_t)M * 128) + ((size_t)bh * SEQ + 16 * i0) * 64;
        for (int i = tid; i < 2176; i += 512) { const int tok = i >> 3, c = i & 7; *(LAS v4u*)(F.lds + A_OFF + tok * 128 + (tok >> 4) * 16 + c * 16) = *((const GAS v4u*)src + i); }
        if (tid < 128) { const float* cbp = (const float*)(ws + WS_CBP) + (size_t)(L * 2 + kv) * 32 * 128 + tid; float cb = 0.f;
            for (int s = 0; s < 32; ++s) cb += cbp[s * 128];
            ((LAS float*)(F.lds + CB_OFF))[tid] = cb; }
        __syncthreads();
        {
            const int row = lane & 15, kg = lane >> 4;
            const bf16* W = (const bf16*)(ws + WS_WC1) + ((size_t)(L * 2 + kv) * 128 + row) * 2048 + 256 * wave + 8 * kg;
            f32x4 acc[8];
#pragma unroll
            for (int nb = 0; nb < 8; ++nb) acc[nb] = (f32x4){0.f, 0.f, 0.f, 0.f};
#pragma unroll
            for (int ks = 0; ks < 8; ++ks) {
                const int k = 256 * wave + 32 * ks + 8 * kg, tok = 16 * row + (k >> 6);
                const bf16x8 af = *(const LAS bf16x8*)(F.lds + A_OFF + tok * 128 + (tok >> 4) * 16 + (k & 63) * 2);
#pragma unroll
                for (int nb = 0; nb < 8; ++nb) { const bf16x8 bfr = *(const GAS bf16x8*)(W + (size_t)nb * 16 * 2048 + ks * 32);
                    acc[nb] = __builtin_amdgcn_mfma_f32_16x16x32_bf16(af, bfr, acc[nb], 0, 0, 0); }
            }
            LAS float* part = (LAS float*)(F.lds + P_OFF) + wave * 2048;
#pragma unroll
            for (int nb = 0; nb < 8; ++nb)
#pragma unroll
                for (int r = 0; r < 4; ++r) part[(4 * kg + r) * 128 + 16 * nb + row] = acc[nb][r];
        }
        __syncthreads();
        {
            const int e = tid * 4; const LAS float* part = (const LAS float*)(F.lds + P_OFF) + e;
            f32x4 s = *(const LAS f32x4*)(F.lds + CB_OFF + (e & 127) * 4);
#pragma unroll
            for (int w = 0; w < 8; ++w) s += *(const LAS f32x4*)(part + w * 2048);
            *(LAS f32x4*)(F.lds + H_OFF + e * 4) = (f32x4){gelu_tanh(s[0]), gelu_tanh(s[1]), gelu_tanh(s[2]), gelu_tanh(s[3])};
        }
        __syncthreads();
        {
            const int i = tid >> 5, d = (tid & 31) * 2;
            const float* w2 = a->in[I_W2] + (size_t)(L * 2 + kv) * 128 * 64 + d; const LAS float* Hr = (const LAS float*)(F.lds + H_OFF) + i * 128;
            float o0 = 0.f, o1 = 0.f;
#pragma unroll 8
            for (int n = 0; n < 128; ++n) { const f32x2_t wv = *(const GAS f32x2_t*)(w2 + n * 64); const float hv = Hr[n]; o0 += hv * wv[0]; o1 += hv * wv[1]; }
            const bool ok = (i0 + i) < N_CMP;
            *(GAS unsigned*)((bf16*)(ws + (kv ? WS_VCC : WS_KCC)) + ((size_t)bh * 128 + i0 + i) * 64 + d) = ok ? pk2(o0, o1) : 0u;
        }
        __syncthreads();
    }
    const int gw = F.vcu * NWAVES + wave;
    if (gw < BATCH * FOX_H) {
        const int b = gw >> 3, h = gw & 7;
        const float* lf = (const float*)(ws + WS_LF) + ((size_t)b * SEQ + 32 * lane) * 8 + h;
        float loc = 0.f;
        for (int i = 0; i < 32; ++i) loc += lf[i * 8];
        float inc = loc;
#pragma unroll
        for (int o = 1; o < 64; o <<= 1) { const float t = __shfl_up(inc, o); if (lane >= o) inc += t; }
        float run = inc - loc;
        float* out = (float*)(ws + WS_NF2) + (size_t)gw * SEQ + 32 * lane;
        for (int i = 0; i < 32; ++i) { run += lf[i * 8]; out[i] = -run * LOG2E; }
    }
}

__device__ __forceinline__ void load_q64(const bf16* q, float (&qf)[64]) {
#pragma unroll
    for (int i = 0; i < 8; ++i) { const v4u v = *(const GAS v4u*)(q + 8 * i);
        qf[8 * i + 0] = bflo(v.x); qf[8 * i + 1] = bfhi(v.x); qf[8 * i + 2] = bflo(v.y); qf[8 * i + 3] = bfhi(v.y); qf[8 * i + 4] = bflo(v.z); qf[8 * i + 5] = bfhi(v.z); qf[8 * i + 6] = bflo(v.w); qf[8 * i + 7] = bfhi(v.w); }
}
__device__ __forceinline__ float dot64(const float (&qf)[64], const bf16* k) {
    float acc = 0.f;
#pragma unroll
    for (int i = 0; i < 8; ++i) { const v4u v = *(const GAS v4u*)(k + 8 * i);
        acc += qf[8 * i + 0] * bflo(v.x) + qf[8 * i + 1] * bfhi(v.x) + qf[8 * i + 2] * bflo(v.y) + qf[8 * i + 3] * bfhi(v.y) + qf[8 * i + 4] * bflo(v.z) + qf[8 * i + 5] * bfhi(v.z) + qf[8 * i + 6] * bflo(v.w) + qf[8 * i + 7] * bfhi(v.w); }
    return acc;
}
__device__ __forceinline__ void softmax_lds(LAS float* sc, int n, int lane, float mxl) {
    const float mx = wave_max(mxl);
    float l = 0.f;
    for (int i = lane; i < n; i += 64) { const float s = sc[i]; const float p = (s > -1e29f) ? exp2f(s - mx) : 0.f; sc[i] = p; l += p; }
    l = wave_sum(l);
    const float inv = 1.f / fmaxf(l, 1e-30f);
    for (int i = lane; i < n; i += 64) sc[i] *= inv;
}

__device__ __forceinline__ void p3_fox_naive(const Frame& F) {
    PHASE_IDS(); const CArgs* a = kargs(); unsigned char* ws = a->ws;
    LAS float* sc = (LAS float*)F.lds + wave * 2048;
    const int gw = F.vcu * NWAVES + wave, NGW = F.G * NWAVES;
    const bf16* FQ = (const bf16*)(ws + WS_FQKV); const bf16* FK = FQ + (size_t)M * 512; const bf16* FV = FK + (size_t)M * 512;
    for (int it = gw; it < BATCH * FOX_H * SEQ; it += NGW) {
        const int bh = it >> 11, t = it & 2047;
        float qf[64]; load_q64(FQ + ((size_t)bh * SEQ + t) * 64, qf);
        const float* nf = (const float*)(ws + WS_NF2) + (size_t)bh * SEQ; const float nft = nf[t];
        const bf16* kb = FK + (size_t)bh * SEQ * 64; const bf16* vb = FV + (size_t)bh * SEQ * 64;
        float mx = -1e30f;
        for (int s = lane; s <= t; s += 64) { const float v = dot64(qf, kb + (size_t)s * 64) + (nf[s] - nft); sc[s] = v; mx = fmaxf(mx, v); }
        softmax_lds(sc, t + 1, lane, mx);
        float o = 0.f;
        for (int s = 0; s <= t; ++s) o += sc[s] * bf2f(vb[(size_t)s * 64 + lane]);
        const int b = bh >> 3, h = bh & 7;
        ((bf16*)(ws + WS_YF))[((size_t)b * SEQ + t) * 512 + h * 64 + lane] = (bf16)f2bf(o);
    }
}

__device__ __forceinline__ void p3_nsa_naive(const Frame& F) {
    PHASE_IDS(); const CArgs* a = kargs(); unsigned char* ws = a->ws;
    const int half = wave >> 2, g = wave & 3;
    LAS float* sc = (LAS float*)F.lds + wave * 1024;
    LAS float* pc = (LAS float*)(F.lds + 32768) + half * 512;
    const bf16* QN = (const bf16*)(ws + WS_QN); const bf16* KV6 = (const bf16*)(ws + WS_KV6);
    const float* rel = a->in[I_REL];
    for (int it = blockIdx.x * 2 + half; it < BATCH * NSA_KVH * SEQ; it += 2 * F.G) {
        const int bk = it >> 11, t = it & 2047, b = bk >> 1, kvh = bk & 1, h = kvh * 4 + g, cur = t >> 6;
        float qf[64]; load_q64(QN + ((size_t)(b * 8 + h) * SEQ + t) * 64, qf);
        const float* ng = (const float*)(ws + WS_NG) + ((size_t)b * SEQ + t) * 24 + h * 3;
        const float g0 = ng[0], g1 = ng[1], g2 = ng[2];
        const bf16* kc = (const bf16*)(ws + WS_KCC) + (size_t)bk * 128 * 64; const bf16* vc = (const bf16*)(ws + WS_VCC) + (size_t)bk * 128 * 64;
        float mx = -1e30f;
        for (int c = lane; c < 128; c += 64) { const int ce = 16 * c + 31; float v = -1e30f;
            if (c < N_CMP && ce <= t) v = dot64(qf, kc + (size_t)c * 64) + rel[t5b(t - ce) * 8 + h] * LOG2E;
            sc[c] = v; mx = fmaxf(mx, v); }
        softmax_lds(sc, 128, lane, mx);
        float oc = 0.f;
        for (int c = 0; c < 128; ++c) oc += sc[c] * bf2f(vc[(size_t)c * 64 + lane]);
        pc[g * 128 + lane] = sc[lane]; pc[g * 128 + 64 + lane] = sc[64 + lane];
        __syncthreads();
        unsigned selmask;
        {
            float imp = -1.f;
            if (lane < 32) {
                const int j = lane;
                float P[5];
#pragma unroll
                for (int q = 0; q < 5; ++q) { const int c = 4 * j - 1 + q; P[q] = (c >= 0 && c < 128) ? ((pc[c] + pc[128 + c]) + (pc[256 + c] + pc[384 + c])) : 0.f; }
                const float v = P[1] + P[2] + P[3] + 0.5f * P[4] + 0.5f * P[0];
                const bool forced = (j == 0) || (j <= cur && j > cur - 2);
                imp = forced ? 1e4f : (j <= cur ? v : -1.f);
            }
            int rank = 0;
            for (int jj = 0; jj < 32; ++jj) { const float o = __shfl(imp, jj); rank += (o > imp || (o == imp && jj < lane)) ? 1 : 0; }
            selmask = (unsigned)(__ballot(lane < 32 && rank < 16) & 0xffffffffull);
        }
        __syncthreads();
        const bf16* ks = KV6 + (size_t)2 * M * 128 + (size_t)bk * SEQ * 64; const bf16* vs = KV6 + (size_t)3 * M * 128 + (size_t)bk * SEQ * 64;
        int nsel = 0; mx = -1e30f;
        for (int j = 0; j <= cur; ++j) if ((selmask >> j) & 1u) { const int pos = 64 * j + lane; float v = -1e30f;
            if (pos <= t) v = dot64(qf, ks + (size_t)pos * 64) + rel[t5b(t - pos) * 8 + h] * LOG2E;
            sc[nsel * 64 + lane] = v; mx = fmaxf(mx, v); ++nsel; }
        softmax_lds(sc, nsel * 64, lane, mx);
        float os = 0.f; { int q = 0;
            for (int j = 0; j <= cur; ++j) if ((selmask >> j) & 1u) { for (int i = 0; i < 64; ++i) os += sc[q * 64 + i] * bf2f(vs[(size_t)(64 * j + i) * 64 + lane]); ++q; } }
        const bf16* kw = KV6 + (size_t)4 * M * 128 + (size_t)bk * SEQ * 64; const bf16* vw = KV6 + (size_t)5 * M * 128 + (size_t)bk * SEQ * 64;
        const int lo = t - 511 > 0 ? t - 511 : 0, nw = t - lo + 1;
        mx = -1e30f;
        for (int i = lane; i < nw; i += 64) { const int pos = lo + i; const float v = dot64(qf, kw + (size_t)pos * 64) + rel[t5b(t - pos) * 8 + h] * LOG2E; sc[i] = v; mx = fmaxf(mx, v); }
        softmax_lds(sc, nw, lane, mx);
        float ow = 0.f;
        for (int i = 0; i < nw; ++i) ow += sc[i] * bf2f(vw[(size_t)(lo + i) * 64 + lane]);
        ((bf16*)(ws + WS_YN))[((size_t)b * SEQ + t) * 512 + h * 64 + lane] = (bf16)f2bf(g0 * oc + g1 * os + g2 * ow);
    }
}

template <int MODE, bool ROUTE, int LNG, int LNB>
__device__ __forceinline__ void ln_phase(const Frame& F, int L, int j) {
    PHASE_IDS(); const CArgs* a = kargs(); unsigned char* ws = a->ws; unsigned* ctl = (unsigned*)(ws + WS_CTL);
    const float* gam = a->in[LNG] + L * DM; const float* bet = a->in[LNB] + L * DM;
    const int gw = F.vcu * NWAVES + wave, NGW = F.G * NWAVES;
    LAS int* lcnt = (LAS int*)F.lds;
    LAS int* lrow = (LAS int*)(F.lds + 256);
    if (ROUTE) { if (tid < 16) lcnt[tid] = 0; __syncthreads(); }
    const float* pre = (const float*)(ws + WS_PRE); float* X = a->out; bf16* XB = (bf16*)(ws + WS_XB);
    f32x4 gv[4], bv[4];
#pragma unroll
    for (int q = 0; q < 4; ++q) { gv[q] = *((const GAS f32x4*)gam + lane + 64 * q); bv[q] = *((const GAS f32x4*)bet + lane + 64 * q); }
    int ri = 0;
    for (int m = gw; m < M; m += NGW, ++ri) {
        f32x4 v[4];
        if (MODE == 0) {
#pragma unroll
            for (int q = 0; q < 4; ++q) v[q] = *((const GAS f32x4*)(pre + (size_t)m * DM) + lane + 64 * q);
        } else {
            const int* ts = (const int*)(ws + WS_TOKS) + 2 * m; const float* tw = (const float*)(ws + WS_TOKW) + 2 * m;
            const int s0 = ts[0], s1 = ts[1]; const float w0 = tw[0], w1 = tw[1];
            const bf16* ys = (const bf16*)(ws + WS_XG);
#pragma unroll
            for (int q = 0; q < 4; ++q) {
                const f32x4 x = *((const GAS f32x4*)(X + (size_t)m * DM) + lane + 64 * q);
                const v2u y0 = *((const GAS v2u*)(ys + (size_t)s0 * DM) + lane + 64 * q), y1 = *((const GAS v2u*)(ys + (size_t)s1 * DM) + lane + 64 * q);
                v[q] = x * DN_ALPHA + (f32x4){bflo(y0.x), bfhi(y0.x), bflo(y0.y), bfhi(y0.y)} * w0 + (f32x4){bflo(y1.x), bfhi(y1.x), bflo(y1.y), bfhi(y1.y)} * w1;
            }
        }
        float s = 0.f;
#pragma unroll
        for (int q = 0; q < 4; ++q) s += (v[q][0] + v[q][1]) + (v[q][2] + v[q][3]);
        const float mean = wave_sum(s) * (1.f / DM); float s2 = 0.f;
#pragma unroll
        for (int q = 0; q < 4; ++q) { v[q] = v[q] - mean; s2 += (v[q][0] * v[q][0] + v[q][1] * v[q][1]) + (v[q][2] * v[q][2] + v[q][3] * v[q][3]); }
        const float rstd = 1.f / sqrtf(wave_sum(s2) * (1.f / DM) + LN_EPS);
#pragma unroll
        for (int q = 0; q < 4; ++q) { v[q] = v[q] * rstd * gv[q] + bv[q];
            *((GAS f32x4*)(X + (size_t)m * DM) + lane + 64 * q) = v[q];
            v2u o; o.x = pk2(v[q][0], v[q][1]); o.y = pk2(v[q][2], v[q][3]); *((GAS v2u*)(XB + (size_t)m * DM) + lane + 64 * q) = o; }
        if (ROUTE) {
            const float* R = a->in[I_ROUT] + (size_t)j * DM * NEXP;
            float lg[8];
#pragma unroll
            for (int e = 0; e < 8; ++e) lg[e] = 0.f;
#pragma unroll
            for (int q = 0; q < 4; ++q)
#pragma unroll
                for (int c = 0; c < 4; ++c) { const float xv = v[q][c]; const float* rr = R + (size_t)(4 * lane + 256 * q + c) * 8; const f32x4 r0 = *(const GAS f32x4*)rr, r1 = *(const GAS f32x4*)(rr + 4);
                    lg[0] += xv * r0[0]; lg[1] += xv * r0[1]; lg[2] += xv * r0[2]; lg[3] += xv * r0[3]; lg[4] += xv * r1[0]; lg[5] += xv * r1[1]; lg[6] += xv * r1[2]; lg[7] += xv * r1[3]; }
#pragma unroll
            for (int e = 0; e < 8; ++e) lg[e] = wave_sum(lg[e]);
            int e0 = 0; float l0 = lg[0];
#pragma unroll
            for (int e = 1; e < 8; ++e) if (lg[e] > l0) { l0 = lg[e]; e0 = e; }
            int e1 = -1; float l1 = -3.0e38f;
#pragma unroll
            for (int e = 0; e < 8; ++e) if (e != e0 && lg[e] > l1) { l1 = lg[e]; e1 = e; }
            const float w0 = 1.f / (1.f + __expf(l1 - l0));
            if (lane == 0) {
                int* te = (int*)(ws + WS_TOKE) + 2 * m; float* tw = (float*)(ws + WS_TOKW) + 2 * m;
                te[0] = e0; te[1] = e1; tw[0] = w0; tw[1] = 1.f - w0;
                const int p0 = __hip_atomic_fetch_add(&lcnt[e0], 1, __ATOMIC_RELAXED, __HIP_MEMORY_SCOPE_WORKGROUP), p1 = __hip_atomic_fetch_add(&lcnt[e1], 1, __ATOMIC_RELAXED, __HIP_MEMORY_SCOPE_WORKGROUP);
                LAS int* lr = lrow + (wave * 16 + ri) * 4; lr[0] = e0; lr[1] = e1; lr[2] = p0; lr[3] = p1;
            }
        }
    }
    if (ROUTE) {
        __syncthreads();
        if (tid < 8) lcnt[8 + tid] = (int)atomicAdd(ctl + CW_MOECNT + j * 64 + tid, (unsigned)lcnt[tid]);
        __syncthreads();
        ri = 0;
        for (int m = gw; m < M; m += NGW, ++ri) if (lane < 2) { LAS int* lr = lrow + (wave * 16 + ri) * 4; ((int*)(ws + WS_TOKP))[2 * m + lane] = lr[2 + lane] + lcnt[8 + lr[lane]]; }
    }
}

struct MoeTiles { int toff[9]; };
__device__ __forceinline__ void moe_tiles(unsigned* ctl, int j, int (&toff)[9]) {
    toff[0] = 0;
#pragma unroll
    for (int e = 0; e < 8; ++e) { const unsigned c = __hip_atomic_load(ctl + CW_MOECNT + j * 64 + e, __ATOMIC_RELAXED, __HIP_MEMORY_SCOPE_AGENT); toff[e + 1] = toff[e] + (int)((c + 255u) >> 8); }
}
__device__ __forceinline__ void moe_gather(const Frame& F, int j) {
    PHASE_IDS(); const CArgs* a = kargs(); unsigned char* ws = a->ws;
    int toff[9]; moe_tiles((unsigned*)(ws + WS_CTL), j, toff);
    const int gw = F.vcu * NWAVES + wave, NGW = F.G * NWAVES;
    const bf16* XB = (const bf16*)(ws + WS_XB); bf16* XG = (bf16*)(ws + WS_XG);
    for (int it = gw; it < 2 * M; it += NGW) {
        const int e = ((const int*)(ws + WS_TOKE))[it], p = ((const int*)(ws + WS_TOKP))[it];
        int tb = toff[0];
#pragma unroll
        for (int q = 1; q < 8; ++q) tb = (e == q) ? toff[q] : tb;
        const int slot = tb * 256 + p;
        if (lane == 0) ((int*)(ws + WS_TOKS))[it] = slot;
        const GAS v4u* src = (const GAS v4u*)(XB + (size_t)(it >> 1) * DM); GAS v4u* dst = (GAS v4u*)(XG + (size_t)slot * DM);
        dst[lane] = src[lane]; dst[64 + lane] = src[64 + lane];
    }
}

namespace att {
constexpr int KSTR = 1152, KT_BYTES = 8 * KSTR, VT_BYTES = 8192;
constexpr int NSLOT = 3;
constexpr int L_K = 0, L_V = NSLOT * KT_BYTES, L_F = L_V + NSLOT * VT_BYTES, L_WSF = L_F + 8192, L_LUT = L_WSF + 8 * 256, L_SEL = L_LUT + 5120, L_ACC = L_SEL + 256, L_OST = L_ACC, L_IMP = L_ACC + 32768, L_END = L_ACC + 65536;
static_assert(L_END <= ATT_LDS_LIMIT, "attention LDS map");
constexpr float MASKV = -3.0e30f, MINIT = -1.0e30f;
typedef short v4i16_t __attribute__((ext_vector_type(4)));
typedef short s16x4 __attribute__((ext_vector_type(4)));
__device__ __forceinline__ int crow(int r, int hi) { return (r & 3) + 8 * (r >> 2) + 4 * hi; }
__device__ __forceinline__ float swap_max(float m) { auto rr = __builtin_amdgcn_permlane32_swap(__float_as_uint(m), __float_as_uint(m), false, false); return fmaxf(__uint_as_float(rr[0]), __uint_as_float(rr[1])); }
__device__ __forceinline__ float swap_sum(float m) { auto rr = __builtin_amdgcn_permlane32_swap(__float_as_uint(m), __float_as_uint(m), false, false); return __uint_as_float(rr[0]) + __uint_as_float(rr[1]); }
__device__ __forceinline__ float swap_other(float m) { return __shfl_xor(m, 32); }
__device__ __forceinline__ unsigned cvtpk(float lo, float hi) { unsigned r; asm volatile("v_cvt_pk_bf16_f32 %0, %1, %2" : "=v"(r) : "v"(lo), "v"(hi)); return r; }

struct TileRegs { v4u k, v; f32x4 f; };
__device__ __forceinline__ void tile_issue(TileRegs& R, const bf16* kt, const bf16* vt, int tid) {
    R.k = *((const GAS v4u*)kt + tid); R.v = *((const GAS v4u*)vt + tid);
}
__device__ __forceinline__ void tile_store(const TileRegs& R, LAS unsigned char* lds, int buf, int tid) {
    const int row = tid >> 3, c = tid & 7;
    *(LAS v4u*)(lds + L_K + buf * KT_BYTES + c * KSTR + row * 16) = R.k;
    *(LAS v4u*)(lds + L_V + buf * VT_BYTES + (c >> 2) * 4096 + row * 64 + (c & 3) * 16) = R.v;
}
__device__ __forceinline__ void qkt(f32x16& p0, f32x16& p1, const LAS unsigned char* kb, const bf16x8 (&qr)[4], int r32, int hi) {
    p0 = (f32x16){}; p1 = (f32x16){};
#pragma unroll
    for (int d0 = 0; d0 < 4; ++d0) {
        const bf16x8 b0 = *(const LAS bf16x8*)(kb + (2 * d0 + hi) * KSTR + r32 * 16);
        const bf16x8 b1 = *(const LAS bf16x8*)(kb + (2 * d0 + hi) * KSTR + r32 * 16 + 512);
        p0 = __builtin_amdgcn_mfma_f32_32x32x16_bf16(b0, qr[d0], p0, 0, 0, 0);
        p1 = __builtin_amdgcn_mfma_f32_32x32x16_bf16(b1, qr[d0], p1, 0, 0, 0);
    }
}
__device__ __forceinline__ s16x4 vtr(const LAS unsigned char* p) { return __builtin_bit_cast(s16x4, __builtin_amdgcn_ds_read_tr16_b64_v4i16((LAS v4i16_t*)p)); }
__device__ __forceinline__ void pv(f32x16 (&o)[2], const LAS unsigned char* vb, const f32x16& p0, const f32x16& p1, int lane) {
    const int hi = lane >> 5;
    const LAS unsigned char* vp = vb + ((lane >> 4) & 1) * 32 + (lane & 3) * 8 + (4 * hi + ((lane & 15) >> 2)) * 64;
    v4u pw[4];
#pragma unroll
    for (int q = 0; q < 4; ++q) { pw[0][q] = cvtpk(p0[2 * q], p0[2 * q + 1]); pw[1][q] = cvtpk(p0[8 + 2 * q], p0[8 + 2 * q + 1]); pw[2][q] = cvtpk(p1[2 * q], p1[2 * q + 1]); pw[3][q] = cvtpk(p1[8 + 2 * q], p1[8 + 2 * q + 1]); }
#pragma unroll
    for (int d0 = 0; d0 < 2; ++d0)
#pragma unroll
        for (int ks = 0; ks < 4; ++ks) {
            const s16x4 lo = vtr(vp + d0 * 4096 + ks * 1024), hh = vtr(vp + d0 * 4096 + ks * 1024 + 512);
            const bf16x8 vf = (bf16x8){lo[0], lo[1], lo[2], lo[3], hh[0], hh[1], hh[2], hh[3]};
            o[d0] = __builtin_amdgcn_mfma_f32_32x32x16_bf16(__builtin_bit_cast(bf16x8, pw[ks]), vf, o[d0], 0, 0, 0);
        }
}
__device__ __forceinline__ void scale_rows(f32x16 (&o)[2], float f, LAS float* wsf, int r32, int hi) {
    if (hi == 0) wsf[r32] = f;
    asm volatile("s_waitcnt lgkmcnt(0)" ::: "memory");
#pragma unroll
    for (int k = 0; k < 4; ++k) { const f32x4 fv = *(const LAS f32x4*)(wsf + 8 * k + 4 * hi);
#pragma unroll
        for (int i = 0; i < 4; ++i) { o[0][4 * k + i] *= fv[i]; o[1][4 * k + i] *= fv[i]; } }
    asm volatile("s_waitcnt lgkmcnt(0)" ::: "memory");
}
__device__ __forceinline__ void axpy_rows(f32x16 (&acc)[2], const f32x16 (&o)[2], float f, LAS float* wsf, int r32, int hi) {
    if (hi == 0) wsf[r32] = f;
    asm volatile("s_waitcnt lgkmcnt(0)" ::: "memory");
#pragma unroll
    for (int k = 0; k < 4; ++k) { const f32x4 fv = *(const LAS f32x4*)(wsf + 8 * k + 4 * hi);
#pragma unroll
        for (int i = 0; i < 4; ++i) { acc[0][4 * k + i] += o[0][4 * k + i] * fv[i]; acc[1][4 * k + i] += o[1][4 * k + i] * fv[i]; } }
    asm volatile("s_waitcnt lgkmcnt(0)" ::: "memory");
}
template <int MODE>
__device__ __forceinline__ void acc_rows(f32x16 (&o)[2], float f, LAS float* wsf, LAS float* accw, int r32, int hi) {
    if (hi == 0) wsf[r32] = f;
    asm volatile("s_waitcnt lgkmcnt(0)" ::: "memory");
#pragma unroll
    for (int k = 0; k < 4; ++k) { const f32x4 fv = *(const LAS f32x4*)(wsf + 8 * k + 4 * hi);
#pragma unroll
        for (int i = 0; i < 4; ++i)
#pragma unroll
            for (int d0 = 0; d0 < 2; ++d0) { LAS float* p = accw + (8 * k + 4 * hi + i) * 64 + d0 * 32 + r32; const float v = o[d0][4 * k + i] * fv[i];
                if (MODE == 0) *p = v; else if (MODE == 1) *p += v; else o[d0][4 * k + i] = *p + v; } }
    asm volatile("s_waitcnt lgkmcnt(0)" ::: "memory");
}
__device__ __forceinline__ void softmax_pv(f32x16& p0, f32x16& p1, f32x16 (&o)[2], float& m, float& l, const LAS unsigned char* vb, LAS float* wsf, int lane) {
    const int r32 = lane & 31, hi = lane >> 5;
    float mt = fmaxf(p0[0], p1[0]);
#pragma unroll
    for (int r = 1; r < 16; ++r) mt = fmaxf(mt, fmaxf(p0[r], p1[r]));
    mt = swap_max(mt);
    if (__any(mt > m + 8.0f)) {
        const float mn = fmaxf(m, mt), alpha = __builtin_amdgcn_exp2f(m - mn);
        l *= alpha; m = mn;
        scale_rows(o, alpha, wsf, r32, hi);
    }
    float s = 0.f;
#pragma unroll
    for (int r = 0; r < 16; ++r) { p0[r] = __builtin_amdgcn_exp2f(p0[r] - m); p1[r] = __builtin_amdgcn_exp2f(p1[r] - m); s += p0[r] + p1[r]; }
    l += s;
    pv(o, vb, p0, p1, lane);
}
__device__ __forceinline__ void store_rows(const f32x16 (&o)[2], LAS unsigned char* ost, bf16* dst, int pitch, int lane) {
    const int r32 = lane & 31, hi = lane >> 5;
    LAS bf16* stg = (LAS bf16*)ost;
#pragma unroll
    for (int r = 0; r < 16; ++r) { const int orow = crow(r, hi);
#pragma unroll
        for (int d0 = 0; d0 < 2; ++d0) stg[orow * 64 + d0 * 32 + r32] = (bf16)f2bf(o[d0][r]); }
    asm volatile("s_waitcnt lgkmcnt(0)" ::: "memory");
#pragma unroll
    for (int i = 0; i < 4; ++i) { const int row = i * 8 + (lane >> 3), ch = lane & 7; const v4u v = *(const LAS v4u*)(stg + row * 64 + ch * 8); *(GAS v4u*)(dst + (size_t)row * pitch + ch * 8) = v; }
    asm volatile("s_waitcnt lgkmcnt(0)" ::: "memory");
}
#define ATT_BAR() do { asm volatile("s_waitcnt vmcnt(0) lgkmcnt(0)" ::: "memory"); __builtin_amdgcn_s_barrier(); asm volatile("" ::: "memory"); } while (0)
#define ATT_LBAR() do { asm volatile("s_waitcnt lgkmcnt(0)" ::: "memory"); __builtin_amdgcn_s_barrier(); asm volatile("" ::: "memory"); } while (0)

__device__ __forceinline__ void glds16(const void* gsrc, unsigned lds_dst) { unsigned keep;
    asm volatile("s_mov_b32 %0, m0\n\ts_mov_b32 m0, %2\n\ts_nop 0\n\tglobal_load_lds_dwordx4 %1, off\n\ts_mov_b32 m0, %0" : "=&s"(keep) : "v"(gsrc), "s"(lds_dst) : "memory"); }
#define SW_BAR() asm volatile("s_waitcnt lgkmcnt(0)\n\ts_barrier" ::: "memory")
#define SW_VBAR() asm volatile("s_waitcnt vmcnt(0) lgkmcnt(0)\n\ts_barrier" ::: "memory")
#define SW_VWAIT() asm volatile("s_waitcnt vmcnt(0)" ::: "memory")

struct PvFrag { v4u pw[4]; };
__device__ __forceinline__ void pack_p(PvFrag& f, const f32x16& p0, const f32x16& p1) {
#pragma unroll
    for (int q = 0; q < 4; ++q) { f.pw[0][q] = cvtpk(p0[2 * q], p0[2 * q + 1]); f.pw[1][q] = cvtpk(p0[8 + 2 * q], p0[8 + 2 * q + 1]); f.pw[2][q] = cvtpk(p1[2 * q], p1[2 * q + 1]); f.pw[3][q] = cvtpk(p1[8 + 2 * q], p1[8 + 2 * q + 1]); }
}
__device__ __forceinline__ void pv_packed(f32x16 (&o)[2], const LAS unsigned char* vb, const PvFrag& f, int lane) {
    const int hi = lane >> 5;
    const LAS unsigned char* vp = vb + ((lane >> 4) & 1) * 32 + (lane & 3) * 8 + (4 * hi + ((lane & 15) >> 2)) * 64;
#pragma unroll
    for (int d0 = 0; d0 < 2; ++d0)
#pragma unroll
        for (int ks = 0; ks < 4; ++ks) {
            const s16x4 lo = vtr(vp + d0 * 4096 + ks * 1024), hh = vtr(vp + d0 * 4096 + ks * 1024 + 512);
            const bf16x8 vf = (bf16x8){lo[0], lo[1], lo[2], lo[3], hh[0], hh[1], hh[2], hh[3]};
            o[d0] = __builtin_amdgcn_mfma_f32_32x32x16_bf16(__builtin_bit_cast(bf16x8, f.pw[ks]), vf, o[d0], 0, 0, 0);
        }
}
__device__ __forceinline__ float max3f(float a, float b, float c) { float r; asm("v_max3_f32 %0, %1, %2, %3" : "=v"(r) : "v"(a), "v"(b), "v"(c)); return r; }
__device__ __forceinline__ void softmax_tile(f32x16& p0, f32x16& p1, f32x16 (&o)[2], float& m, float& l, PvFrag& f, LAS float* wsf, int lane, float cadd) {
    const int r32 = lane & 31, hi = lane >> 5;
    float ma = max3f(p0[0], p0[1], p1[0]), mb = max3f(p0[2], p0[3], p1[1]); ma = max3f(ma, p1[2], p1[3]);
#pragma unroll
    for (int r = 4; r < 16; r += 4) { ma = max3f(ma, p0[r], p0[r + 1]); mb = max3f(mb, p0[r + 2], p0[r + 3]); ma = max3f(ma, p1[r], p1[r + 1]); mb = max3f(mb, p1[r + 2], p1[r + 3]); }
    float mt = swap_max(fmaxf(ma, mb)) + cadd;
    if (__any(mt > m + 8.0f)) {
        const float mn = fmaxf(m, mt), alpha = __builtin_amdgcn_exp2f(m - mn);
        l *= alpha; m = mn;
        scale_rows(o, alpha, wsf, r32, hi);
    }
    const float mref = m - cadd;
    float s0 = 0.f, s1 = 0.f;
#pragma unroll
    for (int r = 0; r < 16; ++r) { p0[r] = __builtin_amdgcn_exp2f(p0[r] - mref); p1[r] = __builtin_amdgcn_exp2f(p1[r] - mref); s0 += p0[r]; s1 += p1[r]; }
    l += s0 + s1;
    pack_p(f, p0, p1);
}
template <class TileOf, class Score, class Active>
__device__ __forceinline__ void sweep(LAS unsigned char* lds, const bf16* kbase, const bf16* vbase, const int NTL, const bf16x8 (&qr)[4], f32x16 (&o)[2], float& m, float& l,
                                      LAS float* wsf, int lane, int wave, const TileOf& tile_of, const Score& score, const Active& active) {
    const int r32 = lane & 31, hi = lane >> 5, half = wave >> 2;
    const unsigned lds0 = (unsigned)(uintptr_t)lds;
    const bf16* ksrc = kbase + lane * 64 + wave * 8;
    const bf16* vsrc = vbase + (16 * (wave & 3) + (lane >> 2)) * 64 + (wave >> 2) * 32 + (lane & 3) * 8;
#define SW_ISSUE(n) do { const int j_ = tile_of(n); const int s_ = (n) % NSLOT; \
        glds16(ksrc + (size_t)j_ * 4096, (unsigned)__builtin_amdgcn_readfirstlane((int)(lds0 + L_K + s_ * KT_BYTES + wave * KSTR))); \
        glds16(vsrc + (size_t)j_ * 4096, (unsigned)__builtin_amdgcn_readfirstlane((int)(lds0 + L_V + s_ * VT_BYTES + wave * 1024))); } while (0)
    SW_ISSUE(0); if (NTL > 1) SW_ISSUE(1); if (NTL > 2) SW_ISSUE(2);
    SW_VBAR();
    if (half) SW_BAR();
    f32x16 p0, p1; PvFrag pf;
    if (active(0)) qkt(p0, p1, lds + L_K, qr, r32, hi);
    SW_BAR();
    if (active(0)) { const float cadd = score(0, tile_of(0), p0, p1); softmax_tile(p0, p1, o, m, l, pf, wsf, lane, cadd); }
    SW_BAR();
    for (int i = 1; i < NTL; ++i) {
        const bool fetch1 = (i + 1 >= NSLOT) && (i + 1 < NTL), fetch2 = (i + 2 >= NSLOT) && (i + 2 < NTL);
        if (!half && fetch1) SW_ISSUE(i + 1);
        if (active(i - 1)) pv_packed(o, lds + L_V + ((i - 1) % NSLOT) * VT_BYTES, pf, lane);
        if (active(i)) qkt(p0, p1, lds + L_K + (i % NSLOT) * KT_BYTES, qr, r32, hi);
        if (half && fetch1) SW_VWAIT();
        SW_BAR();
        if (half && fetch2) SW_ISSUE(i + 2);
        if (active(i)) { const float cadd = score(i, tile_of(i), p0, p1); softmax_tile(p0, p1, o, m, l, pf, wsf, lane, cadd); }
        if (!half && fetch1) SW_VWAIT();
        SW_BAR();
    }
    if (!half) SW_BAR();
    if (active(NTL - 1)) pv_packed(o, lds + L_V + ((NTL - 1) % NSLOT) * VT_BYTES, pf, lane);
    SW_BAR();
#undef SW_ISSUE
}

__device__ __forceinline__ void fox_unit(LAS unsigned char* lds, unsigned char* ws, int bh, int qb, int tid_in) {
    int tid = tid_in; asm volatile("" : "+v"(tid));
    const int lane = tid & 63, wave = __builtin_amdgcn_readfirstlane(tid >> 6), r32 = lane & 31, hi = lane >> 5;
    const bf16* FQ = (const bf16*)(ws + WS_FQKV) + (size_t)bh * SEQ * 64; const bf16* FK = FQ + (size_t)M * 512; const bf16* FV = FK + (size_t)M * 512;
    const float* nf = (const float*)(ws + WS_NF2) + (size_t)bh * SEQ;
    LAS float* wsf = (LAS float*)(lds + L_WSF + wave * 256);
    const int q0 = 256 * qb + 32 * wave, qg = q0 + r32;
    bf16x8 qr[4];
#pragma unroll
    for (int d0 = 0; d0 < 4; ++d0) qr[d0] = *(const GAS bf16x8*)(FQ + (size_t)qg * 64 + 16 * d0 + 8 * hi);
    const int NT = 4 * qb + 4, mylast = (q0 + 31) >> 6;
    for (int i = tid; i < 16 * NT; i += 512) *(LAS f32x4*)(lds + L_F + i * 16) = *((const GAS f32x4*)nf + i);
    float m = MINIT, l = 0.f; f32x16 o[2]; o[0] = (f32x16){}; o[1] = (f32x16){};
    auto tile_of = [&](int i) { return NT - 1 - i; };
    auto active = [&](int i) { return NT - 1 - i <= mylast; };
    auto score = [&](int, int t, f32x16& p0, f32x16& p1) {
        const LAS float* fb = (const LAS float*)(lds + L_F) + 64 * t;
#pragma unroll
        for (int k = 0; k < 4; ++k) { const f32x4 f0 = *(const LAS f32x4*)(fb + 8 * k + 4 * hi), f1 = *(const LAS f32x4*)(fb + 32 + 8 * k + 4 * hi);
#pragma unroll
            for (int i = 0; i < 4; ++i) { p0[4 * k + i] += f0[i]; p1[4 * k + i] += f1[i]; } }
        if (64 * t + 63 > q0) {
            const int lim = qg - 64 * t;
#pragma unroll
            for (int r = 0; r < 16; ++r) { const int kv = crow(r, hi); if (kv > lim) p0[r] = MASKV; if (kv + 32 > lim) p1[r] = MASKV; }
        }
        return 0.f;
    };
    sweep(lds, FK, FV, NT, qr, o, m, l, wsf, lane, wave, tile_of, score, active);
    l = swap_sum(l);
    scale_rows(o, 1.f / l, wsf, r32, hi);
    const int b = bh >> 3, h = bh & 7;
    store_rows(o, lds + L_OST + wave * 4096, (bf16*)(ws + WS_YF) + ((size_t)b * SEQ + q0) * 512 + h * 64, 512, lane);
}

template <bool WIN>
__device__ __forceinline__ float nsa_scores(f32x16& p0, f32x16& p1, int dj, int tl, int hi, bool rowsel, const LAS float* lutg, float cfar) {
    const float rowc = rowsel ? 0.f : MASKV;
    if (dj <= 2) {
        const LAS float* tb = lutg + (255 - 64 * dj - tl + 4 * hi);
#pragma unroll
        for (int r = 0; r < 16; ++r) { const int c = (r & 3) + 8 * (r >> 2); p0[r] += tb[c]; p1[r] += tb[32 + c]; }
        if (dj == 0) {
            const int lim = tl - 4 * hi;
#pragma unroll
            for (int r = 0; r < 16; ++r) { const int c = (r & 3) + 8 * (r >> 2); if (c > lim) p0[r] = MASKV; if (c + 32 > lim) p1[r] = MASKV; }
        }
        return rowc;
    }
    if (WIN && dj == 8) {
        const int lim = tl - 4 * hi;
#pragma unroll
        for (int r = 0; r < 16; ++r) { const int c = (r & 3) + 8 * (r >> 2); if (c <= lim) p0[r] = MASKV; if (c + 32 <= lim) p1[r] = MASKV; }
    }
    return rowsel ? cfar : MASKV;
}

__device__ __forceinline__ void nsa_unit(LAS unsigned char* lds, unsigned char* ws, const float* relb, int bk, int cur, int tid_in) {
    int tid = tid_in; asm volatile("" : "+v"(tid));
    const int lane = tid & 63, wave = __builtin_amdgcn_readfirstlane(tid >> 6), r32 = lane & 31, hi = lane >> 5;
    const int g = wave & 3, th = wave >> 2, tl = 32 * th + r32, t = 64 * cur + tl, b = bk >> 1, kvh = bk & 1, h = 4 * kvh + g;
    LAS float* wsf = (LAS float*)(lds + L_WSF + wave * 256);
    LAS float* lutall = (LAS float*)(lds + L_LUT); const LAS float* lut = lutall + g * 320;
    LAS float* impP = (LAS float*)(lds + L_IMP); LAS unsigned* selm = (LAS unsigned*)(lds + L_SEL);
    const bf16* KV6 = (const bf16*)(ws + WS_KV6);
    for (int e = tid; e < 1280; e += 512) { const int gg = e / 320, rel = 255 - (e % 320); lutall[e] = relb[t5b(rel < 0 ? 0 : rel) * 8 + 4 * kvh + gg] * LOG2E; }
    const float cfar = relb[31 * 8 + h] * LOG2E;
    bf16x8 qr[4];
    { const bf16* Q = (const bf16*)(ws + WS_QN) + ((size_t)(b * 8 + h) * SEQ + t) * 64;
#pragma unroll
      for (int d0 = 0; d0 < 4; ++d0) qr[d0] = *(const GAS bf16x8*)(Q + 16 * d0 + 8 * hi); }
    const float* ngp = (const float*)(ws + WS_NG) + ((size_t)b * SEQ + t) * 24 + h * 3;
    const float g_c = ngp[0], g_s = ngp[1], g_w = ngp[2];
    f32x16 oc[2]; oc[0] = (f32x16){}; oc[1] = (f32x16){};
    LAS float* accw = (LAS float*)(lds + L_ACC + wave * 8192);
    {
        const bf16* kc = (const bf16*)(ws + WS_KCC) + (size_t)bk * 128 * 64; const bf16* vc = (const bf16*)(ws + WS_VCC) + (size_t)bk * 128 * 64;
        { TileRegs R0, R1; tile_issue(R0, kc, vc, tid); tile_issue(R1, kc + 4096, vc + 4096, tid);
          tile_store(R0, lds, 0, tid); tile_store(R1, lds, 1, tid); }
        ATT_BAR();
        const int ntc = cur > 15 ? 2 : 1;
#define CMP_SCORES(tt) do { qkt(p0, p1, lds + L_K + (tt) * KT_BYTES, qr, r32, hi); \
        _Pragma("unroll") for (int r = 0; r < 16; ++r) { const int c0 = 64 * (tt) + crow(r, hi), rel0 = t - (16 * c0 + 31), rel1 = rel0 - 512; \
            p0[r] = (rel0 >= 0) ? p0[r] + lut[255 - min(rel0, 255)] : MASKV; \
            p1[r] = (rel1 >= 0 && c0 + 32 < N_CMP) ? p1[r] + lut[255 - min(max(rel1, 0), 255)] : MASKV; } } while (0)
        float mx = MASKV, s = 0.f;
        for (int tt = 0; tt < ntc; ++tt) {
            f32x16 p0, p1; CMP_SCORES(tt);
            float mt = fmaxf(p0[0], p1[0]);
#pragma unroll
            for (int r = 1; r < 16; ++r) mt = fmaxf(mt, fmaxf(p0[r], p1[r]));
            mt = swap_max(mt);
            const float mn = fmaxf(mx, mt), mref = mn < -1e29f ? 0.f : mn;
            s *= __builtin_amdgcn_exp2f(fmaxf(mx, -1e30f) - fmaxf(mn, -1e30f));
#pragma unroll
            for (int r = 0; r < 16; ++r) s += __builtin_amdgcn_exp2f(p0[r] - mref) + __builtin_amdgcn_exp2f(p1[r] - mref);
            mx = mn;
        }
        s = swap_sum(s);
        const float mref = mx < -1e29f ? 0.f : mx, inv = 1.f / fmaxf(s, 1e-30f);
        LAS float* ip = impP + (size_t)(g * 64 + tl) * 32;
        float carry = 0.f;
        for (int tt = 0; tt < 2; ++tt) {
            if (tt < ntc) {
                f32x16 p0, p1; CMP_SCORES(tt);
#pragma unroll
                for (int r = 0; r < 16; ++r) { p0[r] = __builtin_amdgcn_exp2f(p0[r] - mref) * inv; p1[r] = __builtin_amdgcn_exp2f(p1[r] - mref) * inv; }
#pragma unroll
                for (int nn = 0; nn < 8; ++nn) { const f32x16& P = (nn >> 2) ? p1 : p0; const int k4 = 4 * (nn & 3);
                    const float pe = swap_other(P[k4 + 3]);
                    const float prev = hi ? pe : carry;
                    ip[2 * (8 * tt + nn) + hi] = (P[k4] + P[k4 + 1]) + (P[k4 + 2] + 0.5f * P[k4 + 3]) + 0.5f * prev;
                    carry = pe; }
                pv(oc, lds + L_V + tt * VT_BYTES, p0, p1, lane);
            } else {
#pragma unroll
                for (int nn = 0; nn < 8; ++nn) ip[2 * (8 * tt + nn) + hi] = 0.f;
            }
        }
#undef CMP_SCORES
    }
    ATT_LBAR();
    for (int i = 0; i < 8; ++i) {
        const int tok = 8 * wave + i;
        float imp = -1.f;
        if (lane < 32) { const int j = lane; const float v = (impP[(0 * 64 + tok) * 32 + j] + impP[(1 * 64 + tok) * 32 + j]) + (impP[(2 * 64 + tok) * 32 + j] + impP[(3 * 64 + tok) * 32 + j]);
            const bool forced = (j == 0) || (j <= cur && j > cur - 2);
            imp = forced ? 1e4f : (j <= cur ? v : -1.f); }
        int rank = 0;
#pragma unroll
        for (int jj = 0; jj < 32; ++jj) { const float ov = __int_as_float(__builtin_amdgcn_readlane(__float_as_int(imp), jj)); rank += (ov > imp || (ov == imp && jj < lane)) ? 1 : 0; }
        const unsigned msk = (unsigned)(__ballot(lane < 32 && rank < 16) & 0xffffffffull);
        if (lane == 0) selm[tok] = msk;
    }
    ATT_LBAR();
    acc_rows<0>(oc, g_c, wsf, accw, r32, hi);
    const unsigned vismask = (cur >= 31) ? 0xffffffffu : ((2u << cur) - 1u);
    const unsigned mysel = selm[tl] & vismask;
    unsigned U = selm[lane] & vismask;
#pragma unroll
    for (int of = 1; of < 64; of <<= 1) U |= (unsigned)__shfl_xor((int)U, of);
    U = (unsigned)__builtin_amdgcn_readfirstlane((int)U);
    {
        const bf16* ks = KV6 + (size_t)2 * M * 128 + (size_t)bk * SEQ * 64; const bf16* vs = KV6 + (size_t)3 * M * 128 + (size_t)bk * SEQ * 64;
        float m = MINIT, l = 0.f; f32x16 o[2]; o[0] = (f32x16){}; o[1] = (f32x16){};
        int jv = 0;
        { int cnt = lane + 1;
#pragma unroll 4
          for (int bq = 0; bq < 32; ++bq) if ((U >> bq) & 1u) { if (--cnt == 0) jv = bq; } }
        const int NTL = __builtin_popcount(U);
        auto tile_of = [&](int i) { return __builtin_amdgcn_readlane(jv, i); };
        auto active = [&](int) { return true; };
        auto score = [&](int, int j, f32x16& p0, f32x16& p1) {
            return nsa_scores<false>(p0, p1, cur - j, tl, hi, (mysel >> j) & 1u, lut, cfar);
        };
        sweep(lds, ks, vs, NTL, qr, o, m, l, wsf, lane, wave, tile_of, score, active);
        l = swap_sum(l);
        acc_rows<1>(o, g_s / l, wsf, accw, r32, hi);
    }
    {
        const bf16* kw = KV6 + (size_t)4 * M * 128 + (size_t)bk * SEQ * 64; const bf16* vw = KV6 + (size_t)5 * M * 128 + (size_t)bk * SEQ * 64;
        float m = MINIT, l = 0.f; f32x16 o[2]; o[0] = (f32x16){}; o[1] = (f32x16){};
        const int jlo = cur - 8 > 0 ? cur - 8 : 0;
        auto tile_of = [&](int i) { return cur - i; };
        auto active = [&](int) { return true; };
        auto score = [&](int, int j, f32x16& p0, f32x16& p1) {
            return nsa_scores<true>(p0, p1, cur - j, tl, hi, true, lut, cfar);
        };
        sweep(lds, kw, vw, cur - jlo + 1, qr, o, m, l, wsf, lane, wave, tile_of, score, active);
        l = swap_sum(l);
        acc_rows<2>(o, g_w / l, wsf, accw, r32, hi);
        store_rows(o, (LAS unsigned char*)accw, (bf16*)(ws + WS_YN) + ((size_t)b * SEQ + 64 * cur + 32 * th) * 512 + h * 64, 512, lane);
    }
}
}

__device__ __forceinline__ void p3_attention(const Frame& F) {
    PHASE_IDS(); const CArgs* a = kargs(); unsigned char* ws = a->ws;
#ifndef REP_FOX
#define REP_FOX 1
#endif
#ifndef REP_NSA
#define REP_NSA 1
#endif
    for (int rep_ = 0; rep_ < REP_FOX; ++rep_)
    for (int u = F.vcu; u < 512; u += F.G) { const int idx = u & 255, sec = u >> 8, bh = idx >> 2, s = idx & 3; att::fox_unit(F.lds, ws, bh, sec ? s : 7 - s, tid); }
    for (int rep_ = 0; rep_ < REP_NSA; ++rep_)
    for (int u = F.vcu; u < 512; u += F.G) { const int idx = u & 255, sec = u >> 8, bk = idx >> 4, s = idx & 15; att::nsa_unit(F.lds, ws, a->in[I_REL], bk, sec ? s : 31 - s, tid); }
}

constexpr int PH_PER_LAYER = 10, NPHASES = 1 + DEPTH * PH_PER_LAYER;
#ifndef REP_P0
#define REP_P0 1
#endif
#ifndef REP_INPROJ
#define REP_INPROJ 1
#endif
#ifndef REP_P2
#define REP_P2 1
#endif
#ifndef REP_ATTN
#define REP_ATTN 1
#endif
#ifndef REP_BRANCH
#define REP_BRANCH 1
#endif
#ifndef REP_WO
#define REP_WO 1
#endif
#ifndef REP_LN
#define REP_LN 1
#endif
#ifndef REP_UP
#define REP_UP 1
#endif
#ifndef REP_DOWN
#define REP_DOWN 1
#endif
#define REPEAT(n) for (int rep_ = 0; rep_ < (n); ++rep_)
#ifndef NAIVE_ATTN
#define NAIVE_ATTN 0
#endif
#ifndef MK_SINGLE
#define MK_SINGLE 1
#endif

#define IN(k) (lo <= (k) && (k) < hi)
#define SEAM(k) do { if (IN(k) && IN((k) + 1)) { XcdBarrier b_ = bar; asm volatile("" : "+s"(b_.bar)); xcd_barrier(b_); } } while (0)
template <int L> __device__ __forceinline__ void layer_body(const Frame& F, const int lo, const int hi, const XcdBarrier& bar) {
        const int pb = 1 + PH_PER_LAYER * L, j = L >> 1; const bool moe = (L & 1) != 0;
        if (IN(pb + 0)) REPEAT(REP_INPROJ) {
            const CArgs* ka = kargs(); unsigned char* ws = ka->ws;
            pg8::Gemm g{(const bf16*)(ws + WS_XB), (const bf16*)(ws + WS_WIN) + (size_t)L * NPROJ * DM, DM, DM, DM};
            pg8::StaticOrder S; S.init(M / 256, NPROJ / 256, F.G, (int)blockIdx.x);
            EpiInProj E{ws, ka->in[I_FB] + L * 8};
            pg8::gemm_phase<EpiInProj, pg8::StaticOrder, true, true>(F.lds, g, S, E, F.wave);
        }
        SEAM(pb + 0);
        if (IN(pb + 1)) REPEAT(REP_P2) { p2_cmp_scan(F, L); }
        SEAM(pb + 1);
        if (IN(pb + 2)) REPEAT(REP_ATTN) {
#if NAIVE_ATTN
            p3_fox_naive(F); __syncthreads(); p3_nsa_naive(F);
#else
            p3_attention(F);
#endif
        }
        SEAM(pb + 2);
        if (IN(pb + 3)) REPEAT(REP_BRANCH) {
            const CArgs* ka = kargs(); unsigned char* ws = ka->ws;
            pg8::StaticOrder S; S.init(M / 256, DM / 256, F.G, (int)blockIdx.x);
            { pg8::Gemm g{(const bf16*)(ws + WS_YN), (const bf16*)(ws + WS_WNSA) + (size_t)L * DM * 512, 512, 512, 512};
              EpiBranch<false> E{(const bf16*)(ws + WS_MG), (bf16*)(ws + WS_MERGED), 0};
              pg8::gemm_phase<EpiBranch<false>, pg8::StaticOrder, false, true>(F.lds, g, S, E, F.wave); }
            VM_WAIT(); __syncthreads();
            { pg8::Gemm g{(const bf16*)(ws + WS_YF), (const bf16*)(ws + WS_WFOX) + (size_t)L * DM * 512, 512, 512, 512};
              EpiBranch<true> E{(const bf16*)(ws + WS_MG), (bf16*)(ws + WS_MERGED), 1024};
              pg8::gemm_phase<EpiBranch<true>, pg8::StaticOrder, false, true>(F.lds, g, S, E, F.wave); }
        }
        SEAM(pb + 3);
        if (IN(pb + 4)) REPEAT(REP_WO) {
            const CArgs* ka = kargs(); unsigned char* ws = ka->ws;
            pg8::Gemm g{(const bf16*)(ws + WS_MERGED), (const bf16*)(ws + WS_WO) + (size_t)L * DM * DM, DM, DM, DM};
            pg8::StaticOrder S; S.init(M / 256, DM / 256, F.G, (int)blockIdx.x);
            EpiResF32 E{L == 0 ? ka->in[I_X] : (const float*)ka->out, (float*)(ws + WS_PRE)};
            pg8::gemm_phase<EpiResF32, pg8::StaticOrder, false, true>(F.lds, g, S, E, F.wave);
        }
        SEAM(pb + 4);
        if (IN(pb + 5)) {
            if (moe) ln_phase<0, true, I_LN1G, I_LN1B>(F, L, j);
            else ln_phase<0, false, I_LN1G, I_LN1B>(F, L, j);
        }
        SEAM(pb + 5);
        if (IN(pb + 6) && moe) { moe_gather(F, j); }
        if (moe) SEAM(pb + 6);
        if (IN(pb + 7)) REPEAT(REP_UP) {
            const CArgs* ka = kargs(); unsigned char* ws = ka->ws;
            if (moe) {
                int toff[9]; moe_tiles((unsigned*)(ws + WS_CTL), j, toff);
                pg8::MoeOrder S; S.so.init(toff[8], 2 * FF_E / 256, F.G, (int)blockIdx.x);
                S.t1 = toff[1]; S.t2 = toff[2]; S.t3 = toff[3]; S.t4 = toff[4]; S.t5 = toff[5]; S.t6 = toff[6]; S.t7 = toff[7];
                pg8::Gemm g{(const bf16*)(ws + WS_XG), (const bf16*)(ws + WS_WMGU) + (size_t)j * NEXP * 2 * FF_E * DM, DM, DM, DM};
                EpiSwiGLU E{(bf16*)(ws + WS_HID), FF_E};
                pg8::gemm_phase<EpiSwiGLU, pg8::MoeOrder, true, true>(F.lds, g, S, E, F.wave);
            } else {
                pg8::Gemm g{(const bf16*)(ws + WS_XB), (const bf16*)(ws + WS_WDGU) + (size_t)j * 2 * FF_D * DM, DM, DM, DM};
                pg8::StaticOrder S; S.init(M / 256, 2 * FF_D / 256, F.G, (int)blockIdx.x);
                EpiSwiGLU E{(bf16*)(ws + WS_HID), FF_D};
                pg8::gemm_phase<EpiSwiGLU, pg8::StaticOrder, true, true>(F.lds, g, S, E, F.wave);
            }
        }
        SEAM(pb + 7);
        if (IN(pb + 8)) REPEAT(REP_DOWN) {
            const CArgs* ka = kargs(); unsigned char* ws = ka->ws;
            if (moe) {
                int toff[9]; moe_tiles((unsigned*)(ws + WS_CTL), j, toff);
                pg8::MoeOrder S; S.so.init(toff[8], DM / 256, F.G, (int)blockIdx.x);
                S.t1 = toff[1]; S.t2 = toff[2]; S.t3 = toff[3]; S.t4 = toff[4]; S.t5 = toff[5]; S.t6 = toff[6]; S.t7 = toff[7];
                pg8::Gemm g{(const bf16*)(ws + WS_HID), (const bf16*)(ws + WS_WMD) + (size_t)j * NEXP * DM * FF_E, FF_E, FF_E, FF_E};
                EpiPlainBf16 E{(bf16*)(ws + WS_XG)};
                pg8::gemm_phase<EpiPlainBf16, pg8::MoeOrder, true, true>(F.lds, g, S, E, F.wave);
            } else {
                pg8::Gemm g{(const bf16*)(ws + WS_HID), (const bf16*)(ws + WS_WDD) + (size_t)j * DM * FF_D, FF_D, FF_D, FF_D};
                pg8::StaticOrder S; S.init(M / 256, DM / 256, F.G, (int)blockIdx.x);
                EpiResF32 E{(const float*)ka->out, (float*)(ws + WS_PRE)};
                pg8::gemm_phase<EpiResF32, pg8::StaticOrder, false, true>(F.lds, g, S, E, F.wave);
            }
        }
        SEAM(pb + 8);
        if (IN(pb + 9)) REPEAT(REP_LN) {
            if (moe) ln_phase<1, false, I_LN2G, I_LN2B>(F, L, j);
            else ln_phase<0, false, I_LN2G, I_LN2B>(F, L, j);
        }
        SEAM(pb + 9);
    }

__global__ void __launch_bounds__(NWAVES * 64, 2) hybrid_fwd(Args args) {
    extern __shared__ __attribute__((aligned(16))) unsigned char lds[];
    Frame F;
    F.lds = (LAS unsigned char*)lds;
    F.wave = __builtin_amdgcn_readfirstlane((int)threadIdx.x >> 6);
    F.G = gridDim.x; { const int bx = blockIdx.x; F.vcu = (F.G % 8 == 0) ? (bx % 8) * (F.G / 8) + bx / 8 : bx; }
    for (int u = threadIdx.x; u < (LDS_BYTES - LDSCTL_OFF) / 4; u += NWAVES * 64) ((LAS unsigned*)(F.lds + LDSCTL_OFF))[u] = 0u;
    __syncthreads();
    const int lo = args.ph_lo, hi = args.ph_hi;
    XcdBarrier bar; bar.bar = (unsigned*)(args.ws + WS_CTL) + CW_BAR; bar.x = 0; bar.st = nullptr;
    if (hi - lo > 1) bar = xcd_barrier_post((unsigned*)(args.ws + WS_CTL) + CW_BAR, (volatile LAS unsigned*)(F.lds + MISC_OFF) + 8);

    if (IN(0)) { REPEAT(REP_P0) p0_prologue(F); }
    SEAM(0);

    layer_body<0>(F, lo, hi, bar); layer_body<1>(F, lo, hi, bar); layer_body<2>(F, lo, hi, bar); layer_body<3>(F, lo, hi, bar);
#undef IN
#undef SEAM
}

extern "C" void kernel_launch(void* const* d_in, const int* in_sizes, int n_in, void* d_out, int out_size, void* d_ws, size_t ws_size, hipStream_t stream) {
    static int grid = 0;
    if (grid == 0) {
        if (n_in != 21 || in_sizes[0] != M * DM || out_size != M * DM || ws_size < WS_END) { fprintf(stderr, "kernel_launch: unexpected shapes / workspace (n_in %d, ws %zu, need %zu); nothing launched\n", n_in, ws_size, (size_t)WS_END); grid = -1; return; }
        int dev = 0, cus = 0, per_cu = 0;
        if (hipGetDevice(&dev) != hipSuccess || hipDeviceGetAttribute(&cus, hipDeviceAttributeMultiprocessorCount, dev) != hipSuccess) { grid = -1; return; }
        if (hipFuncSetAttribute((const void*)hybrid_fwd, hipFuncAttributeMaxDynamicSharedMemorySize, LDS_BYTES) != hipSuccess) { fprintf(stderr, "kernel_launch: hipFuncSetAttribute failed\n"); grid = -1; return; }
        if (hipOccupancyMaxActiveBlocksPerMultiprocessor(&per_cu, (const void*)hybrid_fwd, NWAVES * 64, LDS_BYTES) != hipSuccess || per_cu < 1) { fprintf(stderr, "kernel_launch: occupancy query reports %d blocks per CU\n", per_cu); }
        (void)hipGetLastError();
        grid = cus;
    }
    if (grid < 0) return;
    if (hipMemsetAsync((char*)d_ws + WS_CTL, 0, CTL_ZERO_BYTES, stream) != hipSuccess) return;
    Args a{};
    for (int i = 0; i < 21; ++i) a.in[i] = (const float*)d_in[i];
    a.out = (float*)d_out; a.ws = (unsigned char*)d_ws;
#if MK_SINGLE
    a.ph_lo = 0; a.ph_hi = NPHASES;
    hipLaunchKernelGGL(hybrid_fwd, dim3(grid), dim3(NWAVES * 64), LDS_BYTES, stream, a);
#else
    for (int p = 0; p < NPHASES; ++p) {
        if (p >= 1) { const int L = (p - 1) / PH_PER_LAYER, k = (p - 1) % PH_PER_LAYER; if (k == 6 && !(L & 1)) continue; }
        a.ph_lo = p; a.ph_hi = p + 1;
        hipLaunchKernelGGL(hybrid_fwd, dim3(grid), dim3(NWAVES * 64), LDS_BYTES, stream, a);
    }
#endif
}
```

```cpp
#include <hip/hip_runtime.h>
#include <cstdio>
#include <cstdint>

namespace pg8 {
#define PG8_LAS __attribute__((address_space(3)))
typedef unsigned short bf16_t;
typedef short bf16x8 __attribute__((ext_vector_type(8)));
typedef float f32x4 __attribute__((ext_vector_type(4)));
typedef float f32x2 __attribute__((ext_vector_type(2)));
typedef unsigned u32x4 __attribute__((ext_vector_type(4)));
constexpr int BM = 256, BK = 64, HALF = 128, HTB = HALF * BK * 2, STAGE_BYTES = 8 * HTB, NXCD = 8, WGM = 8;

__host__ __device__ __forceinline__ int lds_byte(int r, int c) { const int st = (r >> 4) * 2 + (c >> 5), rr = r & 15, cc = c & 31, ob = rr * 64 + cc * 2; return st * 1024 + (ob ^ (((ob >> 9) & 1) << 5)); }
__host__ __device__ __forceinline__ void stage_rc(int b, int& R, int& C) { const int st = b / 1024, sb = b % 1024, swz = sb ^ (((sb >> 9) & 1) << 5); R = (st >> 1) * 16 + swz / 64; C = (st & 1) * 32 + (swz % 64) / 2; }
__host__ __device__ __forceinline__ int perm32(int rho) { const int n = rho >> 4, i = rho & 15; return 8 * (i >> 2) + 4 * n + (i & 3); }

struct Unit { int pm, pn, pb; };
struct Gemm { const bf16_t* A; const bf16_t* Bt; int lda, ldb, K; };

struct StaticOrder {
    int nM, nN, nwg, G, c;
    __device__ __forceinline__ void init(int nM_, int nN_, int G_, int c_) { nM = nM_; nN = nN_; nwg = nM * nN; G = G_; c = c_; }
    __device__ __forceinline__ bool next(int i, Unit& u) const {
        const long L = (long)i * G + c; if (L >= nwg) return false;
        int wgid = (int)L; { const int q = nwg / NXCD, r = nwg % NXCD, xcd = wgid % NXCD, off = wgid / NXCD; wgid = (xcd < r ? xcd * (q + 1) : r * (q + 1) + (xcd - r) * q) + off; }
        const int nig = WGM * nN, gid = wgid / nig, fm = gid * WGM, gsz = (nM - fm) < WGM ? (nM - fm) : WGM;
        u.pm = fm + ((wgid % nig) % gsz); u.pn = (wgid % nig) / gsz; u.pb = u.pn; return true;
    }
};
struct MoeOrder {
    StaticOrder so; int t1, t2, t3, t4, t5, t6, t7;
    __device__ __forceinline__ bool next(int i, Unit& u) const {
        if (!so.next(i, u)) return false;
        const int e = (u.pm >= t1) + (u.pm >= t2) + (u.pm >= t3) + (u.pm >= t4) + (u.pm >= t5) + (u.pm >= t6) + (u.pm >= t7);
        u.pb = e * so.nN + u.pn; return true;
    }
};

__device__ __forceinline__ unsigned cvt_pk_bf16(float lo, float hi) { unsigned r; asm volatile("v_cvt_pk_bf16_f32 %0, %1, %2" : "=v"(r) : "v"(lo), "v"(hi)); return r; }

template <class Epi, class Sched, bool ALIGN_EPI, bool SP2>
__device__ __forceinline__ void gemm_phase(PG8_LAS unsigned char* lds, const Gemm g, const Sched& S, const Epi& E, int wid_in) {
    int wid = wid_in; asm volatile("" : "+s"(wid));
    int lane; asm volatile("v_mbcnt_lo_u32_b32 %0, -1, 0\n\tv_mbcnt_hi_u32_b32 %0, -1, %0" : "=v"(lane));
    const int tid = wid * 64 + lane, wr = wid >> 2, wc = wid & 3, fr = lane & 15, fq = lane >> 4;
    const int K = g.K, nt = K / BK;
    unsigned voffA[2], voffB[2];
#pragma unroll
    for (int i = 0; i < 2; ++i) { int R, C; stage_rc(tid * 16 + i * 8192, R, C); const int Rb = Epi::PERM ? ((R & ~31) + perm32(R & 31)) : R;
        voffA[i] = (unsigned)(R * g.lda + C) * 2u; voffB[i] = (unsigned)(Rb * g.ldb + C) * 2u; }
    const size_t kstep = (size_t)(BK * 2);
    const size_t hstepA = (size_t)HALF * g.lda * 2, hstepB = (size_t)HALF * g.ldb * 2;
    const size_t tstepA = 2 * hstepA, tstepB = 2 * hstepB;
    const unsigned ldsw = (unsigned)wid * 1024u;
    const int aoff = lds_byte(wr * 64 + fr, fq * 8), boff = lds_byte(wc * 32 + fr, fq * 8);
#define PG8_SA(b, h) (((b) * 2 + (h)) * HTB)
#define PG8_SB(b, h) ((4 + (b) * 2 + (h)) * HTB)
#define PG8_STAGE(bufoff, gbase, voff) do { _Pragma("unroll") for (int _i = 0; _i < 2; ++_i) \
        __builtin_amdgcn_global_load_lds((const unsigned*)((const char*)(gbase) + (voff)[_i]), (PG8_LAS unsigned*)(lds + (bufoff) + ldsw + _i * 8192), 16, 0, 0); } while (0)
#define PG8_LDA(dst, b, h) do { _Pragma("unroll") for (int m = 0; m < 4; ++m) _Pragma("unroll") for (int k = 0; k < 2; ++k) dst[m][k] = *(const PG8_LAS bf16x8*)(lds + PG8_SA(b, h) + aoff + m * 2048 + k * 1024); } while (0)
#define PG8_LDB(dst, b, h) do { _Pragma("unroll") for (int n = 0; n < 2; ++n) _Pragma("unroll") for (int k = 0; k < 2; ++k) dst[n][k] = *(const PG8_LAS bf16x8*)(lds + PG8_SB(b, h) + boff + n * 2048 + k * 1024); } while (0)
#define PG8_MMA(ai, bj, At, Bt) do { __builtin_amdgcn_s_setprio(1); _Pragma("unroll") for (int m = 0; m < 4; ++m) _Pragma("unroll") for (int n = 0; n < 2; ++n) _Pragma("unroll") for (int k = 0; k < 2; ++k) \
        acc[ai][bj][m][n] = __builtin_amdgcn_mfma_f32_16x16x32_bf16(Bt[n][k], At[m][k], acc[ai][bj][m][n], 0, 0, 0); __builtin_amdgcn_s_setprio(0); } while (0)
#define PG8_WAIT_V(n) asm volatile("s_waitcnt vmcnt(" #n ")" ::: "memory")
#define PG8_WAIT_L(n) asm volatile("s_waitcnt lgkmcnt(" #n ")" ::: "memory")
#define PG8_BAR __builtin_amdgcn_s_barrier()
#define PG8_SCHED __builtin_amdgcn_sched_barrier(0)
    Unit cur, nxt; int ui = 0;
    if (!S.next(0, cur)) return;
    f32x4 acc[2][2][4][2];
#pragma unroll
    for (int a = 0; a < 2; ++a)
#pragma unroll
        for (int b = 0; b < 2; ++b)
#pragma unroll
            for (int m = 0; m < 4; ++m)
#pragma unroll
                for (int n = 0; n < 2; ++n) acc[a][b][m][n] = (f32x4){0.f, 0.f, 0.f, 0.f};
    bf16x8 At[4][2], B0[2][2], B1[2][2];
    const char* cA = (const char*)g.A + (size_t)cur.pm * tstepA; const char* cB = (const char*)g.Bt + (size_t)cur.pb * tstepB;
    if constexpr (SP2) {
        PG8_STAGE(PG8_SB(0, 0), cB, voffB); PG8_STAGE(PG8_SB(0, 1), cB + hstepB, voffB); PG8_STAGE(PG8_SA(0, 0), cA, voffA); PG8_STAGE(PG8_SA(0, 1), cA + hstepA, voffA);
        if (wr == 1) PG8_BAR;
        PG8_WAIT_V(2); PG8_BAR;
        PG8_STAGE(PG8_SB(1, 0), cB + kstep, voffB); PG8_STAGE(PG8_SA(1, 0), cA + kstep, voffA); PG8_STAGE(PG8_SB(1, 1), cB + hstepB + kstep, voffB);
        PG8_WAIT_V(6); PG8_BAR;
    } else {
        PG8_STAGE(PG8_SB(0, 0), cB, voffB); PG8_STAGE(PG8_SA(0, 0), cA, voffA); PG8_STAGE(PG8_SB(0, 1), cB + hstepB, voffB); PG8_STAGE(PG8_SA(0, 1), cA + hstepA, voffA);
        if (wr == 1) PG8_BAR;
        PG8_WAIT_V(4); PG8_BAR;
        PG8_STAGE(PG8_SB(1, 0), cB + kstep, voffB); PG8_STAGE(PG8_SA(1, 0), cA + kstep, voffA); PG8_STAGE(PG8_SB(1, 1), cB + hstepB + kstep, voffB);
        PG8_WAIT_V(6); PG8_BAR;
    }
    for (;;) {
        const bool has_next = S.next(ui + 1, nxt);
        const char* nA = has_next ? (const char*)g.A + (size_t)nxt.pm * tstepA : cA; const char* nB = has_next ? (const char*)g.Bt + (size_t)nxt.pb * tstepB : cB;
        for (int t = 0; t < nt; t += 2) {
            const bool last = (t == nt - 2);
            const char* a1 = cA + (size_t)(t + 1) * kstep;
            const char* a2 = last ? nA : cA + (size_t)(t + 2) * kstep; const char* b2 = last ? nB : cB + (size_t)(t + 2) * kstep;
            const char* a3 = a2 + kstep; const char* b3 = b2 + kstep;
            if constexpr (SP2) {
            PG8_LDB(B0, 0, 0); PG8_LDB(B1, 0, 1); PG8_SCHED; PG8_LDA(At, 0, 0); PG8_STAGE(PG8_SA(1, 1), a1 + hstepA, voffA);
            PG8_WAIT_V(8); PG8_WAIT_L(0); PG8_BAR; PG8_MMA(0, 0, At, B0); PG8_MMA(0, 1, At, B1); PG8_BAR; PG8_SCHED;
            PG8_LDA(At, 0, 1); PG8_STAGE(PG8_SB(0, 0), b2, voffB); PG8_STAGE(PG8_SB(0, 1), b2 + hstepB, voffB); PG8_STAGE(PG8_SA(0, 0), a2, voffA);
            PG8_WAIT_V(8); PG8_WAIT_L(0); PG8_BAR; PG8_MMA(1, 0, At, B0); PG8_MMA(1, 1, At, B1); PG8_BAR; PG8_SCHED;
            PG8_LDB(B0, 1, 0); PG8_LDB(B1, 1, 1); PG8_SCHED; PG8_LDA(At, 1, 0); PG8_STAGE(PG8_SA(0, 1), a2 + hstepA, voffA);
            PG8_WAIT_V(8); PG8_WAIT_L(0); PG8_BAR; PG8_MMA(0, 0, At, B0); PG8_MMA(0, 1, At, B1); PG8_BAR; PG8_SCHED;
            PG8_LDA(At, 1, 1); PG8_STAGE(PG8_SB(1, 0), b3, voffB); PG8_STAGE(PG8_SB(1, 1), b3 + hstepB, voffB); PG8_STAGE(PG8_SA(1, 0), a3, voffA);
            PG8_WAIT_V(8); PG8_WAIT_L(0); PG8_BAR; PG8_MMA(1, 0, At, B0); PG8_MMA(1, 1, At, B1); PG8_BAR; PG8_SCHED;
            } else {
            PG8_LDB(B0, 0, 0); PG8_SCHED; PG8_LDA(At, 0, 0); PG8_STAGE(PG8_SA(1, 1), a1 + hstepA, voffA);
            PG8_WAIT_L(8); PG8_BAR; PG8_WAIT_L(0); PG8_MMA(0, 0, At, B0); PG8_BAR; PG8_SCHED;
            PG8_LDB(B1, 0, 1); PG8_STAGE(PG8_SB(0, 0), b2, voffB);
            PG8_BAR; PG8_WAIT_L(0); PG8_MMA(0, 1, At, B1); PG8_BAR;
            PG8_LDA(At, 0, 1); PG8_STAGE(PG8_SA(0, 0), a2, voffA);
            PG8_BAR; PG8_WAIT_L(0); PG8_MMA(1, 0, At, B0); PG8_BAR; PG8_SCHED;
            PG8_STAGE(PG8_SB(0, 1), b2 + hstepB, voffB);
            PG8_WAIT_V(6); PG8_BAR; PG8_MMA(1, 1, At, B1); PG8_BAR;
            PG8_LDB(B0, 1, 0); PG8_SCHED; PG8_LDA(At, 1, 0); PG8_STAGE(PG8_SA(0, 1), a2 + hstepA, voffA);
            PG8_WAIT_L(8); PG8_BAR; PG8_WAIT_L(0); PG8_MMA(0, 0, At, B0); PG8_BAR; PG8_SCHED;
            PG8_LDB(B1, 1, 1); PG8_STAGE(PG8_SB(1, 0), b3, voffB);
            PG8_BAR; PG8_WAIT_L(0); PG8_MMA(0, 1, At, B1); PG8_BAR;
            PG8_LDA(At, 1, 1); PG8_STAGE(PG8_SA(1, 0), a3, voffA);
            PG8_BAR; PG8_WAIT_L(0); PG8_MMA(1, 0, At, B0); PG8_BAR; PG8_SCHED;
            PG8_STAGE(PG8_SB(1, 1), b3 + hstepB, voffB);
            PG8_WAIT_V(6); PG8_BAR; PG8_MMA(1, 1, At, B1); PG8_BAR;
            }
        }
        if constexpr (ALIGN_EPI) { if (wr == 0) PG8_BAR; }
        E(acc, cur, wr, wc, fr, fq);
        if (!has_next) break;
#pragma unroll
        for (int a = 0; a < 2; ++a)
#pragma unroll
            for (int b = 0; b < 2; ++b)
#pragma unroll
                for (int m = 0; m < 4; ++m)
#pragma unroll
                    for (int n = 0; n < 2; ++n) acc[a][b][m][n] = (f32x4){0.f, 0.f, 0.f, 0.f};
        cur = nxt; cA = nA; cB = nB; ++ui;
        if constexpr (ALIGN_EPI) { if (wr == 1) PG8_BAR; }
    }
    PG8_WAIT_V(0);
    if constexpr (!ALIGN_EPI) { if (wr == 0) PG8_BAR; }
    PG8_BAR;
#undef PG8_SA
#undef PG8_SB
#undef PG8_STAGE
#undef PG8_LDA
#undef PG8_LDB
#undef PG8_MMA
#undef PG8_WAIT_V
#undef PG8_WAIT_L
#undef PG8_BAR
#undef PG8_SCHED
}
}

constexpr int NWAVES = 8;
constexpr int BATCH = 8, SEQ = 2048, DM = 1024, DEPTH = 4, M = BATCH * SEQ;
constexpr int HD = 64, NSA_H = 8, NSA_KVH = 2, NSA_G = 4, FOX_H = 8;
constexpr int N_CMP = 127, CMP_HID = 128;
constexpr int D_IN = 4896, NPROJ = 5120;
constexpr int FF_D = 2816, FF_E = 3584, NEXP = 8;
constexpr int XG_ROWS = 34816;
constexpr float LN_EPS = 1e-5f, DN_ALPHA = 1.681792830507429f, LOG2E = 1.4426950408889634f;
constexpr int PC_Q = 0, PC_KV = 512, PC_FOX = 1280, PC_MG = 2816, PC_MISC = 4864;
constexpr int SC_Q = 0, SC_KV = 512, SC_NG = 1280, SC_FOX = 1304, SC_FF = 2840, SC_MG = 2848;

constexpr size_t MiB = 1u << 20;
constexpr size_t WS_CTL = 0, CTL_ZERO_BYTES = 1 * MiB;
constexpr size_t WS_CBP = 1 * MiB;
constexpr size_t WS_NG = 2 * MiB;
constexpr size_t WS_LF = 4 * MiB;
constexpr size_t WS_NF2 = 4 * MiB + 512 * 1024;
constexpr size_t WS_KCC = 5 * MiB;
constexpr size_t WS_VCC = 5 * MiB + 256 * 1024;
constexpr size_t WS_TOKE = 5 * MiB + 512 * 1024;
constexpr size_t WS_TOKW = WS_TOKE + 128 * 1024;
constexpr size_t WS_TOKP = WS_TOKW + 128 * 1024;
constexpr size_t WS_TOKS = WS_TOKP + 128 * 1024;
constexpr size_t WS_WIN = 8 * MiB;
constexpr size_t WS_WC1 = 48 * MiB;
constexpr size_t WS_WNSA = 52 * MiB;
constexpr size_t WS_WFOX = 56 * MiB;
constexpr size_t WS_WO = 60 * MiB;
constexpr size_t WS_WDGU = 68 * MiB;
constexpr size_t WS_WDD = 90 * MiB;
constexpr size_t WS_WMGU = 102 * MiB;
constexpr size_t WS_WMD = 326 * MiB;
constexpr size_t WS_XB = 438 * MiB;
constexpr size_t WS_PRE = 470 * MiB;
constexpr size_t WS_XG = 534 * MiB;
constexpr size_t WS_HID = 602 * MiB;
constexpr size_t WS_QN = 602 * MiB;
constexpr size_t WS_KV6 = 618 * MiB;
constexpr size_t WS_FQKV = 642 * MiB;
constexpr size_t WS_MG = 690 * MiB;
constexpr size_t WS_YN = 754 * MiB;
constexpr size_t WS_YF = 770 * MiB;
constexpr size_t WS_MERGED = 786 * MiB;
constexpr size_t WS_END = 840 * MiB;
static_assert(WS_HID + (size_t)XG_ROWS * FF_E * 2 <= WS_END && WS_MERGED + (size_t)M * DM * 2 <= WS_END, "ws map");
constexpr int CW_BAR = 4096;
constexpr int CW_MOECNT = 16384;

constexpr int RING_BYTES = 131072;
constexpr int ATT_LDS_LIMIT = 143360;
constexpr int LDSCTL_OFF = ATT_LDS_LIMIT, MISC_OFF = LDSCTL_OFF + 320;
constexpr int LDS_BYTES = 147456;

#define GAS __attribute__((address_space(1)))
#define LAS __attribute__((address_space(3)))
typedef unsigned short bf16;
typedef unsigned v4u __attribute__((ext_vector_type(4)));
typedef unsigned v2u __attribute__((ext_vector_type(2)));
typedef float f32x4 __attribute__((ext_vector_type(4)));
typedef float f32x16 __attribute__((ext_vector_type(16)));
typedef short bf16x8 __attribute__((ext_vector_type(8)));
#define LDS_WAIT() asm volatile("s_waitcnt lgkmcnt(0)" ::: "memory")
#define VM_WAIT() asm volatile("s_waitcnt vmcnt(0)" ::: "memory")
__device__ __forceinline__ unsigned f2bf(float f) { unsigned u = __builtin_bit_cast(unsigned, f); return (u + 0x7fffu + ((u >> 16) & 1u)) >> 16; }
__device__ __forceinline__ unsigned pk2(float lo, float hi) { return f2bf(lo) | (f2bf(hi) << 16); }
__device__ __forceinline__ float bf2f(unsigned v) { return __builtin_bit_cast(float, v << 16); }
__device__ __forceinline__ float bflo(unsigned w) { return __builtin_bit_cast(float, w << 16); }
__device__ __forceinline__ float bfhi(unsigned w) { return __builtin_bit_cast(float, w & 0xffff0000u); }
__device__ __forceinline__ float sigmoidf_(float x) { return 1.f / (1.f + __expf(-x)); }
__device__ __forceinline__ float wave_sum(float v) {
#pragma unroll
    for (int o = 1; o < 64; o <<= 1) v += __shfl_xor(v, o);
    return v;
}
__device__ __forceinline__ float wave_max(float v) {
#pragma unroll
    for (int o = 1; o < 64; o <<= 1) v = fmaxf(v, __shfl_xor(v, o));
    return v;
}
__constant__ unsigned char T5LUT[128] = {0, 1, 2, 3, 4, 5, 6, 7, 8, 9, 10, 11, 12, 13, 14, 15, 16, 16, 16, 17, 17, 18, 18, 18, 19, 19, 19, 20, 20, 20, 20, 21, 21, 21, 21, 22, 22, 22, 22, 22, 23, 23, 23, 23, 23, 23, 24, 24, 24, 24, 24, 24, 25, 25, 25, 25, 25, 25, 25, 26, 26, 26, 26, 26, 26, 26, 26, 27, 27, 27, 27, 27, 27, 27, 27, 27, 27, 28, 28, 28, 28, 28, 28, 28, 28, 28, 28, 29, 29, 29, 29, 29, 29, 29, 29, 29, 29, 29, 29, 30, 30, 30, 30, 30, 30, 30, 30, 30, 30, 30, 30, 30, 30, 31, 31, 31, 31, 31, 31, 31, 31, 31, 31, 31, 31, 31, 31, 31};
__device__ __forceinline__ int t5b(int n) { return n < 128 ? (int)T5LUT[n] : 31; }

#define XB_TMO      128
#define XB_XCNT(j)  (256  + 64 * (j))
#define XB_XSUB(j)  (1280 + 64 * (j))
#define XB_XGEN(j)  (2304 + 64 * (j))
#define XB_TOP      3328
#define XB_TOPGEN   3392
#define XCD_BAR_WORDS 3456
#define XB_SPIN_CAP (1u << 18)

__device__ __forceinline__ unsigned xb_ld(unsigned* p)              { return __hip_atomic_load(p, __ATOMIC_RELAXED, __HIP_MEMORY_SCOPE_AGENT); }
__device__ __forceinline__ unsigned xb_add(unsigned* p, unsigned v) { return __hip_atomic_fetch_add(p, v, __ATOMIC_RELAXED, __HIP_MEMORY_SCOPE_AGENT); }
__device__ __forceinline__ unsigned xb_xcc_id() { return (unsigned)__builtin_amdgcn_s_getreg((3 << 11) | 20) & 0xFu; }
#define XB_SPIN(cond, bar) do { unsigned _sp = 0; while (cond) { __builtin_amdgcn_s_sleep(1); \
    if ((++_sp & 255u) == 0u) { if (xb_ld(&(bar)[XB_TMO])) break; if (_sp > XB_SPIN_CAP) { atomicAdd(&(bar)[XB_TMO], 1u); break; } } } } while (0)

struct XcdBarrier {
    unsigned* bar; unsigned x;
    volatile LAS unsigned* st;
};

__device__ __forceinline__ XcdBarrier xcd_barrier_post(unsigned* bar, volatile LAS unsigned* st) {
    XcdBarrier b; b.bar = bar; b.x = xb_xcc_id(); b.st = st;
    if (threadIdx.x == 0) (void)xb_add(&bar[XB_XCNT(b.x)], 1u);
    return b;
}
__device__ __forceinline__ void xcd_barrier_complete(unsigned* bar, unsigned x, unsigned& nloc, unsigned& nx) {
    const unsigned G = gridDim.x * gridDim.y * gridDim.z;
    unsigned sum, cnt, mine, sp = 0u;
    for (;;) {
        sum = 0u; cnt = 0u; mine = 0u;
#pragma unroll
        for (unsigned j = 0; j < 16; ++j) { const unsigned c = xb_ld(&bar[XB_XCNT(j)]); sum += c; cnt += (c > 0u) ? 1u : 0u; mine = (j == x) ? c : mine; }
        if (sum == G) break;
        __builtin_amdgcn_s_sleep(1);
        if ((++sp & 255u) == 0u) { if (xb_ld(&bar[XB_TMO])) break; if (sp > XB_SPIN_CAP) { atomicAdd(&bar[XB_TMO], 1u); break; } }
    }
    nloc = mine > 0u ? mine : 1u; nx = cnt > 0u ? cnt : 1u;
}

__device__ __forceinline__ void xcd_barrier(const XcdBarrier& b) {
    asm volatile("s_waitcnt vmcnt(0)" ::: "memory");
    __syncthreads();
    if (threadIdx.x == 0) {
        unsigned* bar = b.bar;
        __builtin_amdgcn_s_waitcnt(0);
        unsigned nloc = b.st[0], nx = b.st[1];
        if (nloc == 0u) { xcd_barrier_complete(bar, b.x, nloc, nx); b.st[0] = nloc; b.st[1] = nx; }
        const unsigned old = xb_add(&bar[XB_XSUB(b.x)], 1u);
        const unsigned gen = old / nloc;
        if (old + 1u == (gen + 1u) * nloc) {
            __builtin_amdgcn_fence(__ATOMIC_RELEASE, "agent");
            asm volatile("s_waitcnt vmcnt(0)" ::: "memory");
            const unsigned og = xb_add(&bar[XB_TOP], 1u);
            const unsigned tg = og / nx;
            if (og + 1u == (tg + 1u) * nx) xb_add(&bar[XB_TOPGEN], 1u);
            else XB_SPIN(xb_ld(&bar[XB_TOPGEN]) == tg, bar);
            __builtin_amdgcn_fence(__ATOMIC_ACQUIRE, "agent");
            xb_add(&bar[XB_XGEN(b.x)], 1u);
            asm volatile("s_waitcnt vmcnt(0)" ::: "memory");
        } else {
            XB_SPIN(xb_ld(&bar[XB_XGEN(b.x)]) == gen, bar);
            __builtin_amdgcn_fence(__ATOMIC_ACQUIRE, "agent");
            asm volatile("s_waitcnt vmcnt(0)" ::: "memory");
        }
    }
    __syncthreads();
}

using pg8::Unit; using pg8::cvt_pk_bf16;
typedef const f32x4 (&AccRef)[2][2][4][2];

struct EpiInProj {
    static constexpr bool PERM = true;
    unsigned char* ws; const float* fbias;
    __device__ __forceinline__ void operator()(AccRef acc, const Unit& u, int wr, int wc, int fr, int fq) const {
        const int row0 = u.pm * 256 + wr * 64 + fr;
#pragma unroll
        for (int bj = 0; bj < 2; ++bj) {
            const int cw = u.pn * 256 + bj * 128 + wc * 32;
            const int c = cw + 8 * fq;
            if (cw < PC_MG) {
                bf16* base; int nh, head; float sc = 1.f;
                if (cw < PC_KV) { base = (bf16*)(ws + WS_QN); nh = 8; head = c >> 6; sc = 0.125f * LOG2E; }
                else if (cw < PC_FOX) { const int cc = c - PC_KV; base = (bf16*)(ws + WS_KV6) + (size_t)(cc >> 7) * ((size_t)M * 128); nh = 2; head = (cc >> 6) & 1; }
                else { const int cc = c - PC_FOX; const int which = cc >> 9; base = (bf16*)(ws + WS_FQKV) + (size_t)which * ((size_t)M * 512); nh = 8; head = (cc >> 6) & 7; sc = (which == 0) ? 0.125f * LOG2E : 1.f; }
                const int d = c & 63;
#pragma unroll
                for (int ai = 0; ai < 2; ++ai)
#pragma unroll
                    for (int m = 0; m < 4; ++m) {
                        const int row = row0 + ai * 128 + m * 16, b = row >> 11, s = row & 2047;
                        const f32x4 v0 = acc[ai][bj][m][0] * sc, v1 = acc[ai][bj][m][1] * sc;
                        v4u w; w.x = cvt_pk_bf16(v0[0], v0[1]); w.y = cvt_pk_bf16(v0[2], v0[3]); w.z = cvt_pk_bf16(v1[0], v1[1]); w.w = cvt_pk_bf16(v1[2], v1[3]);
                        *(v4u*)(base + ((size_t)(b * nh + head) * SEQ + s) * 64 + d) = w;
                    }
            } else if (cw < PC_MISC) {
                bf16* mg = (bf16*)(ws + WS_MG);
#pragma unroll
                for (int ai = 0; ai < 2; ++ai)
#pragma unroll
                    for (int m = 0; m < 4; ++m) {
                        const int row = row0 + ai * 128 + m * 16;
                        const f32x4 a = acc[ai][bj][m][0], bq = acc[ai][bj][m][1];
                        v4u w; w.x = cvt_pk_bf16(sigmoidf_(a[0]), sigmoidf_(a[1])); w.y = cvt_pk_bf16(sigmoidf_(a[2]), sigmoidf_(a[3]));
                        w.z = cvt_pk_bf16(sigmoidf_(bq[0]), sigmoidf_(bq[1])); w.w = cvt_pk_bf16(sigmoidf_(bq[2]), sigmoidf_(bq[3]));
                        *(v4u*)(mg + (size_t)row * 2048 + (c - PC_MG)) = w;
                    }
            } else if (cw == PC_MISC) {
                float* ng = (float*)(ws + WS_NG); float* lf = (float*)(ws + WS_LF);
#pragma unroll
                for (int ai = 0; ai < 2; ++ai)
#pragma unroll
                    for (int m = 0; m < 4; ++m) {
                        const int row = row0 + ai * 128 + m * 16;
                        const f32x4 a = acc[ai][bj][m][0], bq = acc[ai][bj][m][1];
                        if (fq < 3) {
                            float* o = ng + (size_t)row * 24 + 8 * fq;
                            *(f32x4*)o = (f32x4){sigmoidf_(a[0]), sigmoidf_(a[1]), sigmoidf_(a[2]), sigmoidf_(a[3])};
                            *(f32x4*)(o + 4) = (f32x4){sigmoidf_(bq[0]), sigmoidf_(bq[1]), sigmoidf_(bq[2]), sigmoidf_(bq[3])};
                        } else {
                            float* o = lf + (size_t)row * 8; float r[8];
#pragma unroll
                            for (int i = 0; i < 8; ++i) { const float x = (i < 4 ? a[i & 3] : bq[i & 3]) + fbias[i]; r[i] = fminf(x, 0.f) - log1pf(__expf(-fabsf(x))); }
                            *(f32x4*)o = (f32x4){r[0], r[1], r[2], r[3]}; *(f32x4*)(o + 4) = (f32x4){r[4], r[5], r[6], r[7]};
                        }
                    }
            }
        }
    }
};

template <bool ADD> struct EpiBranch {
    static constexpr bool PERM = true;
    const bf16* mg; bf16* out; int goff;
    __device__ __forceinline__ void operator()(AccRef acc, const Unit& u, int wr, int wc, int fr, int fq) const {
        const int row0 = u.pm * 256 + wr * 64 + fr, col0 = u.pn * 256 + wc * 32 + 8 * fq;
#pragma unroll
        for (int ai = 0; ai < 2; ++ai)
#pragma unroll
            for (int m = 0; m < 4; ++m) {
                const int row = row0 + ai * 128 + m * 16;
#pragma unroll
                for (int bj = 0; bj < 2; ++bj) {
                    const int c = col0 + bj * 128;
                    const v4u g = *(const v4u*)(mg + (size_t)row * 2048 + goff + c);
                    const f32x4 a = acc[ai][bj][m][0], bq = acc[ai][bj][m][1];
                    float r[8] = {bflo(g.x) * a[0], bfhi(g.x) * a[1], bflo(g.y) * a[2], bfhi(g.y) * a[3], bflo(g.z) * bq[0], bfhi(g.z) * bq[1], bflo(g.w) * bq[2], bfhi(g.w) * bq[3]};
                    if (ADD) { const v4u p = *(const v4u*)(out + (size_t)row * DM + c);
                        r[0] += bflo(p.x); r[1] += bfhi(p.x); r[2] += bflo(p.y); r[3] += bfhi(p.y); r[4] += bflo(p.z); r[5] += bfhi(p.z); r[6] += bflo(p.w); r[7] += bfhi(p.w); }
                    v4u w; w.x = cvt_pk_bf16(r[0], r[1]); w.y = cvt_pk_bf16(r[2], r[3]); w.z = cvt_pk_bf16(r[4], r[5]); w.w = cvt_pk_bf16(r[6], r[7]);
                    *(v4u*)(out + (size_t)row * DM + c) = w;
                }
            }
    }
};

struct EpiResF32 {
    static constexpr bool PERM = false;
    const float* xres; float* pre;
    __device__ __forceinline__ void operator()(AccRef acc, const Unit& u, int wr, int wc, int fr, int fq) const {
        const int row0 = u.pm * 256 + wr * 64 + fr, col0 = u.pn * 256 + wc * 32 + 4 * fq;
#pragma unroll
        for (int ai = 0; ai < 2; ++ai)
#pragma unroll
            for (int m = 0; m < 4; ++m) {
                const size_t off = (size_t)(row0 + ai * 128 + m * 16) * DM + col0;
#pragma unroll
                for (int bj = 0; bj < 2; ++bj)
#pragma unroll
                    for (int n = 0; n < 2; ++n) { const f32x4 x = *(const f32x4*)(xres + off + bj * 128 + n * 16); *(f32x4*)(pre + off + bj * 128 + n * 16) = x * DN_ALPHA + acc[ai][bj][m][n]; }
            }
    }
};

struct EpiSwiGLU {
    static constexpr bool PERM = true;
    bf16* hid; int ldh;
    __device__ __forceinline__ void operator()(AccRef acc, const Unit& u, int wr, int wc, int fr, int fq) const {
        const int row0 = u.pm * 256 + wr * 64 + fr, col0 = u.pn * 128 + wc * 32 + 8 * fq;
#pragma unroll
        for (int ai = 0; ai < 2; ++ai)
#pragma unroll
            for (int m = 0; m < 4; ++m) {
                float r[8];
#pragma unroll
                for (int n = 0; n < 2; ++n)
#pragma unroll
                    for (int i = 0; i < 4; ++i) { const float g = acc[ai][0][m][n][i], up = acc[ai][1][m][n][i]; r[n * 4 + i] = g * sigmoidf_(g) * up; }
                v4u w; w.x = cvt_pk_bf16(r[0], r[1]); w.y = cvt_pk_bf16(r[2], r[3]); w.z = cvt_pk_bf16(r[4], r[5]); w.w = cvt_pk_bf16(r[6], r[7]);
                *(v4u*)(hid + (size_t)(row0 + ai * 128 + m * 16) * ldh + col0) = w;
            }
    }
};

struct EpiPlainBf16 {
    static constexpr bool PERM = true;
    bf16* out;
    __device__ __forceinline__ void operator()(AccRef acc, const Unit& u, int wr, int wc, int fr, int fq) const {
        const int row0 = u.pm * 256 + wr * 64 + fr, col0 = u.pn * 256 + wc * 32 + 8 * fq;
#pragma unroll
        for (int ai = 0; ai < 2; ++ai)
#pragma unroll
            for (int m = 0; m < 4; ++m)
#pragma unroll
                for (int bj = 0; bj < 2; ++bj) {
                    const f32x4 a = acc[ai][bj][m][0], bq = acc[ai][bj][m][1];
                    v4u w; w.x = cvt_pk_bf16(a[0], a[1]); w.y = cvt_pk_bf16(a[2], a[3]); w.z = cvt_pk_bf16(bq[0], bq[1]); w.w = cvt_pk_bf16(bq[2], bq[3]);
                    *(v4u*)(out + (size_t)(row0 + ai * 128 + m * 16) * DM + col0 + bj * 128) = w;
                }
    }
};

struct Args { const float* in[21]; float* out; unsigned char* ws; int ph_lo, ph_hi; };
struct Frame { LAS unsigned char* lds; int vcu, G, wave; };
__device__ __forceinline__ int lane_id() { int l; asm volatile("v_mbcnt_lo_u32_b32 %0, -1, 0\n\tv_mbcnt_hi_u32_b32 %0, -1, %0" : "=v"(l)); return l; }
typedef __attribute__((address_space(4))) const Args CArgs;
__device__ __forceinline__ const CArgs* kargs() { const CArgs* p = (const CArgs*)__builtin_amdgcn_kernarg_segment_ptr(); asm volatile("" : "+s"(p)); return p; }
#define PHASE_IDS() int wave = F.wave; asm volatile("" : "+s"(wave)); int lane = lane_id(); asm volatile("" : "+v"(lane)); const int tid = wave * 64 + lane; (void)tid
enum { I_X = 0, I_WIN, I_PE, I_W1, I_W2, I_FB, I_WNSA, I_WFOX, I_WOUT, I_REL, I_LN1G, I_LN1B, I_LN2G, I_LN2B, I_DG, I_DU, I_DD, I_ROUT, I_MG, I_MU, I_MD };

struct SegDesc { const float* W; bf16* dst; int ldw, ncols, K, mode, roff; };
__device__ __forceinline__ SegDesc seg_desc(int s, const CArgs* a) {
    SegDesc d; unsigned char* ws = a->ws;
    if (s < 44) {
        const int L = s / 11, q = s % 11;
        if (q < 6) {
            const int sc[6] = {SC_Q, SC_KV, SC_FOX, SC_MG, SC_NG, SC_FF}, nc[6] = {512, 768, 1536, 2048, 24, 8}, ro[6] = {PC_Q, PC_KV, PC_FOX, PC_MG, PC_MISC, PC_MISC + 24};
            int scq = sc[0], ncq = nc[0], roq = ro[0];
#pragma unroll
            for (int i = 1; i < 6; ++i) if (q == i) { scq = sc[i]; ncq = nc[i]; roq = ro[i]; }
            d.W = a->in[I_WIN] + (size_t)L * DM * D_IN + scq; d.ldw = D_IN; d.ncols = ncq; d.K = DM; d.dst = (bf16*)(ws + WS_WIN) + (size_t)L * NPROJ * DM; d.mode = 0; d.roff = roq;
        } else if (q == 6) { d.W = a->in[I_WNSA] + (size_t)L * 512 * DM; d.ldw = DM; d.ncols = DM; d.K = 512; d.dst = (bf16*)(ws + WS_WNSA) + (size_t)L * DM * 512; d.mode = 0; d.roff = 0; }
        else if (q == 7) { d.W = a->in[I_WFOX] + (size_t)L * 512 * DM; d.ldw = DM; d.ncols = DM; d.K = 512; d.dst = (bf16*)(ws + WS_WFOX) + (size_t)L * DM * 512; d.mode = 0; d.roff = 0; }
        else if (q == 8) { d.W = a->in[I_WOUT] + (size_t)L * DM * DM; d.ldw = DM; d.ncols = DM; d.K = DM; d.dst = (bf16*)(ws + WS_WO) + (size_t)L * DM * DM; d.mode = 0; d.roff = 0; }
        else { const int kv = q - 9; d.W = a->in[I_W1] + (size_t)(L * 2 + kv) * 2048 * 128; d.ldw = 128; d.ncols = 128; d.K = 2048; d.dst = (bf16*)(ws + WS_WC1) + (size_t)(L * 2 + kv) * 128 * 2048; d.mode = 0; d.roff = 0; }
    } else if (s < 50) {
        const int j = (s - 44) / 3, q = (s - 44) % 3;
        if (q < 2) { d.W = a->in[q == 0 ? I_DG : I_DU] + (size_t)j * DM * FF_D; d.ldw = FF_D; d.ncols = FF_D; d.K = DM; d.dst = (bf16*)(ws + WS_WDGU) + (size_t)j * 2 * FF_D * DM; d.mode = 1; d.roff = q * 128; }
        else { d.W = a->in[I_DD] + (size_t)j * FF_D * DM; d.ldw = DM; d.ncols = DM; d.K = FF_D; d.dst = (bf16*)(ws + WS_WDD) + (size_t)j * DM * FF_D; d.mode = 0; d.roff = 0; }
    } else {
        const int je = (s - 50) / 3, q = (s - 50) % 3;
        if (q < 2) { d.W = a->in[q == 0 ? I_MG : I_MU] + (size_t)je * DM * FF_E; d.ldw = FF_E; d.ncols = FF_E; d.K = DM; d.dst = (bf16*)(ws + WS_WMGU) + (size_t)je * 2 * FF_E * DM; d.mode = 1; d.roff = q * 128; }
        else { d.W = a->in[I_MD] + (size_t)je * FF_E * DM; d.ldw = DM; d.ncols = DM; d.K = FF_E; d.dst = (bf16*)(ws + WS_WMD) + (size_t)je * DM * FF_E; d.mode = 0; d.roff = 0; }
    }
    return d;
}
constexpr int NSEG = 98;

__device__ __forceinline__ void p0_prologue(const Frame& F) {
    PHASE_IDS(); const CArgs* a = kargs();
    LAS unsigned char* scr = F.lds + wave * 9216;
    const int gw = F.vcu * NWAVES + wave, NGW = F.G * NWAVES;
    typedef short v4i16_t __attribute__((ext_vector_type(4)));
    const int kr = lane >> 4, nq = lane & 15, grp = lane >> 4, q4 = (lane & 15) >> 2, p4 = lane & 3;
    int base = 0;
    for (int s = 0; s < NSEG; ++s) {
        const SegDesc d = seg_desc(s, a);
        const int nblk = (d.ncols + 63) >> 6, n_items = (d.K >> 6) * nblk;
        int start = gw - (base % NGW); if (start < 0) start += NGW;
        for (int it = start; it < n_items; it += NGW) {
            const int kb = it / nblk, nb = it % nblk, k0 = 64 * kb, n0 = 64 * nb;
            const bool okn = n0 + 4 * nq < d.ncols;
            const float* src = d.W + (size_t)(k0 + kr) * d.ldw + n0 + 4 * nq;
            f32x4 v[16];
#pragma unroll
            for (int i = 0; i < 16; ++i) v[i] = okn ? *(const GAS f32x4*)(src + (size_t)(4 * i) * d.ldw) : (f32x4){0.f, 0.f, 0.f, 0.f};
#pragma unroll
            for (int i = 0; i < 16; ++i) { v2u w; w.x = pk2(v[i][0], v[i][1]); w.y = pk2(v[i][2], v[i][3]); *(LAS v2u*)(scr + (4 * i + kr) * 144 + 8 * nq) = w; }
            LDS_WAIT(); asm volatile("" ::: "memory");
            const int rbase = d.mode ? (d.roff + ((n0 >> 7) << 8) + (n0 & 127)) : (d.roff + n0);
#pragma unroll
            for (int nb4 = 0; nb4 < 4; ++nb4)
#pragma unroll
                for (int h = 0; h < 2; ++h) {
                    const int kc = 4 * h + grp;
                    const LAS unsigned char* rp = scr + (8 * kc + q4) * 144 + (16 * nb4 + 4 * p4) * 2;
                    const v4i16_t lo = __builtin_amdgcn_ds_read_tr16_b64_v4i16((LAS v4i16_t*)rp), hi4 = __builtin_amdgcn_ds_read_tr16_b64_v4i16((LAS v4i16_t*)(rp + 4 * 144));
                    v2u a2 = __builtin_bit_cast(v2u, lo), b2 = __builtin_bit_cast(v2u, hi4); asm volatile("" : "+v"(a2), "+v"(b2));
                    const int n = 16 * nb4 + (lane & 15);
                    if (n0 + n < d.ncols) *(GAS v4u*)(d.dst + (size_t)(rbase + n) * d.K + k0 + 8 * kc) = (v4u){a2.x, a2.y, b2.x, b2.y};
                }
            LDS_WAIT(); asm volatile("" ::: "memory");
        }
        base += n_items;
    }
    {
        constexpr int PADROWS = NPROJ - (PC_MISC + 32), V16_PER_L = PADROWS * DM * 2 / 16;
        const int gt = gw * 64 + lane, NGT = NGW * 64;
        for (int i = gt; i < DEPTH * V16_PER_L; i += NGT) { const int L = i / V16_PER_L, r = i % V16_PER_L;
            *((GAS v4u*)((bf16*)(a->ws + WS_WIN) + ((size_t)L * NPROJ + PC_MISC + 32) * DM) + r) = (v4u){0u, 0u, 0u, 0u}; }
        const float* x = a->in[I_X]; bf16* xb = (bf16*)(a->ws + WS_XB);
        for (int i = gt; i < M * DM / 8; i += NGT) { const f32x4 p = *((const GAS f32x4*)x + 2 * (size_t)i), q = *((const GAS f32x4*)x + 2 * (size_t)i + 1);
            v4u o; o.x = pk2(p[0], p[1]); o.y = pk2(p[2], p[3]); o.z = pk2(q[0], q[1]); o.w = pk2(q[2], q[3]); *((GAS v4u*)xb + i) = o; }
    }
    if (gw < 256) {
        const int lk = gw >> 5, sl = gw & 31;
        const float* pe = a->in[I_PE] + (size_t)lk * 2048 + sl * 64; const float* w1 = a->in[I_W1] + ((size_t)lk * 2048 + sl * 64) * 128;
        float a0 = 0.f, a1 = 0.f;
        for (int k = 0; k < 64; ++k) { const float p = pe[k]; a0 += p * w1[k * 128 + lane]; a1 += p * w1[k * 128 + 64 + lane]; }
        float* cbp = (float*)(a->ws + WS_CBP) + (size_t)gw * 128; cbp[lane] = a0; cbp[64 + lane] = a1;
    }
}

__device__ __forceinline__ float gelu_tanh(float x) { const float u = 0.7978845608028654f * (x + 0.044715f * x * x * x); return 0.5f * x * (1.f + tanhf(u)); }

__device__ __forceinline__ void p2_cmp_scan(const Frame& F, int L) {
    PHASE_IDS(); const CArgs* a = kargs(); unsigned char* ws = a->ws;
    typedef float f32x2_t __attribute__((ext_vector_type(2)));
    constexpr int A_OFF = 0, P_OFF = 36864, H_OFF = P_OFF + 65536, CB_OFF = H_OFF + 8192;
    for (int u = F.vcu; u < 256; u += F.G) {
        const int kv = u >> 7, bh = (u >> 3) & 15, rg = u & 7, i0 = 16 * rg;
        const bf16* src = (const bf16*)(ws + WS_KV6) + (size_t)kv * ((size_t)M * 128) + ((size_t)bh * SEQ + 16 * i0) * 64;
        for (int i = tid; i < 2176; i += 512) { const int tok = i >> 3, c = i & 7; *(LAS v4u*)(F.lds + A_OFF + tok * 128 + (tok >> 4) * 16 + c * 16) = *((const GAS v4u*)src + i); }
        if (tid < 128) { const float* cbp = (const float*)(ws + WS_CBP) + (size_t)(L * 2 + kv) * 32 * 128 + tid; float cb = 0.f;
            for (int s = 0; s < 32; ++s) cb += cbp[s * 128];
            ((LAS float*)(F.lds + CB_OFF))[tid] = cb; }
        __syncthreads();
        {
            const int row = lane & 15, kg = lane >> 4;
            const bf16* W = (const bf16*)(ws + WS_WC1) + ((size_t)(L * 2 + kv) * 128 + row) * 2048 + 256 * wave + 8 * kg;
            f32x4 acc[8];
#pragma unroll
            for (int nb = 0; nb < 8; ++nb) acc[nb] = (f32x4){0.f, 0.f, 0.f, 0.f};
#pragma unroll
            for (int ks = 0; ks < 8; ++ks) {
                const int k = 256 * wave + 32 * ks + 8 * kg, tok = 16 * row + (k >> 6);
                const bf16x8 af = *(const LAS bf16x8*)(F.lds + A_OFF + tok * 128 + (tok >> 4) * 16 + (k & 63) * 2);
#pragma unroll
                for (int nb = 0; nb < 8; ++nb) { const bf16x8 bfr = *(const GAS bf16x8*)(W + (size_t)nb * 16 * 2048 + ks * 32);
                    acc[nb] = __builtin_amdgcn_mfma_f32_16x16x32_bf16(af, bfr, acc[nb], 0, 0, 0); }
            }
            LAS float* part = (LAS float*)(F.lds + P_OFF) + wave * 2048;
#pragma unroll
            for (int nb = 0; nb < 8; ++nb)
#pragma unroll
                for (int r = 0; r < 4; ++r) part[(4 * kg + r) * 128 + 16 * nb + row] = acc[nb][r];
        }
        __syncthreads();
        {
            const int e = tid * 4; const LAS float* part = (const LAS float*)(F.lds + P_OFF) + e;
            f32x4 s = *(const LAS f32x4*)(F.lds + CB_OFF + (e & 127) * 4);
#pragma unroll
            for (int w = 0; w < 8; ++w) s += *(const LAS f32x4*)(part + w * 2048);
            *(LAS f32x4*)(F.lds + H_OFF + e * 4) = (f32x4){gelu_tanh(s[0]), gelu_tanh(s[1]), gelu_tanh(s[2]), gelu_tanh(s[3])};
        }
        __syncthreads();
        {
            const int i = tid >> 5, d = (tid & 31) * 2;
            const float* w2 = a->in[I_W2] + (size_t)(L * 2 + kv) * 128 * 64 + d; const LAS float* Hr = (const LAS float*)(F.lds + H_OFF) + i * 128;
            float o0 = 0.f, o1 = 0.f;
#pragma unroll 8
            for (int n = 0; n < 128; ++n) { const f32x2_t wv = *(const GAS f32x2_t*)(w2 + n * 64); const float hv = Hr[n]; o0 += hv * wv[0]; o1 += hv * wv[1]; }
            const bool ok = (i0 + i) < N_CMP;
            *(GAS unsigned*)((bf16*)(ws + (kv ? WS_VCC : WS_KCC)) + ((size_t)bh * 128 + i0 + i) * 64 + d) = ok ? pk2(o0, o1) : 0u;
        }
        __syncthreads();
    }
    if (F.vcu < BATCH) {
        const int b = F.vcu;
        const float* lf = (const float*)(ws + WS_LF) + ((size_t)b * SEQ + 256 * wave + 4 * lane) * 8;
        f32x4 v[8];
#pragma unroll
        for (int q = 0; q < 8; ++q) v[q] = *(const GAS f32x4*)(lf + 4 * q);
#pragma unroll
        for (int i = 1; i < 4; ++i) { v[2 * i] += v[2 * i - 2]; v[2 * i + 1] += v[2 * i - 1]; }
        f32x4 inc0 = v[6], inc1 = v[7];
#pragma unroll
        for (int o = 1; o < 64; o <<= 1) {
#pragma unroll
            for (int c = 0; c < 4; ++c) { const float t0 = __shfl_up(inc0[c], o), t1 = __shfl_up(inc1[c], o); if (lane >= o) { inc0[c] += t0; inc1[c] += t1; } }
        }
        LAS float* wt = (LAS float*)(F.lds + 120 * 1024);
        if (lane == 63) { *(LAS f32x4*)(wt + wave * 8) = inc0; *(LAS f32x4*)(wt + wave * 8 + 4) = inc1; }
        __syncthreads();
        f32x4 b0 = inc0 - v[6], b1 = inc1 - v[7];
        for (int w = 0; w < wave; ++w) { b0 += *(const LAS f32x4*)(wt + w * 8); b1 += *(const LAS f32x4*)(wt + w * 8 + 4); }
        float* out = (float*)(ws + WS_NF2) + (size_t)b * 8 * SEQ + 256 * wave + 4 * lane;
#pragma unroll
        for (int h = 0; h < 8; ++h) { const float bb = h < 4 ? b0[h & 3] : b1[h & 3];
            f32x4 r;
#pragma unroll
            for (int i = 0; i < 4; ++i) r[i] = -(bb + v[2 * i + (h >> 2)][h & 3]) * LOG2E;
            *(GAS f32x4*)(out + (size_t)h * SEQ) = r; }
    }
}

__device__ __forceinline__ void load_q64(const bf16* q, float (&qf)[64]) {
#pragma unroll
    for (int i = 0; i < 8; ++i) { const v4u v = *(const GAS v4u*)(q + 8 * i);
        qf[8 * i + 0] = bflo(v.x); qf[8 * i + 1] = bfhi(v.x); qf[8 * i + 2] = bflo(v.y); qf[8 * i + 3] = bfhi(v.y); qf[8 * i + 4] = bflo(v.z); qf[8 * i + 5] = bfhi(v.z); qf[8 * i + 6] = bflo(v.w); qf[8 * i + 7] = bfhi(v.w); }
}
__device__ __forceinline__ float dot64(const float (&qf)[64], const bf16* k) {
    float acc = 0.f;
#pragma unroll
    for (int i = 0; i < 8; ++i) { const v4u v = *(const GAS v4u*)(k + 8 * i);
        acc += qf[8 * i + 0] * bflo(v.x) + qf[8 * i + 1] * bfhi(v.x) + qf[8 * i + 2] * bflo(v.y) + qf[8 * i + 3] * bfhi(v.y) + qf[8 * i + 4] * bflo(v.z) + qf[8 * i + 5] * bfhi(v.z) + qf[8 * i + 6] * bflo(v.w) + qf[8 * i + 7] * bfhi(v.w); }
    return acc;
}
__device__ __forceinline__ void softmax_lds(LAS float* sc, int n, int lane, float mxl) {
    const float mx = wave_max(mxl);
    float l = 0.f;
    for (int i = lane; i < n; i += 64) { const float s = sc[i]; const float p = (s > -1e29f) ? exp2f(s - mx) : 0.f; sc[i] = p; l += p; }
    l = wave_sum(l);
    const float inv = 1.f / fmaxf(l, 1e-30f);
    for (int i = lane; i < n; i += 64) sc[i] *= inv;
}

__device__ __forceinline__ void p3_fox_naive(const Frame& F) {
    PHASE_IDS(); const CArgs* a = kargs(); unsigned char* ws = a->ws;
    LAS float* sc = (LAS float*)F.lds + wave * 2048;
    const int gw = F.vcu * NWAVES + wave, NGW = F.G * NWAVES;
    const bf16* FQ = (const bf16*)(ws + WS_FQKV); const bf16* FK = FQ + (size_t)M * 512; const bf16* FV = FK + (size_t)M * 512;
    for (int it = gw; it < BATCH * FOX_H * SEQ; it += NGW) {
        const int bh = it >> 11, t = it & 2047;
        float qf[64]; load_q64(FQ + ((size_t)bh * SEQ + t) * 64, qf);
        const float* nf = (const float*)(ws + WS_NF2) + (size_t)bh * SEQ; const float nft = nf[t];
        const bf16* kb = FK + (size_t)bh * SEQ * 64; const bf16* vb = FV + (size_t)bh * SEQ * 64;
        float mx = -1e30f;
        for (int s = lane; s <= t; s += 64) { const float v = dot64(qf, kb + (size_t)s * 64) + (nf[s] - nft); sc[s] = v; mx = fmaxf(mx, v); }
        softmax_lds(sc, t + 1, lane, mx);
        float o = 0.f;
        for (int s = 0; s <= t; ++s) o += sc[s] * bf2f(vb[(size_t)s * 64 + lane]);
        const int b = bh >> 3, h = bh & 7;
        ((bf16*)(ws + WS_YF))[((size_t)b * SEQ + t) * 512 + h * 64 + lane] = (bf16)f2bf(o);
    }
}

__device__ __forceinline__ void p3_nsa_naive(const Frame& F) {
    PHASE_IDS(); const CArgs* a = kargs(); unsigned char* ws = a->ws;
    const int half = wave >> 2, g = wave & 3;
    LAS float* sc = (LAS float*)F.lds + wave * 1024;
    LAS float* pc = (LAS float*)(F.lds + 32768) + half * 512;
    const bf16* QN = (const bf16*)(ws + WS_QN); const bf16* KV6 = (const bf16*)(ws + WS_KV6);
    const float* rel = a->in[I_REL];
    for (int it = blockIdx.x * 2 + half; it < BATCH * NSA_KVH * SEQ; it += 2 * F.G) {
        const int bk = it >> 11, t = it & 2047, b = bk >> 1, kvh = bk & 1, h = kvh * 4 + g, cur = t >> 6;
        float qf[64]; load_q64(QN + ((size_t)(b * 8 + h) * SEQ + t) * 64, qf);
        const float* ng = (const float*)(ws + WS_NG) + ((size_t)b * SEQ + t) * 24 + h * 3;
        const float g0 = ng[0], g1 = ng[1], g2 = ng[2];
        const bf16* kc = (const bf16*)(ws + WS_KCC) + (size_t)bk * 128 * 64; const bf16* vc = (const bf16*)(ws + WS_VCC) + (size_t)bk * 128 * 64;
        float mx = -1e30f;
        for (int c = lane; c < 128; c += 64) { const int ce = 16 * c + 31; float v = -1e30f;
            if (c < N_CMP && ce <= t) v = dot64(qf, kc + (size_t)c * 64) + rel[t5b(t - ce) * 8 + h] * LOG2E;
            sc[c] = v; mx = fmaxf(mx, v); }
        softmax_lds(sc, 128, lane, mx);
        float oc = 0.f;
        for (int c = 0; c < 128; ++c) oc += sc[c] * bf2f(vc[(size_t)c * 64 + lane]);
        pc[g * 128 + lane] = sc[lane]; pc[g * 128 + 64 + lane] = sc[64 + lane];
        __syncthreads();
        unsigned selmask;
        {
            float imp = -1.f;
            if (lane < 32) {
                const int j = lane;
                float P[5];
#pragma unroll
                for (int q = 0; q < 5; ++q) { const int c = 4 * j - 1 + q; P[q] = (c >= 0 && c < 128) ? ((pc[c] + pc[128 + c]) + (pc[256 + c] + pc[384 + c])) : 0.f; }
                const float v = P[1] + P[2] + P[3] + 0.5f * P[4] + 0.5f * P[0];
                const bool forced = (j == 0) || (j <= cur && j > cur - 2);
                imp = forced ? 1e4f : (j <= cur ? v : -1.f);
            }
            int rank = 0;
            for (int jj = 0; jj < 32; ++jj) { const float o = __shfl(imp, jj); rank += (o > imp || (o == imp && jj < lane)) ? 1 : 0; }
            selmask = (unsigned)(__ballot(lane < 32 && rank < 16) & 0xffffffffull);
        }
        __syncthreads();
        const bf16* ks = KV6 + (size_t)2 * M * 128 + (size_t)bk * SEQ * 64; const bf16* vs = KV6 + (size_t)3 * M * 128 + (size_t)bk * SEQ * 64;
        int nsel = 0; mx = -1e30f;
        for (int j = 0; j <= cur; ++j) if ((selmask >> j) & 1u) { const int pos = 64 * j + lane; float v = -1e30f;
            if (pos <= t) v = dot64(qf, ks + (size_t)pos * 64) + rel[t5b(t - pos) * 8 + h] * LOG2E;
            sc[nsel * 64 + lane] = v; mx = fmaxf(mx, v); ++nsel; }
        softmax_lds(sc, nsel * 64, lane, mx);
        float os = 0.f; { int q = 0;
            for (int j = 0; j <= cur; ++j) if ((selmask >> j) & 1u) { for (int i = 0; i < 64; ++i) os += sc[q * 64 + i] * bf2f(vs[(size_t)(64 * j + i) * 64 + lane]); ++q; } }
        const bf16* kw = KV6 + (size_t)4 * M * 128 + (size_t)bk * SEQ * 64; const bf16* vw = KV6 + (size_t)5 * M * 128 + (size_t)bk * SEQ * 64;
        const int lo = t - 511 > 0 ? t - 511 : 0, nw = t - lo + 1;
        mx = -1e30f;
        for (int i = lane; i < nw; i += 64) { const int pos = lo + i; const float v = dot64(qf, kw + (size_t)pos * 64) + rel[t5b(t - pos) * 8 + h] * LOG2E; sc[i] = v; mx = fmaxf(mx, v); }
        softmax_lds(sc, nw, lane, mx);
        float ow = 0.f;
        for (int i = 0; i < nw; ++i) ow += sc[i] * bf2f(vw[(size_t)(lo + i) * 64 + lane]);
        ((bf16*)(ws + WS_YN))[((size_t)b * SEQ + t) * 512 + h * 64 + lane] = (bf16)f2bf(g0 * oc + g1 * os + g2 * ow);
    }
}

template <int MODE, bool ROUTE, int LNG, int LNB>
__device__ __forceinline__ void ln_phase(const Frame& F, int L, int j) {
    PHASE_IDS(); const CArgs* a = kargs(); unsigned char* ws = a->ws; unsigned* ctl = (unsigned*)(ws + WS_CTL);
    const float* gam = a->in[LNG] + L * DM; const float* bet = a->in[LNB] + L * DM;
    const int gw = F.vcu * NWAVES + wave, NGW = F.G * NWAVES;
    LAS int* lcnt = (LAS int*)F.lds;
    LAS int* lrow = (LAS int*)(F.lds + 256);
    if (ROUTE) { if (tid < 16) lcnt[tid] = 0; __syncthreads(); }
    const float* pre = (const float*)(ws + WS_PRE); float* X = a->out; bf16* XB = (bf16*)(ws + WS_XB);
    f32x4 gv[4], bv[4];
#pragma unroll
    for (int q = 0; q < 4; ++q) { gv[q] = *((const GAS f32x4*)gam + lane + 64 * q); bv[q] = *((const GAS f32x4*)bet + lane + 64 * q); }
    int ri = 0;
    for (int m = gw; m < M; m += NGW, ++ri) {
        f32x4 v[4];
        if (MODE == 0) {
#pragma unroll
            for (int q = 0; q < 4; ++q) v[q] = *((const GAS f32x4*)(pre + (size_t)m * DM) + lane + 64 * q);
        } else {
            const int* ts = (const int*)(ws + WS_TOKS) + 2 * m; const float* tw = (const float*)(ws + WS_TOKW) + 2 * m;
            const int s0 = ts[0], s1 = ts[1]; const float w0 = tw[0], w1 = tw[1];
            const bf16* ys = (const bf16*)(ws + WS_XG);
#pragma unroll
            for (int q = 0; q < 4; ++q) {
                const f32x4 x = *((const GAS f32x4*)(X + (size_t)m * DM) + lane + 64 * q);
                const v2u y0 = *((const GAS v2u*)(ys + (size_t)s0 * DM) + lane + 64 * q), y1 = *((const GAS v2u*)(ys + (size_t)s1 * DM) + lane + 64 * q);
                v[q] = x * DN_ALPHA + (f32x4){bflo(y0.x), bfhi(y0.x), bflo(y0.y), bfhi(y0.y)} * w0 + (f32x4){bflo(y1.x), bfhi(y1.x), bflo(y1.y), bfhi(y1.y)} * w1;
            }
        }
        float s = 0.f;
#pragma unroll
        for (int q = 0; q < 4; ++q) s += (v[q][0] + v[q][1]) + (v[q][2] + v[q][3]);
        const float mean = wave_sum(s) * (1.f / DM); float s2 = 0.f;
#pragma unroll
        for (int q = 0; q < 4; ++q) { v[q] = v[q] - mean; s2 += (v[q][0] * v[q][0] + v[q][1] * v[q][1]) + (v[q][2] * v[q][2] + v[q][3] * v[q][3]); }
        const float rstd = 1.f / sqrtf(wave_sum(s2) * (1.f / DM) + LN_EPS);
#pragma unroll
        for (int q = 0; q < 4; ++q) { v[q] = v[q] * rstd * gv[q] + bv[q];
            *((GAS f32x4*)(X + (size_t)m * DM) + lane + 64 * q) = v[q];
            v2u o; o.x = pk2(v[q][0], v[q][1]); o.y = pk2(v[q][2], v[q][3]); *((GAS v2u*)(XB + (size_t)m * DM) + lane + 64 * q) = o; }
        if (ROUTE) {
            const float* R = a->in[I_ROUT] + (size_t)j * DM * NEXP;
            float lg[8];
#pragma unroll
            for (int e = 0; e < 8; ++e) lg[e] = 0.f;
#pragma unroll
            for (int q = 0; q < 4; ++q)
#pragma unroll
                for (int c = 0; c < 4; ++c) { const float xv = v[q][c]; const float* rr = R + (size_t)(4 * lane + 256 * q + c) * 8; const f32x4 r0 = *(const GAS f32x4*)rr, r1 = *(const GAS f32x4*)(rr + 4);
                    lg[0] += xv * r0[0]; lg[1] += xv * r0[1]; lg[2] += xv * r0[2]; lg[3] += xv * r0[3]; lg[4] += xv * r1[0]; lg[5] += xv * r1[1]; lg[6] += xv * r1[2]; lg[7] += xv * r1[3]; }
#pragma unroll
            for (int e = 0; e < 8; ++e) lg[e] = wave_sum(lg[e]);
            int e0 = 0; float l0 = lg[0];
#pragma unroll
            for (int e = 1; e < 8; ++e) if (lg[e] > l0) { l0 = lg[e]; e0 = e; }
            int e1 = -1; float l1 = -3.0e38f;
#pragma unroll
            for (int e = 0; e < 8; ++e) if (e != e0 && lg[e] > l1) { l1 = lg[e]; e1 = e; }
            const float w0 = 1.f / (1.f + __expf(l1 - l0));
            if (lane == 0) {
                int* te = (int*)(ws + WS_TOKE) + 2 * m; float* tw = (float*)(ws + WS_TOKW) + 2 * m;
                te[0] = e0; te[1] = e1; tw[0] = w0; tw[1] = 1.f - w0;
                const int p0 = __hip_atomic_fetch_add(&lcnt[e0], 1, __ATOMIC_RELAXED, __HIP_MEMORY_SCOPE_WORKGROUP), p1 = __hip_atomic_fetch_add(&lcnt[e1], 1, __ATOMIC_RELAXED, __HIP_MEMORY_SCOPE_WORKGROUP);
                LAS int* lr = lrow + (wave * 16 + ri) * 4; lr[0] = e0; lr[1] = e1; lr[2] = p0; lr[3] = p1;
            }
        }
    }
    if (ROUTE) {
        __syncthreads();
        if (tid < 8) lcnt[8 + tid] = (int)atomicAdd(ctl + CW_MOECNT + j * 64 + tid, (unsigned)lcnt[tid]);
        __syncthreads();
        ri = 0;
        for (int m = gw; m < M; m += NGW, ++ri) if (lane < 2) { LAS int* lr = lrow + (wave * 16 + ri) * 4; ((int*)(ws + WS_TOKP))[2 * m + lane] = lr[2 + lane] + lcnt[8 + lr[lane]]; }
    }
}

struct MoeTiles { int toff[9]; };
__device__ __forceinline__ void moe_tiles(unsigned* ctl, int j, int (&toff)[9]) {
    toff[0] = 0;
#pragma unroll
    for (int e = 0; e < 8; ++e) { const unsigned c = __hip_atomic_load(ctl + CW_MOECNT + j * 64 + e, __ATOMIC_RELAXED, __HIP_MEMORY_SCOPE_AGENT); toff[e + 1] = toff[e] + (int)((c + 255u) >> 8); }
}
__device__ __forceinline__ void moe_gather(const Frame& F, int j) {
    PHASE_IDS(); const CArgs* a = kargs(); unsigned char* ws = a->ws;
    int toff[9]; moe_tiles((unsigned*)(ws + WS_CTL), j, toff);
    const int gw = F.vcu * NWAVES + wave, NGW = F.G * NWAVES;
    const bf16* XB = (const bf16*)(ws + WS_XB); bf16* XG = (bf16*)(ws + WS_XG);
    for (int it = gw; it < 2 * M; it += NGW) {
        const int e = ((const int*)(ws + WS_TOKE))[it], p = ((const int*)(ws + WS_TOKP))[it];
        int tb = toff[0];
#pragma unroll
        for (int q = 1; q < 8; ++q) tb = (e == q) ? toff[q] : tb;
        const int slot = tb * 256 + p;
        if (lane == 0) ((int*)(ws + WS_TOKS))[it] = slot;
        const GAS v4u* src = (const GAS v4u*)(XB + (size_t)(it >> 1) * DM); GAS v4u* dst = (GAS v4u*)(XG + (size_t)slot * DM);
        dst[lane] = src[lane]; dst[64 + lane] = src[64 + lane];
    }
}

namespace att {
constexpr int KSTR = 1152, KT_BYTES = 8 * KSTR, VT_BYTES = 8192;
constexpr int NSLOT = 3;
constexpr int L_K = 0, L_V = NSLOT * KT_BYTES, L_F = L_V + NSLOT * VT_BYTES, L_WSF = L_F + 8192, L_LUT = L_WSF + 8 * 256, L_SEL = L_LUT + 5120, L_ACC = L_SEL + 256, L_OST = L_ACC, L_IMP = L_ACC + 32768, L_END = L_ACC + 65536;
static_assert(L_END <= ATT_LDS_LIMIT, "attention LDS map");
constexpr float MASKV = -3.0e30f, MINIT = -1.0e30f;
typedef short v4i16_t __attribute__((ext_vector_type(4)));
typedef short s16x4 __attribute__((ext_vector_type(4)));
__device__ __forceinline__ int crow(int r, int hi) { return (r & 3) + 8 * (r >> 2) + 4 * hi; }
__device__ __forceinline__ float swap_max(float m) { auto rr = __builtin_amdgcn_permlane32_swap(__float_as_uint(m), __float_as_uint(m), false, false); return fmaxf(__uint_as_float(rr[0]), __uint_as_float(rr[1])); }
__device__ __forceinline__ float swap_sum(float m) { auto rr = __builtin_amdgcn_permlane32_swap(__float_as_uint(m), __float_as_uint(m), false, false); return __uint_as_float(rr[0]) + __uint_as_float(rr[1]); }
__device__ __forceinline__ float swap_other(float m) { return __shfl_xor(m, 32); }
__device__ __forceinline__ unsigned cvtpk(float lo, float hi) { unsigned r; asm volatile("v_cvt_pk_bf16_f32 %0, %1, %2" : "=v"(r) : "v"(lo), "v"(hi)); return r; }

struct TileRegs { v4u k, v; f32x4 f; };
__device__ __forceinline__ void tile_issue(TileRegs& R, const bf16* kt, const bf16* vt, int tid) {
    R.k = *((const GAS v4u*)kt + tid); R.v = *((const GAS v4u*)vt + tid);
}
__device__ __forceinline__ void tile_store(const TileRegs& R, LAS unsigned char* lds, int buf, int tid) {
    const int row = tid >> 3, c = tid & 7;
    *(LAS v4u*)(lds + L_K + buf * KT_BYTES + c * KSTR + row * 16) = R.k;
    *(LAS v4u*)(lds + L_V + buf * VT_BYTES + (c >> 2) * 4096 + row * 64 + (c & 3) * 16) = R.v;
}
__device__ __forceinline__ void qkt(f32x16& p0, f32x16& p1, const LAS unsigned char* kb, const bf16x8 (&qr)[4], int r32, int hi) {
    p0 = (f32x16){}; p1 = (f32x16){};
#pragma unroll
    for (int d0 = 0; d0 < 4; ++d0) {
        const bf16x8 b0 = *(const LAS bf16x8*)(kb + (2 * d0 + hi) * KSTR + r32 * 16);
        const bf16x8 b1 = *(const LAS bf16x8*)(kb + (2 * d0 + hi) * KSTR + r32 * 16 + 512);
        p0 = __builtin_amdgcn_mfma_f32_32x32x16_bf16(b0, qr[d0], p0, 0, 0, 0);
        p1 = __builtin_amdgcn_mfma_f32_32x32x16_bf16(b1, qr[d0], p1, 0, 0, 0);
    }
}
__device__ __forceinline__ s16x4 vtr(const LAS unsigned char* p) { return __builtin_bit_cast(s16x4, __builtin_amdgcn_ds_read_tr16_b64_v4i16((LAS v4i16_t*)p)); }
__device__ __forceinline__ void pv(f32x16 (&o)[2], const LAS unsigned char* vb, const f32x16& p0, const f32x16& p1, int lane) {
    const int hi = lane >> 5;
    const LAS unsigned char* vp = vb + ((lane >> 4) & 1) * 32 + (lane & 3) * 8 + (4 * hi + ((lane & 15) >> 2)) * 64;
    v4u pw[4];
#pragma unroll
    for (int q = 0; q < 4; ++q) { pw[0][q] = cvtpk(p0[2 * q], p0[2 * q + 1]); pw[1][q] = cvtpk(p0[8 + 2 * q], p0[8 + 2 * q + 1]); pw[2][q] = cvtpk(p1[2 * q], p1[2 * q + 1]); pw[3][q] = cvtpk(p1[8 + 2 * q], p1[8 + 2 * q + 1]); }
#pragma unroll
    for (int d0 = 0; d0 < 2; ++d0)
#pragma unroll
        for (int ks = 0; ks < 4; ++ks) {
            const s16x4 lo = vtr(vp + d0 * 4096 + ks * 1024), hh = vtr(vp + d0 * 4096 + ks * 1024 + 512);
            const bf16x8 vf = (bf16x8){lo[0], lo[1], lo[2], lo[3], hh[0], hh[1], hh[2], hh[3]};
            o[d0] = __builtin_amdgcn_mfma_f32_32x32x16_bf16(__builtin_bit_cast(bf16x8, pw[ks]), vf, o[d0], 0, 0, 0);
        }
}
__device__ __forceinline__ void scale_rows(f32x16 (&o)[2], float f, LAS float* wsf, int r32, int hi) {
    if (hi == 0) wsf[r32] = f;
    asm volatile("s_waitcnt lgkmcnt(0)" ::: "memory");
#pragma unroll
    for (int k = 0; k < 4; ++k) { const f32x4 fv = *(const LAS f32x4*)(wsf + 8 * k + 4 * hi);
#pragma unroll
        for (int i = 0; i < 4; ++i) { o[0][4 * k + i] *= fv[i]; o[1][4 * k + i] *= fv[i]; } }
    asm volatile("s_waitcnt lgkmcnt(0)" ::: "memory");
}
__device__ __forceinline__ void axpy_rows(f32x16 (&acc)[2], const f32x16 (&o)[2], float f, LAS float* wsf, int r32, int hi) {
    if (hi == 0) wsf[r32] = f;
    asm volatile("s_waitcnt lgkmcnt(0)" ::: "memory");
#pragma unroll
    for (int k = 0; k < 4; ++k) { const f32x4 fv = *(const LAS f32x4*)(wsf + 8 * k + 4 * hi);
#pragma unroll
        for (int i = 0; i < 4; ++i) { acc[0][4 * k + i] += o[0][4 * k + i] * fv[i]; acc[1][4 * k + i] += o[1][4 * k + i] * fv[i]; } }
    asm volatile("s_waitcnt lgkmcnt(0)" ::: "memory");
}
template <int MODE>
__device__ __forceinline__ void acc_rows(f32x16 (&o)[2], float f, LAS float* wsf, LAS float* accw, int r32, int hi) {
    if (hi == 0) wsf[r32] = f;
    asm volatile("s_waitcnt lgkmcnt(0)" ::: "memory");
#pragma unroll
    for (int k = 0; k < 4; ++k) { const f32x4 fv = *(const LAS f32x4*)(wsf + 8 * k + 4 * hi);
#pragma unroll
        for (int i = 0; i < 4; ++i)
#pragma unroll
            for (int d0 = 0; d0 < 2; ++d0) { LAS float* p = accw + (8 * k + 4 * hi + i) * 64 + d0 * 32 + r32; const float v = o[d0][4 * k + i] * fv[i];
                if (MODE == 0) *p = v; else if (MODE == 1) *p += v; else o[d0][4 * k + i] = *p + v; } }
    asm volatile("s_waitcnt lgkmcnt(0)" ::: "memory");
}
__device__ __forceinline__ void softmax_pv(f32x16& p0, f32x16& p1, f32x16 (&o)[2], float& m, float& l, const LAS unsigned char* vb, LAS float* wsf, int lane) {
    const int r32 = lane & 31, hi = lane >> 5;
    float mt = fmaxf(p0[0], p1[0]);
#pragma unroll
    for (int r = 1; r < 16; ++r) mt = fmaxf(mt, fmaxf(p0[r], p1[r]));
    mt = swap_max(mt);
    if (__any(mt > m + 8.0f)) {
        const float mn = fmaxf(m, mt), alpha = __builtin_amdgcn_exp2f(m - mn);
        l *= alpha; m = mn;
        scale_rows(o, alpha, wsf, r32, hi);
    }
    float s = 0.f;
#pragma unroll
    for (int r = 0; r < 16; ++r) { p0[r] = __builtin_amdgcn_exp2f(p0[r] - m); p1[r] = __builtin_amdgcn_exp2f(p1[r] - m); s += p0[r] + p1[r]; }
    l += s;
    pv(o, vb, p0, p1, lane);
}
__device__ __forceinline__ void store_rows(const f32x16 (&o)[2], LAS unsigned char* ost, bf16* dst, int pitch, int lane) {
    const int r32 = lane & 31, hi = lane >> 5;
    LAS bf16* stg = (LAS bf16*)ost;
#pragma unroll
    for (int r = 0; r < 16; ++r) { const int orow = crow(r, hi);
#pragma unroll
        for (int d0 = 0; d0 < 2; ++d0) stg[orow * 64 + d0 * 32 + r32] = (bf16)f2bf(o[d0][r]); }
    asm volatile("s_waitcnt lgkmcnt(0)" ::: "memory");
#pragma unroll
    for (int i = 0; i < 4; ++i) { const int row = i * 8 + (lane >> 3), ch = lane & 7; const v4u v = *(const LAS v4u*)(stg + row * 64 + ch * 8); *(GAS v4u*)(dst + (size_t)row * pitch + ch * 8) = v; }
    asm volatile("s_waitcnt lgkmcnt(0)" ::: "memory");
}
#define ATT_BAR() do { asm volatile("s_waitcnt vmcnt(0) lgkmcnt(0)" ::: "memory"); __builtin_amdgcn_s_barrier(); asm volatile("" ::: "memory"); } while (0)
#define ATT_LBAR() do { asm volatile("s_waitcnt lgkmcnt(0)" ::: "memory"); __builtin_amdgcn_s_barrier(); asm volatile("" ::: "memory"); } while (0)

__device__ __forceinline__ void glds16(const void* gsrc, unsigned lds_dst) { unsigned keep;
    asm volatile("s_mov_b32 %0, m0\n\ts_mov_b32 m0, %2\n\ts_nop 0\n\tglobal_load_lds_dwordx4 %1, off\n\ts_mov_b32 m0, %0" : "=&s"(keep) : "v"(gsrc), "s"(lds_dst) : "memory"); }
#define SW_BAR() asm volatile("s_waitcnt lgkmcnt(0)\n\ts_barrier" ::: "memory")
#define SW_VBAR() asm volatile("s_waitcnt vmcnt(0) lgkmcnt(0)\n\ts_barrier" ::: "memory")
#define SW_VWAIT() asm volatile("s_waitcnt vmcnt(0)" ::: "memory")

struct PvFrag { v4u pw[4]; };
__device__ __forceinline__ void pack_p(PvFrag& f, const f32x16& p0, const f32x16& p1) {
#pragma unroll
    for (int q = 0; q < 4; ++q) { f.pw[0][q] = cvtpk(p0[2 * q], p0[2 * q + 1]); f.pw[1][q] = cvtpk(p0[8 + 2 * q], p0[8 + 2 * q + 1]); f.pw[2][q] = cvtpk(p1[2 * q], p1[2 * q + 1]); f.pw[3][q] = cvtpk(p1[8 + 2 * q], p1[8 + 2 * q + 1]); }
}
__device__ __forceinline__ void pv_packed(f32x16 (&o)[2], const LAS unsigned char* vb, const PvFrag& f, int lane) {
    const int hi = lane >> 5;
    const LAS unsigned char* vp = vb + ((lane >> 4) & 1) * 32 + (lane & 3) * 8 + (4 * hi + ((lane & 15) >> 2)) * 64;
#pragma unroll
    for (int d0 = 0; d0 < 2; ++d0)
#pragma unroll
        for (int ks = 0; ks < 4; ++ks) {
            const s16x4 lo = vtr(vp + d0 * 4096 + ks * 1024), hh = vtr(vp + d0 * 4096 + ks * 1024 + 512);
            const bf16x8 vf = (bf16x8){lo[0], lo[1], lo[2], lo[3], hh[0], hh[1], hh[2], hh[3]};
            o[d0] = __builtin_amdgcn_mfma_f32_32x32x16_bf16(__builtin_bit_cast(bf16x8, f.pw[ks]), vf, o[d0], 0, 0, 0);
        }
}
__device__ __forceinline__ float max3f(float a, float b, float c) { float r; asm("v_max3_f32 %0, %1, %2, %3" : "=v"(r) : "v"(a), "v"(b), "v"(c)); return r; }
__device__ __forceinline__ void softmax_tile(f32x16& p0, f32x16& p1, f32x16 (&o)[2], float& m, float& l, PvFrag& f, LAS float* wsf, int lane, float cadd) {
    const int r32 = lane & 31, hi = lane >> 5;
    float ma = max3f(p0[0], p0[1], p1[0]), mb = max3f(p0[2], p0[3], p1[1]); ma = max3f(ma, p1[2], p1[3]);
#pragma unroll
    for (int r = 4; r < 16; r += 4) { ma = max3f(ma, p0[r], p0[r + 1]); mb = max3f(mb, p0[r + 2], p0[r + 3]); ma = max3f(ma, p1[r], p1[r + 1]); mb = max3f(mb, p1[r + 2], p1[r + 3]); }
    float mt = swap_max(fmaxf(ma, mb)) + cadd;
    if (__any(mt > m + 8.0f)) {
        const float mn = fmaxf(m, mt), alpha = __builtin_amdgcn_exp2f(m - mn);
        l *= alpha; m = mn;
        scale_rows(o, alpha, wsf, r32, hi);
    }
    const float mref = m - cadd;
    float s0 = 0.f, s1 = 0.f;
#pragma unroll
    for (int r = 0; r < 16; ++r) { p0[r] = __builtin_amdgcn_exp2f(p0[r] - mref); p1[r] = __builtin_amdgcn_exp2f(p1[r] - mref); s0 += p0[r]; s1 += p1[r]; }
    l += s0 + s1;
    pack_p(f, p0, p1);
}
template <class TileOf, class Score, class Active>
__device__ __forceinline__ void sweep(LAS unsigned char* lds, const bf16* kbase, const bf16* vbase, const int NTL, const bf16x8 (&qr)[4], f32x16 (&o)[2], float& m, float& l,
                                      LAS float* wsf, int lane, int wave, const TileOf& tile_of, const Score& score, const Active& active) {
    const int r32 = lane & 31, hi = lane >> 5, half = wave >> 2;
    const unsigned lds0 = (unsigned)(uintptr_t)lds;
    const bf16* ksrc = kbase + lane * 64 + wave * 8;
    const bf16* vsrc = vbase + (16 * (wave & 3) + (lane >> 2)) * 64 + (wave >> 2) * 32 + (lane & 3) * 8;
#define SW_ISSUE(n) do { const int j_ = tile_of(n); const int s_ = (n) % NSLOT; \
        glds16(ksrc + (size_t)j_ * 4096, (unsigned)__builtin_amdgcn_readfirstlane((int)(lds0 + L_K + s_ * KT_BYTES + wave * KSTR))); \
        glds16(vsrc + (size_t)j_ * 4096, (unsigned)__builtin_amdgcn_readfirstlane((int)(lds0 + L_V + s_ * VT_BYTES + wave * 1024))); } while (0)
    SW_ISSUE(0); if (NTL > 1) SW_ISSUE(1); if (NTL > 2) SW_ISSUE(2);
    SW_VBAR();
    if (half) SW_BAR();
    f32x16 p0, p1; PvFrag pf;
    if (active(0)) qkt(p0, p1, lds + L_K, qr, r32, hi);
    SW_BAR();
    if (active(0)) { const float cadd = score(0, tile_of(0), p0, p1); softmax_tile(p0, p1, o, m, l, pf, wsf, lane, cadd); }
    SW_BAR();
    for (int i = 1; i < NTL; ++i) {
        const bool fetch1 = (i + 1 >= NSLOT) && (i + 1 < NTL), fetch2 = (i + 2 >= NSLOT) && (i + 2 < NTL);
        if (!half && fetch1) SW_ISSUE(i + 1);
        if (active(i - 1)) pv_packed(o, lds + L_V + ((i - 1) % NSLOT) * VT_BYTES, pf, lane);
        if (active(i)) qkt(p0, p1, lds + L_K + (i % NSLOT) * KT_BYTES, qr, r32, hi);
        if (half && fetch1) SW_VWAIT();
        SW_BAR();
        if (half && fetch2) SW_ISSUE(i + 2);
        if (active(i)) { const float cadd = score(i, tile_of(i), p0, p1); softmax_tile(p0, p1, o, m, l, pf, wsf, lane, cadd); }
        if (!half && fetch1) SW_VWAIT();
        SW_BAR();
    }
    if (!half) SW_BAR();
    if (active(NTL - 1)) pv_packed(o, lds + L_V + ((NTL - 1) % NSLOT) * VT_BYTES, pf, lane);
    SW_BAR();
#undef SW_ISSUE
}

__device__ __forceinline__ void fox_unit(LAS unsigned char* lds, unsigned char* ws, int bh, int qb, int tid_in) {
    int tid = tid_in; asm volatile("" : "+v"(tid));
    const int lane = tid & 63, wave = __builtin_amdgcn_readfirstlane(tid >> 6), r32 = lane & 31, hi = lane >> 5;
    const bf16* FQ = (const bf16*)(ws + WS_FQKV) + (size_t)bh * SEQ * 64; const bf16* FK = FQ + (size_t)M * 512; const bf16* FV = FK + (size_t)M * 512;
    const float* nf = (const float*)(ws + WS_NF2) + (size_t)bh * SEQ;
    LAS float* wsf = (LAS float*)(lds + L_WSF + wave * 256);
    const int q0 = 256 * qb + 32 * wave, qg = q0 + r32;
    bf16x8 qr[4];
#pragma unroll
    for (int d0 = 0; d0 < 4; ++d0) qr[d0] = *(const GAS bf16x8*)(FQ + (size_t)qg * 64 + 16 * d0 + 8 * hi);
    const int NT = 4 * qb + 4, mylast = (q0 + 31) >> 6;
    for (int i = tid; i < 16 * NT; i += 512) *(LAS f32x4*)(lds + L_F + i * 16) = *((const GAS f32x4*)nf + i);
    float m = MINIT, l = 0.f; f32x16 o[2]; o[0] = (f32x16){}; o[1] = (f32x16){};
    auto tile_of = [&](int i) { return NT - 1 - i; };
    auto active = [&](int i) { return NT - 1 - i <= mylast; };
    auto score = [&](int, int t, f32x16& p0, f32x16& p1) {
        const LAS float* fb = (const LAS float*)(lds + L_F) + 64 * t;
#pragma unroll
        for (int k = 0; k < 4; ++k) { const f32x4 f0 = *(const LAS f32x4*)(fb + 8 * k + 4 * hi), f1 = *(const LAS f32x4*)(fb + 32 + 8 * k + 4 * hi);
#pragma unroll
            for (int i = 0; i < 4; ++i) { p0[4 * k + i] += f0[i]; p1[4 * k + i] += f1[i]; } }
        if (64 * t + 63 > q0) {
            const int lim = qg - 64 * t;
#pragma unroll
            for (int r = 0; r < 16; ++r) { const int kv = crow(r, hi); if (kv > lim) p0[r] = MASKV; if (kv + 32 > lim) p1[r] = MASKV; }
        }
        return 0.f;
    };
    sweep(lds, FK, FV, NT, qr, o, m, l, wsf, lane, wave, tile_of, score, active);
    l = swap_sum(l);
    scale_rows(o, 1.f / l, wsf, r32, hi);
    const int b = bh >> 3, h = bh & 7;
    store_rows(o, lds + L_OST + wave * 4096, (bf16*)(ws + WS_YF) + ((size_t)b * SEQ + q0) * 512 + h * 64, 512, lane);
}

template <bool WIN>
__device__ __forceinline__ float nsa_scores(f32x16& p0, f32x16& p1, int dj, int tl, int hi, bool rowsel, const LAS float* lutg, float cfar) {
    const float rowc = rowsel ? 0.f : MASKV;
    if (dj <= 2) {
        const LAS float* tb = lutg + (255 - 64 * dj - tl + 4 * hi);
#pragma unroll
        for (int r = 0; r < 16; ++r) { const int c = (r & 3) + 8 * (r >> 2); p0[r] += tb[c]; p1[r] += tb[32 + c]; }
        if (dj == 0) {
            const int lim = tl - 4 * hi;
#pragma unroll
            for (int r = 0; r < 16; ++r) { const int c = (r & 3) + 8 * (r >> 2); if (c > lim) p0[r] = MASKV; if (c + 32 > lim) p1[r] = MASKV; }
        }
        return rowc;
    }
    if (WIN && dj == 8) {
        const int lim = tl - 4 * hi;
#pragma unroll
        for (int r = 0; r < 16; ++r) { const int c = (r & 3) + 8 * (r >> 2); if (c <= lim) p0[r] = MASKV; if (c + 32 <= lim) p1[r] = MASKV; }
    }
    return rowsel ? cfar : MASKV;
}

__device__ __forceinline__ void nsa_unit(LAS unsigned char* lds, unsigned char* ws, const float* relb, int bk, int cur, int tid_in) {
    int tid = tid_in; asm volatile("" : "+v"(tid));
    const int lane = tid & 63, wave = __builtin_amdgcn_readfirstlane(tid >> 6), r32 = lane & 31, hi = lane >> 5;
    const int g = wave & 3, th = wave >> 2, tl = 32 * th + r32, t = 64 * cur + tl, b = bk >> 1, kvh = bk & 1, h = 4 * kvh + g;
    LAS float* wsf = (LAS float*)(lds + L_WSF + wave * 256);
    LAS float* lutall = (LAS float*)(lds + L_LUT); const LAS float* lut = lutall + g * 320;
    LAS float* impP = (LAS float*)(lds + L_IMP); LAS unsigned* selm = (LAS unsigned*)(lds + L_SEL);
    const bf16* KV6 = (const bf16*)(ws + WS_KV6);
    for (int e = tid; e < 1280; e += 512) { const int gg = e / 320, rel = 255 - (e % 320); lutall[e] = relb[t5b(rel < 0 ? 0 : rel) * 8 + 4 * kvh + gg] * LOG2E; }
    const float cfar = relb[31 * 8 + h] * LOG2E;
    bf16x8 qr[4];
    { const bf16* Q = (const bf16*)(ws + WS_QN) + ((size_t)(b * 8 + h) * SEQ + t) * 64;
#pragma unroll
      for (int d0 = 0; d0 < 4; ++d0) qr[d0] = *(const GAS bf16x8*)(Q + 16 * d0 + 8 * hi); }
    const float* ngp = (const float*)(ws + WS_NG) + ((size_t)b * SEQ + t) * 24 + h * 3;
    const float g_c = ngp[0], g_s = ngp[1], g_w = ngp[2];
    f32x16 oc[2]; oc[0] = (f32x16){}; oc[1] = (f32x16){};
    LAS float* accw = (LAS float*)(lds + L_ACC + wave * 8192);
    {
        const bf16* kc = (const bf16*)(ws + WS_KCC) + (size_t)bk * 128 * 64; const bf16* vc = (const bf16*)(ws + WS_VCC) + (size_t)bk * 128 * 64;
        { TileRegs R0, R1; tile_issue(R0, kc, vc, tid); tile_issue(R1, kc + 4096, vc + 4096, tid);
          tile_store(R0, lds, 0, tid); tile_store(R1, lds, 1, tid); }
        ATT_BAR();
        const int ntc = cur > 15 ? 2 : 1;
#define CMP_SCORES(tt) do { qkt(p0, p1, lds + L_K + (tt) * KT_BYTES, qr, r32, hi); \
        _Pragma("unroll") for (int r = 0; r < 16; ++r) { const int c0 = 64 * (tt) + crow(r, hi), rel0 = t - (16 * c0 + 31), rel1 = rel0 - 512; \
            p0[r] = (rel0 >= 0) ? p0[r] + lut[255 - min(rel0, 255)] : MASKV; \
            p1[r] = (rel1 >= 0 && c0 + 32 < N_CMP) ? p1[r] + lut[255 - min(max(rel1, 0), 255)] : MASKV; } } while (0)
        float mx = MASKV, s = 0.f;
        for (int tt = 0; tt < ntc; ++tt) {
            f32x16 p0, p1; CMP_SCORES(tt);
            float mt = fmaxf(p0[0], p1[0]);
#pragma unroll
            for (int r = 1; r < 16; ++r) mt = fmaxf(mt, fmaxf(p0[r], p1[r]));
            mt = swap_max(mt);
            const float mn = fmaxf(mx, mt), mref = mn < -1e29f ? 0.f : mn;
            s *= __builtin_amdgcn_exp2f(fmaxf(mx, -1e30f) - fmaxf(mn, -1e30f));
#pragma unroll
            for (int r = 0; r < 16; ++r) s += __builtin_amdgcn_exp2f(p0[r] - mref) + __builtin_amdgcn_exp2f(p1[r] - mref);
            mx = mn;
        }
        s = swap_sum(s);
        const float mref = mx < -1e29f ? 0.f : mx, inv = 1.f / fmaxf(s, 1e-30f);
        LAS float* ip = impP + (size_t)(g * 64 + tl) * 32;
        float carry = 0.f;
        for (int tt = 0; tt < 2; ++tt) {
            if (tt < ntc) {
                f32x16 p0, p1; CMP_SCORES(tt);
#pragma unroll
                for (int r = 0; r < 16; ++r) { p0[r] = __builtin_amdgcn_exp2f(p0[r] - mref) * inv; p1[r] = __builtin_amdgcn_exp2f(p1[r] - mref) * inv; }
#pragma unroll
                for (int nn = 0; nn < 8; ++nn) { const f32x16& P = (nn >> 2) ? p1 : p0; const int k4 = 4 * (nn & 3);
                    const float pe = swap_other(P[k4 + 3]);
                    const float prev = hi ? pe : carry;
                    ip[2 * (8 * tt + nn) + hi] = (P[k4] + P[k4 + 1]) + (P[k4 + 2] + 0.5f * P[k4 + 3]) + 0.5f * prev;
                    carry = pe; }
                pv(oc, lds + L_V + tt * VT_BYTES, p0, p1, lane);
            } else {
#pragma unroll
                for (int nn = 0; nn < 8; ++nn) ip[2 * (8 * tt + nn) + hi] = 0.f;
            }
        }
#undef CMP_SCORES
    }
    ATT_LBAR();
    for (int i = 0; i < 8; ++i) {
        const int tok = 8 * wave + i;
        float imp = -1.f;
        if (lane < 32) { const int j = lane; const float v = (impP[(0 * 64 + tok) * 32 + j] + impP[(1 * 64 + tok) * 32 + j]) + (impP[(2 * 64 + tok) * 32 + j] + impP[(3 * 64 + tok) * 32 + j]);
            const bool forced = (j == 0) || (j <= cur && j > cur - 2);
            imp = forced ? 1e4f : (j <= cur ? v : -1.f); }
        int rank = 0;
#pragma unroll
        for (int jj = 0; jj < 32; ++jj) { const float ov = __int_as_float(__builtin_amdgcn_readlane(__float_as_int(imp), jj)); rank += (ov > imp || (ov == imp && jj < lane)) ? 1 : 0; }
        const unsigned msk = (unsigned)(__ballot(lane < 32 && rank < 16) & 0xffffffffull);
        if (lane == 0) selm[tok] = msk;
    }
    ATT_LBAR();
    acc_rows<0>(oc, g_c, wsf, accw, r32, hi);
    const unsigned vismask = (cur >= 31) ? 0xffffffffu : ((2u << cur) - 1u);
    const unsigned mysel = selm[tl] & vismask;
    unsigned U = selm[lane] & vismask;
#pragma unroll
    for (int of = 1; of < 64; of <<= 1) U |= (unsigned)__shfl_xor((int)U, of);
    U = (unsigned)__builtin_amdgcn_readfirstlane((int)U);
    {
        const bf16* ks = KV6 + (size_t)2 * M * 128 + (size_t)bk * SEQ * 64; const bf16* vs = KV6 + (size_t)3 * M * 128 + (size_t)bk * SEQ * 64;
        float m = MINIT, l = 0.f; f32x16 o[2]; o[0] = (f32x16){}; o[1] = (f32x16){};
        int jv = 0;
        { int cnt = lane + 1;
#pragma unroll 4
          for (int bq = 0; bq < 32; ++bq) if ((U >> bq) & 1u) { if (--cnt == 0) jv = bq; } }
        const int NTL = __builtin_popcount(U);
        auto tile_of = [&](int i) { return __builtin_amdgcn_readlane(jv, i); };
        auto active = [&](int) { return true; };
        auto score = [&](int, int j, f32x16& p0, f32x16& p1) {
            return nsa_scores<false>(p0, p1, cur - j, tl, hi, (mysel >> j) & 1u, lut, cfar);
        };
        sweep(lds, ks, vs, NTL, qr, o, m, l, wsf, lane, wave, tile_of, score, active);
        l = swap_sum(l);
        acc_rows<1>(o, g_s / l, wsf, accw, r32, hi);
    }
    {
        const bf16* kw = KV6 + (size_t)4 * M * 128 + (size_t)bk * SEQ * 64; const bf16* vw = KV6 + (size_t)5 * M * 128 + (size_t)bk * SEQ * 64;
        float m = MINIT, l = 0.f; f32x16 o[2]; o[0] = (f32x16){}; o[1] = (f32x16){};
        const int jlo = cur - 8 > 0 ? cur - 8 : 0;
        auto tile_of = [&](int i) { return cur - i; };
        auto active = [&](int) { return true; };
        auto score = [&](int, int j, f32x16& p0, f32x16& p1) {
            return nsa_scores<true>(p0, p1, cur - j, tl, hi, true, lut, cfar);
        };
        sweep(lds, kw, vw, cur - jlo + 1, qr, o, m, l, wsf, lane, wave, tile_of, score, active);
        l = swap_sum(l);
        acc_rows<2>(o, g_w / l, wsf, accw, r32, hi);
        store_rows(o, (LAS unsigned char*)accw, (bf16*)(ws + WS_YN) + ((size_t)b * SEQ + 64 * cur + 32 * th) * 512 + h * 64, 512, lane);
    }
}
}

__device__ __forceinline__ void p3_attention(const Frame& F) {
    PHASE_IDS(); const CArgs* a = kargs(); unsigned char* ws = a->ws;
#ifndef REP_FOX
#define REP_FOX 1
#endif
#ifndef REP_NSA
#define REP_NSA 1
#endif
    for (int rep_ = 0; rep_ < REP_FOX; ++rep_)
    for (int u = F.vcu; u < 512; u += F.G) { const int idx = u & 255, sec = u >> 8, bh = idx >> 2, s = idx & 3; att::fox_unit(F.lds, ws, bh, sec ? s : 7 - s, tid); }
    for (int rep_ = 0; rep_ < REP_NSA; ++rep_)
    for (int u = F.vcu; u < 512; u += F.G) { const int idx = u & 255, sec = u >> 8, bk = idx >> 4, s = idx & 15; att::nsa_unit(F.lds, ws, a->in[I_REL], bk, sec ? s : 31 - s, tid); }
}

constexpr int PH_PER_LAYER = 10, NPHASES = 1 + DEPTH * PH_PER_LAYER;
#ifndef REP_P0
#define REP_P0 1
#endif
#ifndef REP_INPROJ
#define REP_INPROJ 1
#endif
#ifndef REP_P2
#define REP_P2 1
#endif
#ifndef REP_ATTN
#define REP_ATTN 1
#endif
#ifndef REP_BRANCH
#define REP_BRANCH 1
#endif
#ifndef REP_WO
#define REP_WO 1
#endif
#ifndef REP_LN
#define REP_LN 1
#endif
#ifndef REP_UP
#define REP_UP 1
#endif
#ifndef REP_DOWN
#define REP_DOWN 1
#endif
#define REPEAT(n) for (int rep_ = 0; rep_ < (n); ++rep_)
#ifndef NAIVE_ATTN
#define NAIVE_ATTN 0
#endif
#ifndef MK_SINGLE
#define MK_SINGLE 1
#endif

#define IN(k) (lo <= (k) && (k) < hi)
#define SEAM(k) do { if (IN(k) && IN((k) + 1)) { XcdBarrier b_ = bar; asm volatile("" : "+s"(b_.bar)); xcd_barrier(b_); } } while (0)
template <int L> __device__ __forceinline__ void layer_body(const Frame& F, const int lo, const int hi, const XcdBarrier& bar) {
        const int pb = 1 + PH_PER_LAYER * L, j = L >> 1; const bool moe = (L & 1) != 0;
        if (IN(pb + 0)) REPEAT(REP_INPROJ) {
            const CArgs* ka = kargs(); unsigned char* ws = ka->ws;
            pg8::Gemm g{(const bf16*)(ws + WS_XB), (const bf16*)(ws + WS_WIN) + (size_t)L * NPROJ * DM, DM, DM, DM};
            pg8::StaticOrder S; S.init(M / 256, NPROJ / 256, F.G, (int)blockIdx.x);
            EpiInProj E{ws, ka->in[I_FB] + L * 8};
            pg8::gemm_phase<EpiInProj, pg8::StaticOrder, true, true>(F.lds, g, S, E, F.wave);
        }
        SEAM(pb + 0);
        if (IN(pb + 1)) REPEAT(REP_P2) { p2_cmp_scan(F, L); }
        SEAM(pb + 1);
        if (IN(pb + 2)) REPEAT(REP_ATTN) {
#if NAIVE_ATTN
            p3_fox_naive(F); __syncthreads(); p3_nsa_naive(F);
#else
            p3_attention(F);
#endif
        }
        SEAM(pb + 2);
        if (IN(pb + 3)) REPEAT(REP_BRANCH) {
            const CArgs* ka = kargs(); unsigned char* ws = ka->ws;
            pg8::StaticOrder S; S.init(M / 256, DM / 256, F.G, (int)blockIdx.x);
            { pg8::Gemm g{(const bf16*)(ws + WS_YN), (const bf16*)(ws + WS_WNSA) + (size_t)L * DM * 512, 512, 512, 512};
              EpiBranch<false> E{(const bf16*)(ws + WS_MG), (bf16*)(ws + WS_MERGED), 0};
              pg8::gemm_phase<EpiBranch<false>, pg8::StaticOrder, false, true>(F.lds, g, S, E, F.wave); }
            VM_WAIT(); __syncthreads();
            { pg8::Gemm g{(const bf16*)(ws + WS_YF), (const bf16*)(ws + WS_WFOX) + (size_t)L * DM * 512, 512, 512, 512};
              EpiBranch<true> E{(const bf16*)(ws + WS_MG), (bf16*)(ws + WS_MERGED), 1024};
              pg8::gemm_phase<EpiBranch<true>, pg8::StaticOrder, false, true>(F.lds, g, S, E, F.wave); }
        }
        SEAM(pb + 3);
        if (IN(pb + 4)) REPEAT(REP_WO) {
            const CArgs* ka = kargs(); unsigned char* ws = ka->ws;
            pg8::Gemm g{(const bf16*)(ws + WS_MERGED), (const bf16*)(ws + WS_WO) + (size_t)L * DM * DM, DM, DM, DM};
            pg8::StaticOrder S; S.init(M / 256, DM / 256, F.G, (int)blockIdx.x);
            EpiResF32 E{L == 0 ? ka->in[I_X] : (const float*)ka->out, (float*)(ws + WS_PRE)};
            pg8::gemm_phase<EpiResF32, pg8::StaticOrder, false, true>(F.lds, g, S, E, F.wave);
        }
        SEAM(pb + 4);
        if (IN(pb + 5)) {
            if (moe) ln_phase<0, true, I_LN1G, I_LN1B>(F, L, j);
            else ln_phase<0, false, I_LN1G, I_LN1B>(F, L, j);
        }
        SEAM(pb + 5);
        if (IN(pb + 6) && moe) { moe_gather(F, j); }
        if (moe) SEAM(pb + 6);
        if (IN(pb + 7)) REPEAT(REP_UP) {
            const CArgs* ka = kargs(); unsigned char* ws = ka->ws;
            if (moe) {
                int toff[9]; moe_tiles((unsigned*)(ws + WS_CTL), j, toff);
                pg8::MoeOrder S; S.so.init(toff[8], 2 * FF_E / 256, F.G, (int)blockIdx.x);
                S.t1 = toff[1]; S.t2 = toff[2]; S.t3 = toff[3]; S.t4 = toff[4]; S.t5 = toff[5]; S.t6 = toff[6]; S.t7 = toff[7];
                pg8::Gemm g{(const bf16*)(ws + WS_XG), (const bf16*)(ws + WS_WMGU) + (size_t)j * NEXP * 2 * FF_E * DM, DM, DM, DM};
                EpiSwiGLU E{(bf16*)(ws + WS_HID), FF_E};
                pg8::gemm_phase<EpiSwiGLU, pg8::MoeOrder, true, true>(F.lds, g, S, E, F.wave);
            } else {
                pg8::Gemm g{(const bf16*)(ws + WS_XB), (const bf16*)(ws + WS_WDGU) + (size_t)j * 2 * FF_D * DM, DM, DM, DM};
                pg8::StaticOrder S; S.init(M / 256, 2 * FF_D / 256, F.G, (int)blockIdx.x);
                EpiSwiGLU E{(bf16*)(ws + WS_HID), FF_D};
                pg8::gemm_phase<EpiSwiGLU, pg8::StaticOrder, true, true>(F.lds, g, S, E, F.wave);
            }
        }
        SEAM(pb + 7);
        if (IN(pb + 8)) REPEAT(REP_DOWN) {
            const CArgs* ka = kargs(); unsigned char* ws = ka->ws;
            if (moe) {
                int toff[9]; moe_tiles((unsigned*)(ws + WS_CTL), j, toff);
                pg8::MoeOrder S; S.so.init(toff[8], DM / 256, F.G, (int)blockIdx.x);
                S.t1 = toff[1]; S.t2 = toff[2]; S.t3 = toff[3]; S.t4 = toff[4]; S.t5 = toff[5]; S.t6 = toff[6]; S.t7 = toff[7];
                pg8::Gemm g{(const bf16*)(ws + WS_HID), (const bf16*)(ws + WS_WMD) + (size_t)j * NEXP * DM * FF_E, FF_E, FF_E, FF_E};
                EpiPlainBf16 E{(bf16*)(ws + WS_XG)};
                pg8::gemm_phase<EpiPlainBf16, pg8::MoeOrder, true, true>(F.lds, g, S, E, F.wave);
            } else {
                pg8::Gemm g{(const bf16*)(ws + WS_HID), (const bf16*)(ws + WS_WDD) + (size_t)j * DM * FF_D, FF_D, FF_D, FF_D};
                pg8::StaticOrder S; S.init(M / 256, DM / 256, F.G, (int)blockIdx.x);
                EpiResF32 E{(const float*)ka->out, (float*)(ws + WS_PRE)};
                pg8::gemm_phase<EpiResF32, pg8::StaticOrder, false, true>(F.lds, g, S, E, F.wave);
            }
        }
        SEAM(pb + 8);
        if (IN(pb + 9)) REPEAT(REP_LN) {
            if (moe) ln_phase<1, false, I_LN2G, I_LN2B>(F, L, j);
            else ln_phase<0, false, I_LN2G, I_LN2B>(F, L, j);
        }
        SEAM(pb + 9);
    }

__global__ void __launch_bounds__(NWAVES * 64, 2) hybrid_fwd(Args args) {
    extern __shared__ __attribute__((aligned(16))) unsigned char lds[];
    Frame F;
    F.lds = (LAS unsigned char*)lds;
    F.wave = __builtin_amdgcn_readfirstlane((int)threadIdx.x >> 6);
    F.G = gridDim.x; { const int bx = blockIdx.x; F.vcu = (F.G % 8 == 0) ? (bx % 8) * (F.G / 8) + bx / 8 : bx; }
    for (int u = threadIdx.x; u < (LDS_BYTES - LDSCTL_OFF) / 4; u += NWAVES * 64) ((LAS unsigned*)(F.lds + LDSCTL_OFF))[u] = 0u;
    __syncthreads();
    const int lo = args.ph_lo, hi = args.ph_hi;
    XcdBarrier bar; bar.bar = (unsigned*)(args.ws + WS_CTL) + CW_BAR; bar.x = 0; bar.st = nullptr;
    if (hi - lo > 1) bar = xcd_barrier_post((unsigned*)(args.ws + WS_CTL) + CW_BAR, (volatile LAS unsigned*)(F.lds + MISC_OFF) + 8);

    if (IN(0)) { REPEAT(REP_P0) p0_prologue(F); }
    SEAM(0);

    layer_body<0>(F, lo, hi, bar); layer_body<1>(F, lo, hi, bar); layer_body<2>(F, lo, hi, bar); layer_body<3>(F, lo, hi, bar);
#undef IN
#undef SEAM
}

extern "C" void kernel_launch(void* const* d_in, const int* in_sizes, int n_in, void* d_out, int out_size, void* d_ws, size_t ws_size, hipStream_t stream) {
    static int grid = 0;
    if (grid == 0) {
        if (n_in != 21 || in_sizes[0] != M * DM || out_size != M * DM || ws_size < WS_END) { fprintf(stderr, "kernel_launch: unexpected shapes / workspace (n_in %d, ws %zu, need %zu); nothing launched\n", n_in, ws_size, (size_t)WS_END); grid = -1; return; }
        int dev = 0, cus = 0, per_cu = 0;
        if (hipGetDevice(&dev) != hipSuccess || hipDeviceGetAttribute(&cus, hipDeviceAttributeMultiprocessorCount, dev) != hipSuccess) { grid = -1; return; }
        if (hipFuncSetAttribute((const void*)hybrid_fwd, hipFuncAttributeMaxDynamicSharedMemorySize, LDS_BYTES) != hipSuccess) { fprintf(stderr, "kernel_launch: hipFuncSetAttribute failed\n"); grid = -1; return; }
        if (hipOccupancyMaxActiveBlocksPerMultiprocessor(&per_cu, (const void*)hybrid_fwd, NWAVES * 64, LDS_BYTES) != hipSuccess || per_cu < 1) { fprintf(stderr, "kernel_launch: occupancy query reports %d blocks per CU\n", per_cu); }
        (void)hipGetLastError();
        grid = cus;
    }
    if (grid < 0) return;
    if (hipMemsetAsync((char*)d_ws + WS_CTL, 0, CTL_ZERO_BYTES, stream) != hipSuccess) return;
    Args a{};
    for (int i = 0; i < 21; ++i) a.in[i] = (const float*)d_in[i];
    a.out = (float*)d_out; a.ws = (unsigned char*)d_ws;
#if MK_SINGLE
    a.ph_lo = 0; a.ph_hi = NPHASES;
    hipLaunchKernelGGL(hybrid_fwd, dim3(grid), dim3(NWAVES * 64), LDS_BYTES, stream, a);
#else
    for (int p = 0; p < NPHASES; ++p) {
        if (p >= 1) { const int L = (p - 1) / PH_PER_LAYER, k = (p - 1) % PH_PER_LAYER; if (k == 6 && !(L & 1)) continue; }
        a.ph_lo = p; a.ph_hi = p + 1;
        hipLaunchKernelGGL(hybrid_fwd, dim3(grid), dim3(NWAVES * 64), LDS_BYTES, stream, a);
    }
#endif
}
```
